# Optimizing an MI355X kernel written in HIP

```python
import jax, jax.numpy as jnp
from jax import lax
import numpy as np

D_MODEL = 1024
BATCH = 8
SEQ = 2048
DEPTH = 4

CTX_LEN = 256
GRID_W = 64
Q_BLOCK = 128
ROPE_THETA = 10000.0
EPS = 1e-6

F_GROUPS = 4
F_GROUP_DIM = 128
F_WIDTH = F_GROUPS * F_GROUP_DIM
MLA_HEADS = 8
MLA_Q_RANK = 256
MLA_KV_RANK = 256
MLA_NOPE_DIM = 64
MLA_ROPE_DIM = 32
MLA_QK_DIM = MLA_NOPE_DIM + MLA_ROPE_DIM
MLA_V_DIM = 64
MLA_WIDTH = MLA_HEADS * MLA_V_DIM
GQA_HEADS = 8
GQA_KV_HEADS = 2
GQA_GROUP = GQA_HEADS // GQA_KV_HEADS
GQA_HEAD_DIM = 64
GQA_WIDTH = GQA_HEADS * GQA_HEAD_DIM
GQA_KV_WIDTH = GQA_KV_HEADS * GQA_HEAD_DIM

N_BRANCHES = 3
D_FF = 4 * D_MODEL
N_MOD = 6

KV_COLS = MLA_KV_RANK + MLA_ROPE_DIM + 2 * GQA_KV_WIDTH
KV_SPLITS = (MLA_KV_RANK, MLA_KV_RANK + MLA_ROPE_DIM, MLA_KV_RANK + MLA_ROPE_DIM + GQA_KV_WIDTH)
REST_SPLITS = (F_WIDTH, F_WIDTH + MLA_Q_RANK, F_WIDTH + MLA_Q_RANK + GQA_WIDTH)
IN_COLS = KV_COLS + F_WIDTH + MLA_Q_RANK + GQA_WIDTH + N_BRANCHES * D_MODEL

kernel_name = "hybrid_fourier_mla_gqa_dit_prefix"


def layer_norm(x, g=None, b=None):
    xf = x.astype(jnp.float32)
    mu = xf.mean(-1, keepdims=True)
    var = jnp.square(xf - mu).mean(-1, keepdims=True)
    y = (xf - mu) * lax.rsqrt(var + EPS)
    if g is not None:
        y = y * g.astype(jnp.float32) + b.astype(jnp.float32)
    return y.astype(x.dtype)


def rms_norm(x, g):
    xf = x.astype(jnp.float32)
    y = xf * lax.rsqrt(jnp.square(xf).mean(-1, keepdims=True) + EPS)
    return (y * g.astype(jnp.float32)).astype(x.dtype)


def modulate(x, shift, scale):
    return layer_norm(x) * (1 + scale) + shift


def rope_angles(rows, cols, d_rot):
    n = d_rot // 4
    freqs = ROPE_THETA ** (-jnp.arange(n, dtype=jnp.float32) / n)
    ang = jnp.concatenate([rows[:, None] * freqs, cols[:, None] * freqs], axis=-1)
    return jnp.cos(ang), jnp.sin(ang)


def apply_rope(x, cos, sin):
    x1, x2 = jnp.split(x, 2, axis=-1)
    cos = cos[:, None, :].astype(x.dtype)
    sin = sin[:, None, :].astype(x.dtype)
    return jnp.concatenate([x1 * cos - x2 * sin, x1 * sin + x2 * cos], axis=-1)


def attend(q, k, v):
    B, S, Hk, G, dk = q.shape
    nb = S // Q_BLOCK
    qb = jnp.moveaxis(q.reshape(B, nb, Q_BLOCK, Hk, G, dk), 1, 0)

    def block(qi):
        s = jnp.einsum("bqkgd,btkd->bkgqt", qi, k).astype(jnp.float32)
        w = jax.nn.softmax(s, axis=-1).astype(v.dtype)
        return jnp.einsum("bkgqt,btkd->bqkgd", w, v)

    o = lax.map(block, qb)
    return jnp.moveaxis(o, 0, 1).reshape(B, S, Hk * G * v.shape[-1])


def fourier_mix(u):
    B, S, _ = u.shape
    ug = u.reshape(B, S, F_GROUPS, F_GROUP_DIM).astype(jnp.float32)
    f = jnp.fft.fft2(ug, axes=(1, 3), norm="ortho").real
    return f.reshape(B, S, F_WIDTH).astype(u.dtype)


def kv_parts(p, lw, rope):
    B, T, _ = p.shape
    c_kv, k_r, k_g, v_g = jnp.split(p[..., :KV_COLS], KV_SPLITS, axis=-1)
    c_kv = rms_norm(c_kv, lw["mla_kv_g"])
    k_nope = (c_kv @ lw["w_uk"]).reshape(B, T, MLA_HEADS, MLA_NOPE_DIM)
    v_m = (c_kv @ lw["w_uv"]).reshape(B, T, MLA_HEADS, MLA_V_DIM)
    k_r = k_r[:, :, None, :]
    k_g = rms_norm(k_g.reshape(B, T, GQA_KV_HEADS, GQA_HEAD_DIM), lw["gqa_k_g"])
    v_g = v_g.reshape(B, T, GQA_KV_HEADS, GQA_HEAD_DIM)
    if rope is not None:
        k_r = apply_rope(k_r, *rope[0])
        k_g = apply_rope(k_g, *rope[1])
    k_m = jnp.concatenate([k_nope, jnp.broadcast_to(k_r, (B, T, MLA_HEADS, MLA_ROPE_DIM))], axis=-1)
    return (k_m, v_m, k_g, v_g)


def mixer(p, kv, lw, rope):
    B, S, _ = p.shape
    k_m, v_m, k_g, v_g = kv
    f_in, c_q, q_g, gate_logits = jnp.split(p[..., KV_COLS:], REST_SPLITS, axis=-1)
    y_f = fourier_mix(f_in) @ lw["w_fo"]
    q_m = (rms_norm(c_q, lw["mla_q_g"]) @ lw["w_uq"]).reshape(B, S, MLA_HEADS, MLA_QK_DIM)
    q_nope, q_rope = jnp.split(q_m, [MLA_NOPE_DIM], axis=-1)
    q_g = rms_norm(q_g.reshape(B, S, GQA_HEADS, GQA_HEAD_DIM), lw["gqa_q_g"])
    if rope is not None:
        q_rope = apply_rope(q_rope, *rope[0])
        q_g = apply_rope(q_g, *rope[1])
    q_m = jnp.concatenate([q_nope, q_rope], axis=-1)[:, :, :, None, :] * (MLA_QK_DIM ** -0.5)
    y_m = attend(q_m, k_m, v_m) @ lw["w_mo"]
    q_g = q_g.reshape(B, S, GQA_KV_HEADS, GQA_GROUP, GQA_HEAD_DIM) * (GQA_HEAD_DIM ** -0.5)
    y_g = attend(q_g, k_g, v_g) @ lw["w_go"]
    g_f, g_m, g_g = jnp.split(jax.nn.sigmoid(gate_logits + lw["b_gate"]), N_BRANCHES, axis=-1)
    return (g_f * y_f + g_m * y_m + g_g * y_g) @ lw["w_o"]


def sq_relu_mlp(h, lw):
    return jnp.square(jax.nn.relu(h @ lw["w1"])) @ lw["w2"]


def setup_inputs(seed: int = 0) -> dict:
    key = jax.random.key(seed)
    ks = iter(jax.random.split(key, 32))

    def nrm(shape, scale):
        return jax.random.normal(next(ks), shape, jnp.float32) * scale

    def gain(shape):
        return 1.0 + nrm(shape, 0.02)

    L, D = DEPTH, D_MODEL
    beta = (8.0 * DEPTH) ** -0.25
    return {
        "x": nrm((BATCH, SEQ, D), 1.0),
        "c": nrm((BATCH, D), 1.0),
        "ctx": nrm((BATCH, CTX_LEN, D), 1.0),
        "c_ctx": nrm((D,), 1.0),
        "w_ada": nrm((L, D, N_MOD * D), 0.5 * D ** -0.5),
        "b_ada": nrm((L, N_MOD * D), 0.01),
        "w_in": nrm((L, D, IN_COLS), D ** -0.5),
        "b_gate": nrm((L, N_BRANCHES * D), 0.01),
        "mla_q_g": gain((L, MLA_Q_RANK)),
        "mla_kv_g": gain((L, MLA_KV_RANK)),
        "w_uq": nrm((L, MLA_Q_RANK, MLA_HEADS * MLA_QK_DIM), MLA_Q_RANK ** -0.5),
        "w_uk": nrm((L, MLA_KV_RANK, MLA_HEADS * MLA_NOPE_DIM), MLA_KV_RANK ** -0.5),
        "w_uv": nrm((L, MLA_KV_RANK, MLA_HEADS * MLA_V_DIM), MLA_KV_RANK ** -0.5),
        "gqa_q_g": gain((L, GQA_HEAD_DIM)),
        "gqa_k_g": gain((L, GQA_HEAD_DIM)),
        "w_fo": nrm((L, F_WIDTH, D), F_WIDTH ** -0.5),
        "w_mo": nrm((L, MLA_WIDTH, D), MLA_WIDTH ** -0.5),
        "w_go": nrm((L, GQA_WIDTH, D), GQA_WIDTH ** -0.5),
        "w_o": nrm((L, D, D), beta * D ** -0.5),
        "ln1_g": gain((L, D)),
        "ln1_b": nrm((L, D), 0.02),
        "w1": nrm((L, D, D_FF), D ** -0.5),
        "w2": nrm((L, D_FF, D), beta * D_FF ** -0.5),
        "ln2_g": gain((L, D)),
        "ln2_b": nrm((L, D), 0.02),
    }


def reference(x, c, ctx, c_ctx, w_ada, b_ada, w_in, b_gate, mla_q_g, mla_kv_g, w_uq, w_uk, w_uv,
              gqa_q_g, gqa_k_g, w_fo, w_mo, w_go, w_o, ln1_g, ln1_b, w1, w2, ln2_g, ln2_b):
    B, S, D = x.shape
    ROWS = S // GRID_W
    rows = jnp.repeat(jnp.arange(ROWS), GRID_W).astype(jnp.float32)
    cols = jnp.tile(jnp.arange(GRID_W), ROWS).astype(jnp.float32)
    rope = (rope_angles(rows, cols, MLA_ROPE_DIM), rope_angles(rows, cols, GQA_HEAD_DIM))
    alpha = (2.0 * DEPTH) ** 0.25
    xc = ctx
    for l in range(DEPTH):
        last = l == DEPTH - 1
        lw = {
            "w_in": w_in[l], "b_gate": b_gate[l], "mla_q_g": mla_q_g[l], "mla_kv_g": mla_kv_g[l],
            "w_uq": w_uq[l], "w_uk": w_uk[l], "w_uv": w_uv[l], "gqa_q_g": gqa_q_g[l],
            "gqa_k_g": gqa_k_g[l], "w_fo": w_fo[l], "w_mo": w_mo[l], "w_go": w_go[l], "w_o": w_o[l],
            "w1": w1[l], "w2": w2[l],
        }
        mod_x = (jax.nn.silu(c) @ w_ada[l] + b_ada[l])[:, None, :]
        mod_c = (jax.nn.silu(c_ctx) @ w_ada[l] + b_ada[l])[None, None, :]
        sh1, sc1, g1, sh2, sc2, g2 = jnp.split(mod_x, N_MOD, axis=-1)
        csh1, csc1, cg1, csh2, csc2, cg2 = jnp.split(mod_c, N_MOD, axis=-1)

        h_x = modulate(x, sh1, sc1)
        h_c = modulate(xc, csh1, csc1)
        p_x = h_x @ lw["w_in"]
        p_c = h_c @ (lw["w_in"][:, :KV_COLS] if last else lw["w_in"])
        kv_c = kv_parts(p_c, lw, None)
        kv_x = kv_parts(p_x, lw, rope)
        kv_all = (
            jnp.concatenate([kv_c[0], kv_x[0]], axis=1),
            jnp.concatenate([kv_c[1], kv_x[1]], axis=1),
            jnp.concatenate([kv_c[2], kv_x[2]], axis=1),
            jnp.concatenate([kv_c[3], kv_x[3]], axis=1),
        )
        mix_x = mixer(p_x, kv_all, lw, rope)
        x = layer_norm(alpha * x + g1 * mix_x, ln1_g[l], ln1_b[l])
        x = layer_norm(alpha * x + g2 * sq_relu_mlp(modulate(x, sh2, sc2), lw), ln2_g[l], ln2_b[l])

        if not last:
            mix_c = mixer(p_c, kv_c, lw, None)
            xc = layer_norm(alpha * xc + cg1 * mix_c, ln1_g[l], ln1_b[l])
            xc = layer_norm(alpha * xc + cg2 * sq_relu_mlp(modulate(xc, csh2, csc2), lw), ln2_g[l], ln2_b[l])
    return x
```

```cpp
#include <hip/hip_runtime.h>
#include <hip/hip_cooperative_groups.h>
#include <cstdio>
#include <cstdint>
namespace cg = cooperative_groups;

#define LAS __attribute__((address_space(3)))
#define DI __device__ __forceinline__
typedef unsigned short bf16_t;
typedef short bf16x8 __attribute__((ext_vector_type(8)));
typedef short s16x4 __attribute__((ext_vector_type(4)));
typedef float f32x2 __attribute__((ext_vector_type(2)));
typedef float f32x4 __attribute__((ext_vector_type(4)));
typedef float f32x16 __attribute__((ext_vector_type(16)));
typedef unsigned u32x4 __attribute__((ext_vector_type(4)));
typedef unsigned u32x2 __attribute__((ext_vector_type(2)));
typedef __bf16 bf16x2_t __attribute__((ext_vector_type(2)));

#ifndef MK_ONE_LAUNCH
#define MK_ONE_LAUNCH 1
#endif
#ifndef OPQ_MASK
#if MK_ONE_LAUNCH
#define OPQ_MASK 7
#else
#define OPQ_MASK 0
#endif
#endif

constexpr int D = 1024, NB = 8, SEQ = 2048, CTXL = 256, NL = 4;
constexpr int ML = NB * SEQ, MC = NB * CTXL, MT = ML + MC;
constexpr int DFF = 4096, INC = 4896;
constexpr float EPS = 1e-6f;
constexpr float ALPHA = 1.6817928305074290f;
constexpr float QS_MLA = (float)(0.10206207261596575 * 1.4426950408889634);
constexpr float QS_GQA = (float)(0.125 * 1.4426950408889634);
constexpr int NIN = 4352;

constexpr size_t MiB = 1u << 20;
constexpr size_t WS_CTL = 0, CTL_BYTES = 65536;
constexpr size_t WS_MOD = 1 * MiB;
constexpr size_t WS_ROPEM = 2 * MiB;
constexpr size_t WS_ROPEG = 2 * MiB + 262144;
constexpr size_t WS_SSKV = 3 * MiB, WS_SSQ = 3 * MiB + 524288;
constexpr size_t WS_DFTMC = 4 * MiB;
constexpr size_t WS_DFTM = 5 * MiB;
constexpr size_t WS_W = 21 * MiB;
constexpr size_t W_IN = 0, W_KR = 8 * MiB + 524288, W_T = 9 * MiB, W_UKV = 11 * MiB, W_UQ = 11 * MiB + 524288, W_FO = 12 * MiB, W_MO = 13 * MiB,
                 W_GO = 14 * MiB, W_O = 15 * MiB, W_1 = 17 * MiB, W_2 = 25 * MiB;
constexpr size_t WS_XC = 54 * MiB;
constexpr size_t WS_HB = 62 * MiB;
constexpr size_t WS_CKV = 98 * MiB, WS_CQ = 107 * MiB, WS_KG = 116 * MiB, WS_VG = 120 * MiB + 524288, WS_QG = 125 * MiB, WS_KR = 143 * MiB;
constexpr size_t WS_KN = 145 * MiB, WS_VM = 163 * MiB, WS_QM = 181 * MiB;
constexpr size_t WS_F = 208 * MiB, WS_AM = 226 * MiB;
constexpr size_t WS_GATE = 244 * MiB, WS_TF = 352 * MiB, WS_TFC = 384 * MiB, WS_U = 244 * MiB;
constexpr size_t WS_END = 388 * MiB;

constexpr int LDS_BYTES = 147456, RING_BYTES = 131072, MISC_OFF = RING_BYTES + 320;

struct Params {
    const float* in[25];
    float* out;
    unsigned char* ws;
    int ph_lo, ph_hi;
};
enum { I_X = 0, I_C, I_CTX, I_CCTX, I_WADA, I_BADA, I_WIN, I_BGATE, I_MQG, I_MKVG, I_WUQ, I_WUK, I_WUV, I_GQG, I_GKG, I_WFO, I_WMO, I_WGO, I_WO,
       I_LN1G, I_LN1B, I_W1, I_W2, I_LN2G, I_LN2B };

DI unsigned pk2(float lo, float hi) { f32x2 v = {lo, hi}; bf16x2_t b = __builtin_convertvector(v, bf16x2_t); return __builtin_bit_cast(unsigned, b); }
DI u32x4 pk8(const f32x4& a, const f32x4& b) { u32x4 w; w.x = pk2(a[0], a[1]); w.y = pk2(a[2], a[3]); w.z = pk2(b[0], b[1]); w.w = pk2(b[2], b[3]); return w; }
DI float bf2f(unsigned short h) { return __uint_as_float((unsigned)h << 16); }
DI void unpk8(const u32x4& w, float* f) {
    f[0] = __uint_as_float(w.x << 16); f[1] = __uint_as_float(w.x & 0xffff0000u); f[2] = __uint_as_float(w.y << 16); f[3] = __uint_as_float(w.y & 0xffff0000u);
    f[4] = __uint_as_float(w.z << 16); f[5] = __uint_as_float(w.z & 0xffff0000u); f[6] = __uint_as_float(w.w << 16); f[7] = __uint_as_float(w.w & 0xffff0000u);
}
DI float shx(float v, int m, int lane) { return __int_as_float(__builtin_amdgcn_ds_bpermute((lane ^ m) << 2, __float_as_int(v))); }
DI float wave_sum(float v, int lane) {
#pragma unroll
    for (int o = 1; o < 64; o <<= 1) v += shx(v, o, lane);
    return v;
}

#define XB_TMO      128
#define XB_XCNT(j)  (256  + 64 * (j))
#define XB_XSUB(j)  (1280 + 64 * (j))
#define XB_XGEN(j)  (2304 + 64 * (j))
#define XB_TOP      3328
#define XB_TOPGEN   3392
#define XB_SPIN_CAP (1u << 22)
DI unsigned xb_ld(unsigned* p)              { return __hip_atomic_load(p, __ATOMIC_RELAXED, __HIP_MEMORY_SCOPE_AGENT); }
DI unsigned xb_add(unsigned* p, unsigned v) { return __hip_atomic_fetch_add(p, v, __ATOMIC_RELAXED, __HIP_MEMORY_SCOPE_AGENT); }
DI unsigned xb_xcc_id() { return (unsigned)__builtin_amdgcn_s_getreg((3 << 11) | 20) & 0xFu; }
#define XB_SPIN(cond, bar) do { unsigned _sp = 0; while (cond) { __builtin_amdgcn_s_sleep(1); \
    if ((++_sp & 255u) == 0u) { if (xb_ld(&(bar)[XB_TMO])) break; if (_sp > XB_SPIN_CAP) { atomicAdd(&(bar)[XB_TMO], 1u); break; } } } } while (0)
struct XcdBarrier { unsigned* bar; unsigned x; volatile LAS unsigned* st; };
DI XcdBarrier xcd_barrier_post(unsigned* bar, volatile LAS unsigned* st) {
    XcdBarrier b; b.bar = bar; b.x = xb_xcc_id(); b.st = st;
    if (threadIdx.x == 0) (void)xb_add(&bar[XB_XCNT(b.x)], 1u);
    return b;
}
DI void xcd_barrier_complete(unsigned* bar, unsigned x, unsigned& nloc, unsigned& nx) {
    const unsigned G = gridDim.x * gridDim.y * gridDim.z;
    unsigned sum, cnt, mine, sp = 0u;
    for (;;) {
        sum = 0u; cnt = 0u; mine = 0u;
#pragma unroll
        for (unsigned j = 0; j < 16; ++j) { const unsigned c = xb_ld(&bar[XB_XCNT(j)]); sum += c; cnt += (c > 0u) ? 1u : 0u; mine = (j == x) ? c : mine; }
        if (sum == G) break;
        __builtin_amdgcn_s_sleep(1);
        if ((++sp & 255u) == 0u) { if (xb_ld(&bar[XB_TMO])) break; if (sp > XB_SPIN_CAP) { atomicAdd(&bar[XB_TMO], 1u); break; } }
    }
    nloc = mine > 0u ? mine : 1u; nx = cnt > 0u ? cnt : 1u;
}
DI void xcd_barrier(const XcdBarrier& b, const int tid) {
    asm volatile("s_waitcnt vmcnt(0)" ::: "memory");
    __syncthreads();
    if (tid == 0) {
        unsigned* bar = b.bar;
        __builtin_amdgcn_s_waitcnt(0);
        unsigned nloc = b.st[0], nx = b.st[1];
        const unsigned old = xb_add(&bar[XB_XSUB(b.x)], 1u);
        const unsigned gen = old / nloc;
        if (old + 1u == (gen + 1u) * nloc) {
            __builtin_amdgcn_fence(__ATOMIC_RELEASE, "agent");
            asm volatile("s_waitcnt vmcnt(0)" ::: "memory");
            const unsigned og = xb_add(&bar[XB_TOP], 1u);
            const unsigned tg = og / nx;
            if (og + 1u == (tg + 1u) * nx) xb_add(&bar[XB_TOPGEN], 1u);
            else XB_SPIN(xb_ld(&bar[XB_TOPGEN]) == tg, bar);
            __builtin_amdgcn_fence(__ATOMIC_ACQUIRE, "agent");
            xb_add(&bar[XB_XGEN(b.x)], 1u);
            asm volatile("s_waitcnt vmcnt(0)" ::: "memory");
        } else {
            XB_SPIN(xb_ld(&bar[XB_XGEN(b.x)]) == gen, bar);
            __builtin_amdgcn_fence(__ATOMIC_ACQUIRE, "agent");
            asm volatile("s_waitcnt vmcnt(0)" ::: "memory");
        }
    }
    __syncthreads();
}

namespace pg8 {
constexpr int BM = 256, BK = 64, HALF = 128, HTB = HALF * BK * 2;
DI int lds_byte(int r, int c) { const int st = (r >> 4) * 2 + (c >> 5), rr = r & 15, cc = c & 31, ob = rr * 64 + cc * 2; return st * 1024 + (ob ^ (((ob >> 9) & 1) << 5)); }
DI void stage_rc(int b, int& R, int& C) { const int st = b / 1024, sb = b % 1024, swz = sb ^ (((sb >> 9) & 1) << 5); R = (st >> 1) * 16 + swz / 64; C = (st & 1) * 32 + (swz % 64) / 2; }
DI int perm32(int rho) { const int n = rho >> 4, i = rho & 15; return 8 * (i >> 2) + 4 * n + (i & 3); }

struct Unit { const char* A; const char* B; int job, pm, pn, z, seg; bool last; };
struct JobD { const char* A; const char* B; int nM, nN, nZ; long Az, Bz; };
DI void decode(const JobD& j, int t, long tileBytes, int jobid, Unit& u) {
    const int nMt = j.nM * j.nZ, nwg = nMt * j.nN;
    int wg; { const int q = nwg >> 3, r = nwg & 7, xcd = t & 7, off = t >> 3; wg = (xcd < r ? xcd * (q + 1) : r * (q + 1) + (xcd - r) * q) + off; }
    const int nig = 8 * j.nN, gid = wg / nig, fm = gid * 8, gsz = (nMt - fm) < 8 ? (nMt - fm) : 8;
    const int rem = wg - gid * nig, pn = rem / gsz, pmt = fm + (rem - pn * gsz);
    const int z = pmt / j.nM, pm = pmt - z * j.nM;
    u.A = j.A + (long)z * j.Az + (long)pm * tileBytes; u.B = j.B + (long)z * j.Bz + (long)pn * tileBytes;
    u.job = jobid; u.pm = pm; u.pn = pn; u.z = z; u.seg = 0; u.last = true;
}
struct Sched2 {
    JobD j0, j1; int n0, total, G, c; long tileBytes;
    DI bool next(int i, Unit& u) const {
        const long L = (long)i * G + c; if (L >= total) return false;
        if ((int)L < n0) decode(j0, (int)L, tileBytes, 0, u); else decode(j1, (int)L - n0, tileBytes, 1, u);
        return true;
    }
};
struct Sched3 {
    JobD j; const char* A1; const char* A2; const char* B1; const char* B2; int ntiles, G, c; long tileBytes;
    DI bool next(int i, Unit& u) const {
        const int ti = i / 3, seg = i - ti * 3; const long L = (long)ti * G + c; if (L >= ntiles) return false;
        decode(j, (int)L, tileBytes, 0, u);
        if (seg == 1) { u.A = A1 + (u.A - j.A); u.B = B1 + (u.B - j.B); }
        if (seg == 2) { u.A = A2 + (u.A - j.A); u.B = B2 + (u.B - j.B); }
        u.seg = seg; u.last = (seg == 2);
        return true;
    }
};

typedef f32x4 Acc[2][2][4][2];
template <int PITCH = 0, class Epi, class Sched>
DI void gemm_phase(LAS unsigned char* lds, const int K_, const Sched& S, const Epi& E, const int tid_in) {
    int Kq = K_; asm volatile("" : "+s"(Kq)); const int K = Kq & 0x1fc0;
    int tid_ = tid_in;
#ifndef NO_OPQ_TID
    asm volatile("" : "+v"(tid_));
#endif
    const int tid = tid_ & 511, wid = __builtin_amdgcn_readfirstlane(tid >> 6), lane = tid & 63, wr = wid >> 2, wc = wid & 3, fr = lane & 15, fq = lane >> 4;
    const int nt = K / BK;
    unsigned voffA[2], voffB[2];
#pragma unroll
    for (int i = 0; i < 2; ++i) { int R, C; stage_rc(tid * 16 + i * 8192, R, C); const int Rb = (R & ~31) + perm32(R & 31);
        voffA[i] = (unsigned)(R * (PITCH ? PITCH : K) + C) * 2u; voffB[i] = (unsigned)(Rb * (PITCH ? PITCH : K) + C) * 2u; }
    const size_t kstep = (size_t)(BK * 2);
    const size_t hstep = (size_t)HALF * (PITCH ? PITCH : K) * 2;
    const unsigned ldsw = (unsigned)wid * 1024u;
    const int aoff = lds_byte(wr * 64 + fr, fq * 8), boff = lds_byte(wc * 32 + fr, fq * 8);
#define PG8_SA(b, h) (((b) * 2 + (h)) * HTB)
#define PG8_SB(b, h) ((4 + (b) * 2 + (h)) * HTB)
#define PG8_STAGE(bufoff, gbase, voff) do { _Pragma("unroll") for (int _i = 0; _i < 2; ++_i) \
        __builtin_amdgcn_global_load_lds((const unsigned*)((const char*)(gbase) + (voff)[_i]), (LAS unsigned*)(lds + (bufoff) + ldsw + _i * 8192), 16, 0, 0); } while (0)
#define PG8_LDA(dst, b, h) do { _Pragma("unroll") for (int m = 0; m < 4; ++m) _Pragma("unroll") for (int k = 0; k < 2; ++k) dst[m][k] = *(const LAS bf16x8*)(lds + PG8_SA(b, h) + aoff + m * 2048 + k * 1024); } while (0)
#define PG8_LDB(dst, b, h) do { _Pragma("unroll") for (int n = 0; n < 2; ++n) _Pragma("unroll") for (int k = 0; k < 2; ++k) dst[n][k] = *(const LAS bf16x8*)(lds + PG8_SB(b, h) + boff + n * 2048 + k * 1024); } while (0)
#define PG8_MMA(ai, bj, At, Bt) do { __builtin_amdgcn_s_setprio(1); _Pragma("unroll") for (int m = 0; m < 4; ++m) _Pragma("unroll") for (int n = 0; n < 2; ++n) _Pragma("unroll") for (int k = 0; k < 2; ++k) \
        acc[ai][bj][m][n] = __builtin_amdgcn_mfma_f32_16x16x32_bf16(Bt[n][k], At[m][k], acc[ai][bj][m][n], 0, 0, 0); __builtin_amdgcn_s_setprio(0); } while (0)
#define PG8_WAIT_V(n) asm volatile("s_waitcnt vmcnt(" #n ")" ::: "memory")
#define PG8_WAIT_L(n) asm volatile("s_waitcnt lgkmcnt(" #n ")" ::: "memory")
#define PG8_BAR __builtin_amdgcn_s_barrier()
#define PG8_SCHED __builtin_amdgcn_sched_barrier(0)
    Unit cur, nxt; int ui = 0;
    if (!S.next(0, cur)) return;
    Acc acc;
#pragma unroll
    for (int a = 0; a < 2; ++a)
#pragma unroll
        for (int b = 0; b < 2; ++b)
#pragma unroll
            for (int m = 0; m < 4; ++m)
#pragma unroll
                for (int n = 0; n < 2; ++n) acc[a][b][m][n] = (f32x4){0.f, 0.f, 0.f, 0.f};
    bf16x8 At[4][2], B0[2][2], B1[2][2];
    const char* cA = cur.A; const char* cB = cur.B;
    PG8_STAGE(PG8_SB(0, 0), cB, voffB); PG8_STAGE(PG8_SB(0, 1), cB + hstep, voffB); PG8_STAGE(PG8_SA(0, 0), cA, voffA); PG8_STAGE(PG8_SA(0, 1), cA + hstep, voffA);
    if (wr == 1) PG8_BAR;
    PG8_WAIT_V(2); PG8_BAR;
    PG8_STAGE(PG8_SB(1, 0), cB + kstep, voffB); PG8_STAGE(PG8_SA(1, 0), cA + kstep, voffA); PG8_STAGE(PG8_SB(1, 1), cB + hstep + kstep, voffB);
    PG8_WAIT_V(6); PG8_BAR;
    for (;;) {
        const bool has_next = S.next(ui + 1, nxt);
        const char* nA = has_next ? nxt.A : cA; const char* nB = has_next ? nxt.B : cB;
        for (int t = 0; t < nt; t += 2) {
            const bool last = (t == nt - 2);
            const char* a1 = cA + (size_t)(t + 1) * kstep;
            const char* a2 = last ? nA : cA + (size_t)(t + 2) * kstep; const char* b2 = last ? nB : cB + (size_t)(t + 2) * kstep;
            const char* a3 = a2 + kstep; const char* b3 = b2 + kstep;
            PG8_LDB(B0, 0, 0); PG8_LDB(B1, 0, 1); PG8_SCHED; PG8_LDA(At, 0, 0); PG8_STAGE(PG8_SA(1, 1), a1 + hstep, voffA);
            PG8_WAIT_V(8); PG8_WAIT_L(0); PG8_BAR; PG8_MMA(0, 0, At, B0); PG8_MMA(0, 1, At, B1); PG8_BAR; PG8_SCHED;
            PG8_LDA(At, 0, 1); PG8_STAGE(PG8_SB(0, 0), b2, voffB); PG8_STAGE(PG8_SB(0, 1), b2 + hstep, voffB); PG8_STAGE(PG8_SA(0, 0), a2, voffA);
            PG8_WAIT_V(8); PG8_WAIT_L(0); PG8_BAR; PG8_MMA(1, 0, At, B0); PG8_MMA(1, 1, At, B1); PG8_BAR; PG8_SCHED;
            PG8_LDB(B0, 1, 0); PG8_LDB(B1, 1, 1); PG8_SCHED; PG8_LDA(At, 1, 0); PG8_STAGE(PG8_SA(0, 1), a2 + hstep, voffA);
            PG8_WAIT_V(8); PG8_WAIT_L(0); PG8_BAR; PG8_MMA(0, 0, At, B0); PG8_MMA(0, 1, At, B1); PG8_BAR; PG8_SCHED;
            PG8_LDA(At, 1, 1); PG8_STAGE(PG8_SB(1, 0), b3, voffB); PG8_STAGE(PG8_SB(1, 1), b3 + hstep, voffB); PG8_STAGE(PG8_SA(1, 0), a3, voffA);
            PG8_WAIT_V(8); PG8_WAIT_L(0); PG8_BAR; PG8_MMA(1, 0, At, B0); PG8_MMA(1, 1, At, B1); PG8_BAR; PG8_SCHED;
        }
        if (wr == 0) PG8_BAR;
        E(acc, cur, wr, wc, fr, fq);
        if (!has_next) break;
        if (cur.last) {
#pragma unroll
            for (int a = 0; a < 2; ++a)
#pragma unroll
                for (int b = 0; b < 2; ++b)
#pragma unroll
                    for (int m = 0; m < 4; ++m)
#pragma unroll
                        for (int n = 0; n < 2; ++n) acc[a][b][m][n] = (f32x4){0.f, 0.f, 0.f, 0.f};
        }
        cur = nxt; cA = nA; cB = nB; ++ui;
        if (wr == 1) PG8_BAR;
    }
    PG8_WAIT_V(0);
    PG8_BAR;
#undef PG8_SA
#undef PG8_SB
#undef PG8_STAGE
#undef PG8_LDA
#undef PG8_LDB
#undef PG8_MMA
#undef PG8_WAIT_V
#undef PG8_WAIT_L
#undef PG8_BAR
#undef PG8_SCHED
}
}
using pg8::Acc; using pg8::Unit;

struct Frame {
    const Params* P;
    unsigned char* ws;
    LAS unsigned char* lds;
    int tid, lane, wave, G, bid, vcu;
    int l;
    int zo;
};
DI const float* pin(const Frame& F, int idx) { return F.P->in[idx + F.zo]; }
DI const float* inl(const Frame& F, int idx, size_t per_layer) { return pin(F, idx) + (size_t)F.l * per_layer; }
DI const float* modp(const Frame& F, int l, int mr, int which) { return (const float*)(F.ws + WS_MOD) + ((size_t)(l * 9 + mr) * 6 + which) * 1024; }
DI int modrow_of_tile(int row0) { return row0 < ML ? (row0 >> 11) : 8; }
DI float* xrow_ptr(const Frame& F, int row) { return row < ML ? F.P->out + (size_t)row * D : (float*)(F.ws + WS_XC) + (size_t)(row - ML) * D; }
DI const float* xin_ptr(const Frame& F, int row) {
    if (F.l == 0) return row < ML ? pin(F, I_X) + (size_t)row * D : pin(F, I_CTX) + (size_t)(row - ML) * D;
    return xrow_ptr(F, row);
}

#define EPI_ROWS(ai, m) (128 * (ai) + 64 * wr + 16 * (m) + fr)
#define EPI_COL8(bj) (128 * (bj) + 32 * wc + 8 * fq)
#define FOR_AI_M _Pragma("unroll") for (int ai = 0; ai < 2; ++ai) _Pragma("unroll") for (int m = 0; m < 4; ++m)
#define ROW_FENCE asm volatile("" ::: "memory")

struct EpiG1 {
    const Frame& F;
    DI void operator()(Acc& acc, const Unit& u, int wr, int wc, int fr, int fq) const {
        unsigned char* ws = F.ws;
        if (u.job == 1) {
            bf16_t* base; int ld;
            if (u.pn < 64) { base = (bf16_t*)(ws + WS_TF) + (size_t)(u.pn >> 3) * 1024 * 2048 + (u.pn & 7) * 256; ld = 2048; }
            else { base = (bf16_t*)(ws + WS_TFC) + (size_t)(u.pn - 64) * 1024 * 256; ld = 256; }
            FOR_AI_M { const int r = u.pm * 256 + EPI_ROWS(ai, m);
#pragma unroll
                for (int bj = 0; bj < 2; ++bj) *(u32x4*)(base + (size_t)r * ld + EPI_COL8(bj)) = pk8(acc[ai][bj][m][0], acc[ai][bj][m][1]); }
            return;
        }
        const int row0 = u.pm * 256;
        if (u.pn <= 1) {
            bf16_t* dst = (bf16_t*)(ws + (u.pn == 0 ? WS_CKV : WS_CQ)); float* ss = (float*)(ws + (u.pn == 0 ? WS_SSKV : WS_SSQ));
            FOR_AI_M { const int r = row0 + EPI_ROWS(ai, m); float s = 0.f;
#pragma unroll
                for (int bj = 0; bj < 2; ++bj) { const f32x4 a = acc[ai][bj][m][0], b = acc[ai][bj][m][1];
                    s += (a[0] * a[0] + a[1] * a[1]) + (a[2] * a[2] + a[3] * a[3]) + (b[0] * b[0] + b[1] * b[1]) + (b[2] * b[2] + b[3] * b[3]);
                    *(u32x4*)(dst + (size_t)r * 256 + EPI_COL8(bj)) = pk8(a, b); }
                s += shx(s, 16, fr + 16 * fq); s += shx(s, 32, fr + 16 * fq);
                if (fq == 0) ss[(size_t)r * 4 + wc] = s; }
            return;
        }
        if (u.pn >= 5) {
            const int cb = (u.pn - 5) * 256; const float* bg = inl(F, I_BGATE, 3072) + cb; bf16_t* dst = (bf16_t*)(ws + WS_GATE) + cb;
            f32x4 bv[2][2];
#pragma unroll
            for (int bj = 0; bj < 2; ++bj) { bv[bj][0] = *(const f32x4*)(bg + EPI_COL8(bj)); bv[bj][1] = *(const f32x4*)(bg + EPI_COL8(bj) + 4); }
            FOR_AI_M { const int r = row0 + EPI_ROWS(ai, m);
#pragma unroll
                for (int bj = 0; bj < 2; ++bj) { f32x4 a = acc[ai][bj][m][0] + bv[bj][0], b = acc[ai][bj][m][1] + bv[bj][1];
#pragma unroll
                    for (int e = 0; e < 4; ++e) { a[e] = __builtin_amdgcn_rcpf(1.f + __builtin_amdgcn_exp2f(-1.4426950408889634f * a[e])); b[e] = __builtin_amdgcn_rcpf(1.f + __builtin_amdgcn_exp2f(-1.4426950408889634f * b[e])); }
                    *(u32x4*)(dst + (size_t)r * 3072 + EPI_COL8(bj)) = pk8(a, b); } }
            return;
        }
        const bool is_q = (u.pn >= 3);
        const bool is_v = (!is_q) && (wc >= 2);
        const float* gain = is_q ? inl(F, I_GQG, 64) : inl(F, I_GKG, 64);
        f32x4 gv[2][2];
#pragma unroll
        for (int bj = 0; bj < 2; ++bj) { gv[bj][0] = *(const f32x4*)(gain + 32 * bj + 8 * fq); gv[bj][1] = *(const f32x4*)(gain + 32 * bj + 8 * fq + 4); }
        bf16_t* dst; int ld, colb;
        if (is_q) { dst = (bf16_t*)(ws + WS_QG); ld = 512; colb = ((u.pn - 3) * 4 + wc) * 64; }
        else if (!is_v) { dst = (bf16_t*)(ws + WS_KG); ld = 128; colb = wc * 64; }
        else { dst = (bf16_t*)(ws + WS_VG); ld = 128; colb = (wc - 2) * 64; }
        const bool rope = (row0 < ML);
        const float* rg = (const float*)(ws + WS_ROPEG);
        const float qs = is_q ? QS_GQA : 1.f;
        FOR_AI_M { const int r = row0 + EPI_ROWS(ai, m);
            f32x4 x[2][2];
#pragma unroll
            for (int bj = 0; bj < 2; ++bj) { x[bj][0] = acc[ai][bj][m][0]; x[bj][1] = acc[ai][bj][m][1]; }
            if (!is_v) {
                float s = 0.f;
#pragma unroll
                for (int bj = 0; bj < 2; ++bj)
#pragma unroll
                    for (int n = 0; n < 2; ++n) s += (x[bj][n][0] * x[bj][n][0] + x[bj][n][1] * x[bj][n][1]) + (x[bj][n][2] * x[bj][n][2] + x[bj][n][3] * x[bj][n][3]);
                s += shx(s, 16, fr + 16 * fq); s += shx(s, 32, fr + 16 * fq);
                const float rstd = 1.f / sqrtf(s * (1.f / 64.f) + EPS);
#pragma unroll
                for (int bj = 0; bj < 2; ++bj)
#pragma unroll
                    for (int n = 0; n < 2; ++n) x[bj][n] = x[bj][n] * rstd * gv[bj][n];
                if (rope) {
                    const float* rr = rg + (size_t)(r & 2047) * 64 + 8 * fq;
#pragma unroll
                    for (int n = 0; n < 2; ++n) { const f32x4 cs = *(const f32x4*)(rr + 4 * n), sn = *(const f32x4*)(rr + 32 + 4 * n);
                        const f32x4 x1 = x[0][n], x2 = x[1][n]; x[0][n] = x1 * cs - x2 * sn; x[1][n] = x1 * sn + x2 * cs; }
                }
#pragma unroll
                for (int bj = 0; bj < 2; ++bj)
#pragma unroll
                    for (int n = 0; n < 2; ++n) x[bj][n] = x[bj][n] * qs;
            }
#pragma unroll
            for (int bj = 0; bj < 2; ++bj) *(u32x4*)(dst + (size_t)r * ld + colb + 32 * bj + 8 * fq) = pk8(x[bj][0], x[bj][1]);
            if (m & 1) ROW_FENCE;
        }
    }
};

struct EpiG2 {
    const Frame& F;
    DI void operator()(Acc& acc, const Unit& u, int wr, int wc, int fr, int fq) const {
        unsigned char* ws = F.ws; const int row0 = u.pm * 256;
        const float* ss = (const float*)(ws + (u.job == 0 ? WS_SSKV : WS_SSQ));
        bf16_t* dst; int ld; float sc = 1.f;
        if (u.job == 0) { dst = (bf16_t*)(ws + (u.pn < 2 ? WS_KN : WS_VM)) + (u.pn & 1) * 256; ld = 512; }
        else { dst = (bf16_t*)(ws + WS_QM); ld = 768; sc = QS_MLA; }
        const bool ropet = (u.job == 1 && u.pn == 2);
        const bool rope = ropet && row0 < ML;
        const float* rm = (const float*)(ws + WS_ROPEM) + 4 * fq;
        int colv[2];
#pragma unroll
        for (int bj = 0; bj < 2; ++bj) {
            if (u.job == 0) colv[bj] = EPI_COL8(bj);
            else if (!ropet) { const int c = u.pn * 256 + EPI_COL8(bj); colv[bj] = (c >> 6) * 96 + (c & 63); }
            else { const int c = EPI_COL8(bj); colv[bj] = (c >> 5) * 96 + 64 + (c & 31); }
        }
        FOR_AI_M { const int r = row0 + EPI_ROWS(ai, m);
            const f32x4 s4 = *(const f32x4*)(ss + (size_t)r * 4);
            const float rstd = sc * __builtin_amdgcn_rsqf(((s4[0] + s4[1]) + (s4[2] + s4[3])) * (1.f / 256.f) + EPS);
            f32x4 cs = {1.f, 1.f, 1.f, 1.f}, sn = {0.f, 0.f, 0.f, 0.f};
            if (rope) { const float* rr = rm + (size_t)(r & 2047) * 32; cs = *(const f32x4*)rr; sn = *(const f32x4*)(rr + 16); }
#pragma unroll
            for (int bj = 0; bj < 2; ++bj) {
                const f32x4 x1 = acc[ai][bj][m][0] * rstd, x2 = acc[ai][bj][m][1] * rstd;
                f32x4 a = x1, b = x2;
                if (ropet) { a = x1 * cs - x2 * sn; b = x1 * sn + x2 * cs; }
                *(u32x4*)(dst + (size_t)r * ld + colv[bj]) = pk8(a, b);
            }
            ROW_FENCE;
        }
    }
};

struct EpiDft {
    bf16_t* dst; int zrows, ld;
    DI void operator()(Acc& acc, const Unit& u, int wr, int wc, int fr, int fq) const {
        FOR_AI_M { const int r = u.z * zrows + u.pm * 256 + EPI_ROWS(ai, m);
#pragma unroll
            for (int bj = 0; bj < 2; ++bj) *(u32x4*)(dst + (size_t)r * ld + u.pn * 256 + EPI_COL8(bj)) = pk8(acc[ai][bj][m][0], acc[ai][bj][m][1]); }
    }
};

struct EpiG3 {
    const Frame& F;
    DI void operator()(Acc& acc, const Unit& u, int wr, int wc, int fr, int fq) const {
        const bf16_t* gate = (const bf16_t*)(F.ws + WS_GATE); bf16_t* Y = (bf16_t*)(F.ws + WS_HB);
        const int row0 = u.pm * 256, col0 = u.pn * 256;
        const int s1 = u.seg < 2 ? u.seg + 1 : u.seg;
#pragma unroll
        for (int aim = 0; aim < 4; ++aim) { const int ai = aim >> 1, mb = (aim & 1) * 2;
            u32x4 ga[4][2], gb[4][2];
#pragma unroll
            for (int m = mb; m < mb + 2; ++m)
#pragma unroll
                for (int bj = 0; bj < 2; ++bj) { const size_t o = (size_t)(row0 + EPI_ROWS(ai, m)) * 3072 + col0 + EPI_COL8(bj);
                    ga[m][bj] = *(const u32x4*)(gate + o + u.seg * 1024); if (u.seg < 2) gb[m][bj] = *(const u32x4*)(gate + o + s1 * 1024); }
#pragma unroll
            for (int m = mb; m < mb + 2; ++m) { const int r = row0 + EPI_ROWS(ai, m);
#pragma unroll
                for (int bj = 0; bj < 2; ++bj) {
                    float g0[8]; unpk8(ga[m][bj], g0);
                    if (u.seg < 2) { float g1[8]; unpk8(gb[m][bj], g1);
#pragma unroll
                        for (int e = 0; e < 8; ++e) g0[e] = g0[e] * __builtin_amdgcn_rcpf(fmaxf(g1[e], 1e-20f)); }
#pragma unroll
                    for (int e = 0; e < 4; ++e) { acc[ai][bj][m][0][e] *= g0[e]; acc[ai][bj][m][1][e] *= g0[4 + e]; }
                    if (u.seg == 2) *(u32x4*)(Y + (size_t)r * 1024 + col0 + EPI_COL8(bj)) = pk8(acc[ai][bj][m][0], acc[ai][bj][m][1]);
                }
            }
            ROW_FENCE;
        }
    }
};

struct EpiRes {
    const Frame& F; int which; bool from_input;
    DI void operator()(Acc& acc, const Unit& u, int wr, int wc, int fr, int fq) const {
        const int row0 = u.pm * 256, col0 = u.pn * 256;
        const float* g = modp(F, F.l, modrow_of_tile(row0), which) + col0;
        f32x4 gv[2][2];
#pragma unroll
        for (int bj = 0; bj < 2; ++bj) { gv[bj][0] = *(const f32x4*)(g + EPI_COL8(bj)); gv[bj][1] = *(const f32x4*)(g + EPI_COL8(bj) + 4); }
        const float* xib = (from_input ? xin_ptr(F, row0) : xrow_ptr(F, row0)) + col0; float* xob = xrow_ptr(F, row0) + col0;
#pragma unroll
        for (int aim = 0; aim < 4; ++aim) { const int ai = aim >> 1, mb = (aim & 1) * 2;
            f32x4 xa[4][2][2];
#pragma unroll
            for (int m = mb; m < mb + 2; ++m)
#pragma unroll
                for (int bj = 0; bj < 2; ++bj) { const float* p = xib + (size_t)EPI_ROWS(ai, m) * D + EPI_COL8(bj); xa[m][bj][0] = *(const f32x4*)p; xa[m][bj][1] = *(const f32x4*)(p + 4); }
#pragma unroll
            for (int m = mb; m < mb + 2; ++m)
#pragma unroll
                for (int bj = 0; bj < 2; ++bj) { float* p = xob + (size_t)EPI_ROWS(ai, m) * D + EPI_COL8(bj);
                    *(f32x4*)p = xa[m][bj][0] * ALPHA + gv[bj][0] * acc[ai][bj][m][0]; *(f32x4*)(p + 4) = xa[m][bj][1] * ALPHA + gv[bj][1] * acc[ai][bj][m][1]; }
            ROW_FENCE;
        }
    }
};

struct EpiSlab {
    float* slab;
    DI void operator()(Acc& acc, const Unit& u, int wr, int wc, int fr, int fq) const {
        FOR_AI_M { const int r = u.z * MC + u.pm * 256 + EPI_ROWS(ai, m);
#pragma unroll
            for (int bj = 0; bj < 2; ++bj) { float* o = slab + (size_t)r * 1024 + u.pn * 256 + EPI_COL8(bj);
                *(f32x4*)o = acc[ai][bj][m][0]; *(f32x4*)(o + 4) = acc[ai][bj][m][1]; } }
    }
};

struct EpiW1 {
    const Frame& F;
    DI void operator()(Acc& acc, const Unit& u, int wr, int wc, int fr, int fq) const {
        bf16_t* U = (bf16_t*)(F.ws + WS_U);
        FOR_AI_M { const int r = u.pm * 256 + EPI_ROWS(ai, m);
#pragma unroll
            for (int bj = 0; bj < 2; ++bj) { f32x4 a = acc[ai][bj][m][0], b = acc[ai][bj][m][1];
#pragma unroll
                for (int e = 0; e < 4; ++e) { const float x = fmaxf(a[e], 0.f), y = fmaxf(b[e], 0.f); a[e] = x * x; b[e] = y * y; }
                *(u32x4*)(U + (size_t)r * DFF + u.pn * 256 + EPI_COL8(bj)) = pk8(a, b); } }
    }
};

#define MFMA32(a, b, c) __builtin_amdgcn_mfma_f32_32x32x16_bf16((a), (b), (c), 0, 0, 0)
constexpr int ATT_BUF = 22528;
constexpr int ATT_KR = 9216, ATT_V = 14336;
template <int KIND>
DI void attn_unit(const Frame& F, int qrow0, int head, int ctx_row0, int lat_row0, int ntiles) {
    constexpr int ND = KIND == 0 ? 6 : 4;
    unsigned char* ws = F.ws; LAS unsigned char* lds = F.lds;
    int tid_ = F.tid; asm volatile("" : "+v"(tid_));
    const int tid = tid_ & 511, lane = tid & 63, w = __builtin_amdgcn_readfirstlane(tid >> 6), r32 = lane & 31, h5 = lane >> 5;
    const bf16_t *Kp, *Vp, *Qp; bf16_t* Op; int ldk, ldq, ldo;
    if (KIND == 0) { Kp = (const bf16_t*)(ws + WS_KN) + head * 64; Vp = (const bf16_t*)(ws + WS_VM) + head * 64; ldk = 512; Qp = (const bf16_t*)(ws + WS_QM) + head * 96; ldq = 768;
                     Op = (bf16_t*)(ws + WS_AM) + head * 64; ldo = 512; }
    else { Kp = (const bf16_t*)(ws + WS_KG) + (head >> 2) * 64; Vp = (const bf16_t*)(ws + WS_VG) + (head >> 2) * 64; ldk = 128; Qp = (const bf16_t*)(ws + WS_QG) + head * 64; ldq = 512;
           Op = (bf16_t*)(ws + WS_QG) + head * 64; ldo = 512; }
    const bf16_t* Krp = (const bf16_t*)(ws + WS_KR);
    bf16x8 qf[ND];
    { const bf16_t* qr = Qp + (size_t)(qrow0 + 32 * w + r32) * ldq + 8 * h5;
#pragma unroll
      for (int ds = 0; ds < ND; ++ds) qf[ds] = *(const bf16x8*)(qr + 16 * ds); }
    const int skey = tid >> 3, sch = tid & 7;
    const int skey_r = (tid & 255) >> 2, sch_r = tid & 3;
    const unsigned kdst = skey * 144 + sch * 16;
    const unsigned vdst = ATT_V + (sch >> 2) * 4096 + skey * 64 + (sch & 3) * 16;
    const unsigned rdst = ATT_KR + skey_r * 80 + sch_r * 16;
    u32x4 kreg, vreg, rreg;
#define ATT_KEYROW(t) ((t) < 4 ? ctx_row0 + 64 * (t) : lat_row0 + 64 * ((t) - 4))
#define ATT_LOAD(t) do { const int kr_ = ATT_KEYROW(t); kreg = *(const u32x4*)(Kp + (size_t)(kr_ + skey) * ldk + sch * 8); vreg = *(const u32x4*)(Vp + (size_t)(kr_ + skey) * ldk + sch * 8); \
        if (KIND == 0 && tid < 256) rreg = *(const u32x4*)(Krp + (size_t)(kr_ + skey_r) * 32 + sch_r * 8); } while (0)
#define ATT_STORE(buf) do { LAS unsigned char* b_ = lds + (buf) * ATT_BUF; *(LAS u32x4*)(b_ + kdst) = kreg; *(LAS u32x4*)(b_ + vdst) = vreg; \
        if (KIND == 0 && tid < 256) *(LAS u32x4*)(b_ + rdst) = rreg; } while (0)
    const unsigned kbase = r32 * 144 + h5 * 16, rbase = ATT_KR + r32 * 80 + h5 * 16;
    const unsigned voff = ATT_V + (4 * h5 + ((lane & 15) >> 2)) * 64 + ((lane >> 4) & 1) * 32 + (lane & 3) * 8;
    float mref = 0.f, lsum = 0.f;
    f32x16 o0, o1;
#pragma unroll
    for (int i = 0; i < 16; ++i) { o0[i] = 0.f; o1[i] = 0.f; }
#define ATT_LOADK(t) do { const int kr_ = ATT_KEYROW(t); kreg = *(const u32x4*)(Kp + (size_t)(kr_ + skey) * ldk + sch * 8); \
        if (KIND == 0 && tid < 256) rreg = *(const u32x4*)(Krp + (size_t)(kr_ + skey_r) * 32 + sch_r * 8); } while (0)
#define ATT_LOADV(t) do { const int kr_ = ATT_KEYROW(t); vreg = *(const u32x4*)(Vp + (size_t)(kr_ + skey) * ldk + sch * 8); } while (0)
#define ATT_STOREK(buf) do { LAS unsigned char* b_ = lds + (buf) * ATT_BUF; *(LAS u32x4*)(b_ + kdst) = kreg; if (KIND == 0 && tid < 256) *(LAS u32x4*)(b_ + rdst) = rreg; } while (0)
#define ATT_STOREV(buf) do { LAS unsigned char* b_ = lds + (buf) * ATT_BUF; *(LAS u32x4*)(b_ + vdst) = vreg; } while (0)
#define ATT_KFRAG(buf) do { LAS unsigned char* kq_ = lds + (buf) * ATT_BUF; \
        _Pragma("unroll") for (int ds = 0; ds < ND; ++ds) { \
            const unsigned o_ = ds < 4 ? kbase + ds * 32 : rbase + (ds - 4) * 32; const unsigned p_ = ds < 4 ? 32 * 144 : 32 * 80; \
            kf[0][ds] = *(const LAS bf16x8*)(kq_ + o_); kf[1][ds] = *(const LAS bf16x8*)(kq_ + o_ + p_); } } while (0)
#define ATT_QKM(S0, S1, C) do { \
        _Pragma("unroll") for (int ds = 0; ds < ND; ++ds) { \
            if (ds == 0) { S0 = MFMA32(kf[0][0], qf[0], C); S1 = MFMA32(kf[1][0], qf[0], C); } else { S0 = MFMA32(kf[0][ds], qf[ds], S0); S1 = MFMA32(kf[1][ds], qf[ds], S1); } } } while (0)
#define ATT_VFRAG(dst, vb, kb) do { \
        _Pragma("unroll") for (int s = 0; s < 2; ++s) _Pragma("unroll") for (int db = 0; db < 2; ++db) { \
            const unsigned a_ = voff + db * 4096 + (32 * (kb) + 16 * s) * 64; \
            const s16x4 lo = __builtin_bit_cast(s16x4, __builtin_amdgcn_ds_read_tr16_b64_v4i16((LAS s16x4*)((vb) + a_))); \
            const s16x4 hi = __builtin_bit_cast(s16x4, __builtin_amdgcn_ds_read_tr16_b64_v4i16((LAS s16x4*)((vb) + a_ + 512))); \
            dst[s][db] = __builtin_shufflevector(lo, hi, 0, 1, 2, 3, 4, 5, 6, 7); } } while (0)
    bf16x8 kf[2][ND];
    f32x16 s0, s1, n0, n1, negm;
#pragma unroll
    for (int i = 0; i < 16; ++i) negm[i] = 0.f;
#define ATT_LOADK2(t, KR_, RR_) do { const int kr_ = ATT_KEYROW(t); KR_ = *(const u32x4*)(Kp + (size_t)(kr_ + skey) * ldk + sch * 8); \
        if (KIND == 0 && tid < 256) RR_ = *(const u32x4*)(Krp + (size_t)(kr_ + skey_r) * 32 + sch_r * 8); } while (0)
#define ATT_LOADV2(t, VR_) do { const int kr_ = ATT_KEYROW(t); VR_ = *(const u32x4*)(Vp + (size_t)(kr_ + skey) * ldk + sch * 8); } while (0)
#define ATT_STOREK2(buf, KR_, RR_) do { LAS unsigned char* b_ = lds + (buf) * ATT_BUF; *(LAS u32x4*)(b_ + kdst) = KR_; if (KIND == 0 && tid < 256) *(LAS u32x4*)(b_ + rdst) = RR_; } while (0)
#define ATT_STOREV2(buf, VR_) do { LAS unsigned char* b_ = lds + (buf) * ATT_BUF; *(LAS u32x4*)(b_ + vdst) = VR_; } while (0)
#define ATT_BODY(t, KS, VS, RS, KL, VL, RL, C0, C1, N0, N1) do { \
        const bool more = (t + 1 < ntiles), more2 = (t + 2 < ntiles); \
        if (t + 3 < ntiles) ATT_LOADK2(t + 3, KL, RL); \
        if (more2) ATT_LOADV2(t + 2, VL); \
        LAS unsigned char* kb_ = lds + (t & 1) * ATT_BUF; \
        bf16x8 va[2][2], vb2[2][2]; \
        if (more) ATT_KFRAG((t + 1) & 1); \
        __builtin_amdgcn_sched_barrier(0); \
        if (more) { f32x16 ng_; _Pragma("unroll") for (int i = 0; i < 16; ++i) ng_[i] = -mref; ATT_QKM(N0, N1, ng_); } \
        float psa = 0.f, psb = 0.f; \
        _Pragma("unroll") for (int i = 0; i < 16; ++i) { C0[i] = __builtin_amdgcn_exp2f(C0[i]); C1[i] = __builtin_amdgcn_exp2f(C1[i]); psa += C0[i]; psb += C1[i]; } \
        psa += psb; \
        if (__builtin_expect(__any(psa > BIGP), 0)) { \
            float mx = fmaxf(C0[0], C1[0]); \
            _Pragma("unroll") for (int i = 1; i < 16; ++i) mx = fmaxf(mx, fmaxf(C0[i], C1[i])); \
            { auto rr = __builtin_amdgcn_permlane32_swap(__float_as_uint(mx), __float_as_uint(mx), false, false); mx = fmaxf(__uint_as_float(rr[0]), __uint_as_float(rr[1])); } \
            const float dl = mx > 1.f ? ceilf(__log2f(mx)) : 0.f; const float f = __builtin_amdgcn_exp2f(-dl); \
            mref += dl; lsum *= f; psa *= f; \
            _Pragma("unroll") for (int i = 0; i < 16; ++i) { C0[i] *= f; C1[i] *= f; o0[i] *= f; o1[i] *= f; N0[i] -= dl; N1[i] -= dl; } \
        } \
        lsum += psa; \
        bf16x8 pf[2][2]; \
        _Pragma("unroll") for (int s = 0; s < 2; ++s) { \
            u32x4 a, b; \
            a.x = pk2(C0[8 * s + 0], C0[8 * s + 1]); a.y = pk2(C0[8 * s + 2], C0[8 * s + 3]); a.z = pk2(C0[8 * s + 4], C0[8 * s + 5]); a.w = pk2(C0[8 * s + 6], C0[8 * s + 7]); \
            b.x = pk2(C1[8 * s + 0], C1[8 * s + 1]); b.y = pk2(C1[8 * s + 2], C1[8 * s + 3]); b.z = pk2(C1[8 * s + 4], C1[8 * s + 5]); b.w = pk2(C1[8 * s + 6], C1[8 * s + 7]); \
            pf[0][s] = __builtin_bit_cast(bf16x8, a); pf[1][s] = __builtin_bit_cast(bf16x8, b); \
        } \
        ATT_VFRAG(va, kb_, 0); ATT_VFRAG(vb2, kb_, 1); \
        _Pragma("unroll") for (int s = 0; s < 2; ++s) { o0 = MFMA32(va[s][0], pf[0][s], o0); o1 = MFMA32(va[s][1], pf[0][s], o1); } \
        _Pragma("unroll") for (int s = 0; s < 2; ++s) { o0 = MFMA32(vb2[s][0], pf[1][s], o0); o1 = MFMA32(vb2[s][1], pf[1][s], o1); } \
        __builtin_amdgcn_sched_barrier(0); \
        if (more2) ATT_STOREK2(t & 1, KS, RS); \
        if (more) ATT_STOREV2((t + 1) & 1, VS); \
        asm volatile("s_waitcnt lgkmcnt(0)\n\ts_barrier" ::: "memory"); \
    } while (0)
    constexpr float BIGP = 65536.f;
    u32x4 kreg2, vreg2, rreg2;
    ATT_LOADK(0); ATT_LOADV(0); ATT_STOREK(0); ATT_STOREV(0);
    ATT_LOADK(1); ATT_STOREK(1);
    __syncthreads();
    ATT_LOADK2(2, kreg, rreg); ATT_LOADV2(1, vreg);
    ATT_KFRAG(0); ATT_QKM(s0, s1, negm);
    {
        float mx = fmaxf(s0[0], s1[0]);
#pragma unroll
        for (int i = 1; i < 16; ++i) mx = fmaxf(mx, fmaxf(s0[i], s1[i]));
        { auto rr = __builtin_amdgcn_permlane32_swap(__float_as_uint(mx), __float_as_uint(mx), false, false); mx = fmaxf(__uint_as_float(rr[0]), __uint_as_float(rr[1])); }
        mref = mx;
#pragma unroll
        for (int i = 0; i < 16; ++i) { s0[i] -= mx; s1[i] -= mx; }
    }
    for (int t2 = 0; t2 < ntiles; t2 += 2) {
        { const int t = t2; ATT_BODY(t, kreg, vreg, rreg, kreg2, vreg2, rreg2, s0, s1, n0, n1); }
        { const int t = t2 + 1; ATT_BODY(t, kreg2, vreg2, rreg2, kreg, vreg, rreg, n0, n1, s0, s1); }
    }
    { auto rr = __builtin_amdgcn_permlane32_swap(__float_as_uint(lsum), __float_as_uint(lsum), false, false); lsum = __uint_as_float(rr[0]) + __uint_as_float(rr[1]); }
    const float inv = 1.f / lsum;
    {
        LAS unsigned char* stg = lds + 49152 + w * 4608;
        LAS unsigned char* mine = stg + r32 * 144 + 8 * h5;
#pragma unroll
        for (int g = 0; g < 4; ++g) {
            u32x2 a, b;
            a.x = pk2(o0[4 * g] * inv, o0[4 * g + 1] * inv); a.y = pk2(o0[4 * g + 2] * inv, o0[4 * g + 3] * inv);
            b.x = pk2(o1[4 * g] * inv, o1[4 * g + 1] * inv); b.y = pk2(o1[4 * g + 2] * inv, o1[4 * g + 3] * inv);
            *(LAS u32x2*)(mine + 16 * g) = a; *(LAS u32x2*)(mine + 64 + 16 * g) = b;
        }
        asm volatile("s_waitcnt lgkmcnt(0)" ::: "memory");
        bf16_t* ob = Op + (size_t)(qrow0 + 32 * w) * ldo;
#pragma unroll
        for (int it = 0; it < 4; ++it) { const int row = it * 8 + (lane >> 3), ch = lane & 7;
            const u32x4 v = *(const LAS u32x4*)(stg + row * 144 + ch * 16);
            *(u32x4*)(ob + (size_t)row * ldo + ch * 8) = v; }
    }
#undef ATT_LOADK
#undef ATT_LOADV
#undef ATT_STOREK
#undef ATT_STOREV
#undef ATT_KFRAG
#undef ATT_BODY
#undef ATT_LOADK2
#undef ATT_LOADV2
#undef ATT_STOREK2
#undef ATT_STOREV2
#undef ATT_QKM
#undef ATT_VFRAG
#undef ATT_KEYROW
#undef ATT_LOAD
#undef ATT_STORE
}

DI void wave_sum2(float& a, float& b, int lane) {
#pragma unroll
    for (int o = 1; o < 64; o <<= 1) { const float ta = shx(a, o, lane), tb = shx(b, o, lane); a += ta; b += tb; }
}
DI void ln_row_v(const Frame& F, f32x4 (&v)[4], float* xout, const float* g, const float* b, const float* sh, const float* sc, bf16_t* hout, const float* slab, const float* gres) {
    if (slab) {
#pragma unroll
        for (int j = 0; j < 4; ++j) { f32x4 a = ((const f32x4*)slab)[F.lane + 64 * j];
#pragma unroll
            for (int z = 1; z < 8; ++z) a += ((const f32x4*)(slab + (size_t)z * MC * 1024))[F.lane + 64 * j];
            v[j] = v[j] * ALPHA + ((const f32x4*)gres)[F.lane + 64 * j] * a; }
    }
    if (g) {
        float s = 0.f, s2 = 0.f;
#pragma unroll
        for (int j = 0; j < 4; ++j) { s += (v[j][0] + v[j][1]) + (v[j][2] + v[j][3]); s2 += (v[j][0] * v[j][0] + v[j][1] * v[j][1]) + (v[j][2] * v[j][2] + v[j][3] * v[j][3]); }
        wave_sum2(s, s2, F.lane);
        const float mean = s * (1.f / D); const float rstd = 1.f / sqrtf(fmaxf(s2 * (1.f / D) - mean * mean, 0.f) + EPS);
#pragma unroll
        for (int j = 0; j < 4; ++j) { const f32x4 gg = ((const f32x4*)g)[F.lane + 64 * j], bb = ((const f32x4*)b)[F.lane + 64 * j];
            v[j] = (v[j] - mean) * rstd * gg + bb; ((f32x4*)xout)[F.lane + 64 * j] = v[j]; }
    }
    if (hout) {
        float s = 0.f, s2 = 0.f;
#pragma unroll
        for (int j = 0; j < 4; ++j) { s += (v[j][0] + v[j][1]) + (v[j][2] + v[j][3]); s2 += (v[j][0] * v[j][0] + v[j][1] * v[j][1]) + (v[j][2] * v[j][2] + v[j][3] * v[j][3]); }
        wave_sum2(s, s2, F.lane);
        const float mean = s * (1.f / D); const float rstd = 1.f / sqrtf(fmaxf(s2 * (1.f / D) - mean * mean, 0.f) + EPS);
#pragma unroll
        for (int j = 0; j < 4; ++j) { const f32x4 hh = ((const f32x4*)sh)[F.lane + 64 * j], cc = ((const f32x4*)sc)[F.lane + 64 * j];
            const f32x4 o = (v[j] - mean) * rstd * (cc + 1.f) + hh; u32x2 wv; wv.x = pk2(o[0], o[1]); wv.y = pk2(o[2], o[3]);
            ((u32x2*)hout)[F.lane + 64 * j] = wv; }
    }
}
DI void ln_load(const Frame& F, const float* xin, f32x4 (&v)[4]) {
    const f32x4* xr = (const f32x4*)xin + F.lane;
#pragma unroll
    for (int j = 0; j < 4; ++j) v[j] = xr[64 * j];
}
DI void ln_row(const Frame& F, const float* xin, float* xout, const float* g, const float* b, const float* sh, const float* sc, bf16_t* hout, const float* slab = nullptr, const float* gres = nullptr) {
    f32x4 v[4]; ln_load(F, xin, v);
    ln_row_v(F, v, xout, g, b, sh, sc, hout, slab, gres);
}

DI int srcmap(int kind, int n) {
    switch (kind) {
    case 0: {
        if (n < 256) return n;
        if (n < 512) return 1056 + (n - 256);
        if (n < 768) { const int c = n - 512, slot = (c & 127) >> 5, d = 32 * (c >> 7) + (c & 31); return slot < 2 ? 288 + slot * 64 + d : 416 + (slot - 2) * 64 + d; }
        if (n < 1280) { const int t = (n - 768) >> 8, c = (n - 768) & 255, slot = (c & 127) >> 5, d = 32 * (c >> 7) + (c & 31); return 1312 + (4 * t + slot) * 64 + d; }
        return 1824 + (n - 1280); }
    case 1: { const int half = (n & 7) >> 2, i = 4 * (n >> 3) + (n & 3); return 256 + half * 16 + i; }
    case 2: {
        if (n < 512) return (n >> 6) * 96 + (n & 63);
        const int c = n - 512, hd = c >> 5, j = c & 31, half = (j & 7) >> 2, i = 4 * (j >> 3) + (j & 3); return hd * 96 + 64 + half * 16 + i; }
    default: return n;
    }
}
DI void conv_item(const float* W, int K, int ld, int kind, const float* gain, bf16_t* WT, int item, int nblk, LAS float* scr, int lane) {
    const int kb = item / nblk, nb = item % nblk, k0 = 64 * kb, n0 = 32 * nb;
    const int sc_ = srcmap(kind, n0 + (lane & 31));
    float wv[32];
#pragma unroll
    for (int i = 0; i < 32; ++i) wv[i] = W[(size_t)(k0 + 2 * i + (lane >> 5)) * ld + sc_];
    if (gain) {
#pragma unroll
        for (int i = 0; i < 32; ++i) wv[i] *= gain[k0 + 2 * i + (lane >> 5)];
    }
#pragma unroll
    for (int i = 0; i < 32; ++i) scr[(2 * i + (lane >> 5)) * 33 + (lane & 31)] = wv[i];
    asm volatile("s_waitcnt lgkmcnt(0)" ::: "memory");
    const int c = lane & 7;
#pragma unroll
    for (int j = 0; j < 4; ++j) { const int n = (lane >> 3) + 8 * j; const LAS float* s = scr + (8 * c) * 33 + n;
        u32x4 o; o.x = pk2(s[0 * 33], s[1 * 33]); o.y = pk2(s[2 * 33], s[3 * 33]); o.z = pk2(s[4 * 33], s[5 * 33]); o.w = pk2(s[6 * 33], s[7 * 33]);
        *(u32x4*)(WT + (size_t)(n0 + n) * K + k0 + 8 * c) = o; }
    asm volatile("s_waitcnt lgkmcnt(0)" ::: "memory");
}
template <int Q0, int Q1>
DI void convert_weights(const Frame& F, int l, int crank, int ncu) {
    LAS float* scr = (LAS float*)(F.lds + F.wave * 16384);
    unsigned char* W = F.ws + WS_W;
    const int gw = crank * 8 + F.wave, NGW = ncu * 8;
    const float* w_in = pin(F, I_WIN) + (size_t)l * D * INC;
    struct It { const float* src; int K, ld, kind, N; const float* gain; size_t dst; };
    const It its[11] = {
        {w_in, 1024, INC, 0, NIN, nullptr, W_IN},
        {w_in, 1024, INC, 1, 32, nullptr, W_KR},
        {pin(F, I_WUK) + (size_t)l * 256 * 512, 256, 512, 9, 512, pin(F, I_MKVG) + l * 256, W_UKV},
        {pin(F, I_WUV) + (size_t)l * 256 * 512, 256, 512, 9, 512, pin(F, I_MKVG) + l * 256, W_UKV + 512 * 256 * 2},
        {pin(F, I_WUQ) + (size_t)l * 256 * 768, 256, 768, 2, 768, pin(F, I_MQG) + l * 256, W_UQ},
        {pin(F, I_WFO) + (size_t)l * 512 * 1024, 512, 1024, 9, 1024, nullptr, W_FO},
        {pin(F, I_WMO) + (size_t)l * 512 * 1024, 512, 1024, 9, 1024, nullptr, W_MO},
        {pin(F, I_WGO) + (size_t)l * 512 * 1024, 512, 1024, 9, 1024, nullptr, W_GO},
        {pin(F, I_WO) + (size_t)l * 1024 * 1024, 1024, 1024, 9, 1024, nullptr, W_O},
        {pin(F, I_W1) + (size_t)l * 1024 * 4096, 1024, 4096, 9, 4096, nullptr, W_1},
        {pin(F, I_W2) + (size_t)l * 4096 * 1024, 4096, 1024, 9, 1024, nullptr, W_2}};
    int base = 0;
#pragma unroll
    for (int q = Q0; q < Q1; ++q) {
        const int nblk = its[q].N / 32, nit = (its[q].K / 64) * nblk;
        int first = (gw - base) % NGW; if (first < 0) first += NGW;
        for (int it = first; it < nit; it += NGW) conv_item(its[q].src, its[q].K, its[q].ld, its[q].kind, its[q].gain, (bf16_t*)(W + its[q].dst), it, nblk, scr, F.lane);
        base = (base + nit) % NGW;
    }
}
DI void fold_fourier(const Frame& F, int l, int crank, int ncu) {
    __syncthreads();
    LAS float* u = (LAS float*)F.lds;
    LAS float* T = (LAS float*)(F.lds + 32768);
    if (F.tid < 128) T[F.tid] = cospif((float)F.tid * (1.f / 64.f));
    const float* w_in = pin(F, I_WIN) + (size_t)l * D * INC;
    bf16_t* WT = (bf16_t*)(F.ws + WS_W + W_T);
    for (int item = crank; item < 256; item += ncu) {
        const int g = item >> 6, k0 = (item & 63) * 16;
        __syncthreads();
        for (int e = F.tid; e < 16 * 128; e += 512) { const int kk = e >> 7, c = e & 127; u[kk * 129 + c] = w_in[(size_t)(k0 + kk) * INC + 544 + g * 128 + c]; }
        __syncthreads();
        const int kk = F.tid & 15, grp = F.tid >> 4;
        float a[8];
#pragma unroll
        for (int o = 0; o < 8; ++o) a[o] = 0.f;
        for (int c = 0; c < 128; ++c) { const float uv = u[kk * 129 + c];
#pragma unroll
            for (int o = 0; o < 8; ++o) { const int mcs = grp * 8 + o, mm = mcs >> 1, cs = mcs & 1; a[o] += uv * T[(mm * c - 32 * cs) & 127]; } }
#pragma unroll
        for (int o = 0; o < 8; ++o) { const int mcs = grp * 8 + o; unsigned short hv = (unsigned short)(pk2(a[o], 0.f) & 0xffffu); WT[(size_t)(g * 256 + mcs) * 1024 + k0 + kk] = hv; }
    }
    __syncthreads();
}
DI void krope_phase(const Frame& F, int crank, int ncu) {
    const bf16_t* H = (const bf16_t*)(F.ws + WS_HB); const bf16_t* Wk = (const bf16_t*)(F.ws + WS_W + W_KR); bf16_t* KR = (bf16_t*)(F.ws + WS_KR);
    const float* rm = (const float*)(F.ws + WS_ROPEM);
    const int r32 = F.lane & 31, h5 = F.lane >> 5, w = F.wave;
    LAS float* part = (LAS float*)F.lds;
    for (int it = crank; it < MT / 32; it += ncu) {
        const int row0 = it * 32;
        f32x16 acc;
#pragma unroll
        for (int i = 0; i < 16; ++i) acc[i] = 0.f;
        const bf16_t* hp = H + (size_t)(row0 + r32) * 1024 + 8 * h5 + 128 * w; const bf16_t* wp = Wk + (size_t)r32 * 1024 + 8 * h5 + 128 * w;
        bf16x8 a[8], b[8];
#pragma unroll
        for (int q = 0; q < 8; ++q) { a[q] = *(const bf16x8*)(wp + 16 * q); b[q] = *(const bf16x8*)(hp + 16 * q); }
#pragma unroll
        for (int q = 0; q < 8; ++q) acc = MFMA32(a[q], b[q], acc);
        __syncthreads();
#pragma unroll
        for (int i = 0; i < 16; ++i) part[(w * 16 + i) * 64 + F.lane] = acc[i];
        __syncthreads();
        if (w == 0) {
#pragma unroll
            for (int i = 0; i < 16; ++i) { float sacc = 0.f;
#pragma unroll
                for (int q = 0; q < 8; ++q) sacc += part[(q * 16 + i) * 64 + F.lane];
                acc[i] = sacc; }
            const int row = row0 + r32;
            f32x16 oth;
#pragma unroll
            for (int i = 0; i < 16; ++i) oth[i] = shx(acc[i], 32, F.lane);
            u32x2 wv[4];
#pragma unroll
            for (int g = 0; g < 4; ++g) { float o[4];
#pragma unroll
                for (int e = 0; e < 4; ++e) { const int i = 4 * g + e; float x1 = h5 ? oth[i] : acc[i], x2 = h5 ? acc[i] : oth[i]; float cs = 1.f, sn = 0.f;
                    if (row < ML) { cs = rm[(size_t)(row & 2047) * 32 + i]; sn = rm[(size_t)(row & 2047) * 32 + 16 + i]; }
                    o[e] = h5 ? (x1 * sn + x2 * cs) : (x1 * cs - x2 * sn); }
                wv[g].x = pk2(o[0], o[1]); wv[g].y = pk2(o[2], o[3]); }
#pragma unroll
            for (int g = 0; g < 4; ++g) *(u32x2*)(KR + (size_t)row * 32 + 8 * g + 4 * h5) = wv[g];
        }
    }
    __syncthreads();
}

DI void prologue_a(const Frame& F) {
    unsigned char* ws = F.ws;
    convert_weights<0, 5>(F, 0, F.vcu, F.G);
    fold_fourier(F, 0, F.bid, F.G);
    { const int gt = F.bid * 512 + F.tid, NT = F.G * 512;
      float* rm = (float*)(ws + WS_ROPEM); float* rg = (float*)(ws + WS_ROPEG);
      for (int e = gt; e < 2048 * 16; e += NT) { const int pos = e >> 4, i = e & 15; const float fr_ = powf(10000.f, -(float)(i & 7) / 8.f); const float p_ = (i < 8) ? (float)(pos >> 6) : (float)(pos & 63);
          float sn, cs; sincosf(p_ * fr_, &sn, &cs); rm[pos * 32 + i] = cs; rm[pos * 32 + 16 + i] = sn; }
      for (int e = gt; e < 2048 * 32; e += NT) { const int pos = e >> 5, i = e & 31; const float fr_ = powf(10000.f, -(float)(i & 15) / 16.f); const float p_ = (i < 16) ? (float)(pos >> 6) : (float)(pos & 63);
          float sn, cs; sincosf(p_ * fr_, &sn, &cs); rg[pos * 64 + i] = cs; rg[pos * 64 + 32 + i] = sn; }
      bf16_t* dm = (bf16_t*)(ws + WS_DFTM);
      for (int e = gt; e < 2048 * 1024; e += NT) { const int k = e >> 10, j2 = (e & 1023) * 2; unsigned wv[2];
#pragma unroll
          for (int q = 0; q < 2; ++q) { const int j = j2 + q * 2048; float v0, v1; { const int jj = j & 2047; const float a0 = (float)((k * jj) & 2047) * (1.f / 1024.f), a1 = (float)((k * (jj + 1)) & 2047) * (1.f / 1024.f);
              if (j < 2048) { v0 = cospif(a0); v1 = cospif(a1); } else { v0 = -sinpif(a0); v1 = -sinpif(a1); } }
              wv[q] = pk2(v0 * (1.f / 512.f), v1 * (1.f / 512.f)); }
          *(unsigned*)(dm + (size_t)k * 4096 + j2) = wv[0]; *(unsigned*)(dm + (size_t)k * 4096 + 2048 + j2) = wv[1]; }
      bf16_t* dc = (bf16_t*)(ws + WS_DFTMC); const float sc = 0.005524271728019903f;
      for (int e = gt; e < 256 * 512; e += NT) { const int k = e >> 9, j = e & 511, jj = j & 255; const float a0 = (float)((k * jj) & 255) * (1.f / 128.f);
          const float v = (j < 256) ? cospif(a0) : -sinpif(a0); dc[e] = (unsigned short)(pk2(v * sc, 0.f) & 0xffffu); }
    }
    { __syncthreads();
      LAS float* sl = (LAS float*)F.lds;
      LAS float* red = (LAS float*)(F.lds + 36864);
      for (int e = F.tid; e < 9 * 1024; e += 512) { const int r = e >> 10, k = e & 1023; const float c = r < 8 ? pin(F, I_C)[r * 1024 + k] : pin(F, I_CCTX)[k]; sl[e] = c / (1.f + __expf(-c)); }
      __syncthreads();
      const int col = F.tid & 63, kg = F.tid >> 6;
      for (int item = F.bid; item < 4 * 96; item += F.G) {
          const int l = item / 96, cb = (item % 96) * 64;
          const float* wa = pin(F, I_WADA) + (size_t)l * 1024 * 6144 + cb + col;
          float a[9];
#pragma unroll
          for (int r = 0; r < 9; ++r) a[r] = 0.f;
          for (int k0 = kg * 128; k0 < kg * 128 + 128; k0 += 32) { float wv[32];
#pragma unroll
              for (int q = 0; q < 32; ++q) wv[q] = wa[(size_t)(k0 + q) * 6144];
#pragma unroll
              for (int q = 0; q < 32; ++q)
#pragma unroll
                  for (int r = 0; r < 9; ++r) a[r] += sl[r * 1024 + k0 + q] * wv[q]; }
#pragma unroll
          for (int r = 0; r < 9; ++r) red[(kg * 9 + r) * 64 + col] = a[r];
          __syncthreads();
          for (int e = F.tid; e < 9 * 64; e += 512) { const int r = e >> 6, c2 = e & 63; float s = pin(F, I_BADA)[l * 6144 + cb + c2];
#pragma unroll
              for (int q = 0; q < 8; ++q) s += red[(q * 9 + r) * 64 + c2];
              ((float*)(ws + WS_MOD))[(size_t)(l * 9 + r) * 6144 + cb + c2] = s; }
          __syncthreads();
      }
    }
}
DI void prologue_b(const Frame& F) {
    const int gw = F.vcu * 8 + F.wave, NGW = F.G * 8;
    bf16_t* H = (bf16_t*)(F.ws + WS_HB);
    f32x4 vc[4], vn[4];
    if (gw < MT) ln_load(F, gw < ML ? pin(F, I_X) + (size_t)gw * D : pin(F, I_CTX) + (size_t)(gw - ML) * D, vc);
    for (int row = gw; row < MT; row += NGW) {
        const int nr = row + NGW;
        if (nr < MT) ln_load(F, nr < ML ? pin(F, I_X) + (size_t)nr * D : pin(F, I_CTX) + (size_t)(nr - ML) * D, vn);
        const int mr = row < ML ? (row >> 11) : 8;
        ln_row_v(F, vc, nullptr, nullptr, nullptr, modp(F, 0, mr, 0), modp(F, 0, mr, 1), H + (size_t)row * D, nullptr, nullptr);
#pragma unroll
        for (int j = 0; j < 4; ++j) vc[j] = vn[j];
    }
}
DI void ln_phase(const Frame& F, int which) {
    const int gw = F.vcu * 8 + F.wave, NGW = F.G * 8; const int l = F.l;
    const int nrows = (l == NL - 1) ? ML : MT;
    bf16_t* H = (bf16_t*)(F.ws + WS_HB);
    const float* g = pin(F, which == 0 ? I_LN1G : I_LN2G) + l * 1024; const float* b = pin(F, which == 0 ? I_LN1B : I_LN2B) + l * 1024;
    const bool wh = !(which == 1 && l == NL - 1);
    f32x4 vc[4], vn[4];
    if (gw < nrows) ln_load(F, xrow_ptr(F, gw), vc);
    for (int row = gw; row < nrows; row += NGW) {
        if (row + NGW < nrows) ln_load(F, xrow_ptr(F, row + NGW), vn);
        const int mr = row < ML ? (row >> 11) : 8;
        const float* sh = which == 0 ? modp(F, l, mr, 3) : modp(F, l + 1 < NL ? l + 1 : l, mr, 0);
        const float* sc = which == 0 ? modp(F, l, mr, 4) : modp(F, l + 1 < NL ? l + 1 : l, mr, 1);
        const bool sl = (which == 1 && row >= ML);
        ln_row_v(F, vc, xrow_ptr(F, row), g, b, sh, sc, wh ? H + (size_t)row * D : nullptr, sl ? (const float*)(F.ws + WS_KN) + (size_t)(row - ML) * 1024 : nullptr, modp(F, l, mr, 5));
#pragma unroll
        for (int j = 0; j < 4; ++j) vc[j] = vn[j];
    }
}

DI void phase_g1(const Frame& F) {
    const unsigned char* W = F.ws + WS_W; const char* H = (const char*)(F.ws + WS_HB);
    pg8::Sched2 S; S.tileBytes = 256L * 1024 * 2; S.G = F.G; S.c = F.bid;
    S.j0 = pg8::JobD{H, (const char*)(W + W_IN), MT / 256, NIN / 256, 1, 0, 0};
    S.j1 = pg8::JobD{(const char*)(W + W_T), H, 4, MT / 256, 1, 0, 0};
    S.n0 = (MT / 256) * (NIN / 256); S.total = S.n0 + 4 * (MT / 256);
    krope_phase(F, F.bid, F.G);
    EpiG1 E{F};
    pg8::gemm_phase(F.lds, 1024, S, E, F.tid);
}
DI void phase_g2(const Frame& F) {
    const unsigned char* W = F.ws + WS_W;
    pg8::Sched2 S; S.tileBytes = 256L * 256 * 2; S.G = F.G; S.c = F.bid;
    S.j0 = pg8::JobD{(const char*)(F.ws + WS_CKV), (const char*)(W + W_UKV), MT / 256, 4, 1, 0, 0};
    S.j1 = pg8::JobD{(const char*)(F.ws + WS_CQ), (const char*)(W + W_UQ), MT / 256, 3, 1, 0, 0};
    S.n0 = (MT / 256) * 4; S.total = S.n0 + (MT / 256) * 3;
    EpiG2 E{F};
    pg8::gemm_phase(F.lds, 256, S, E, F.tid);
}
DI void phase_att(const Frame& F) {
    const bool lastl = (F.l == NL - 1);
    const int nun = (!lastl && F.vcu < 128) ? 5 : 4;
#pragma unroll 1
    for (int i = 0; i < nun; ++i) {
        int kind, b, h, q0, nt;
        if (i < 4) { const int idx = (i >> 1) * 256 + F.vcu; kind = i & 1; b = idx >> 6; h = (idx >> 3) & 7; q0 = b * SEQ + (idx & 7) * 256; nt = 36; }
        else { const int idx = F.vcu >> 1; kind = F.vcu & 1; b = idx >> 3; h = idx & 7; q0 = ML + b * CTXL; nt = 4; }
        if (kind == 0) attn_unit<0>(F, q0, h, ML + b * CTXL, b * SEQ, nt);
        else attn_unit<1>(F, q0, h, ML + b * CTXL, b * SEQ, nt);
    }
    __syncthreads();
#ifndef NO_DFT
    {
        pg8::Sched2 S; S.tileBytes = 256L * 4096 * 2; S.G = F.G; S.c = (F.bid + 128) & 255;
        S.j0 = pg8::JobD{(const char*)(F.ws + WS_DFTM), (const char*)(F.ws + WS_TF), 8, 2, 8, 0, 1024L * 2048 * 2}; S.j1 = S.j0;
        S.n0 = 128; S.total = 128;
        EpiDft E{(bf16_t*)(F.ws + WS_F), 2048, 512};
        pg8::gemm_phase(F.lds, 4096, S, E, F.tid);
#ifdef PROBE_DFT
        pg8::gemm_phase(F.lds, 4096, S, E, F.tid);
#endif
    }
    if (!lastl) {
        pg8::Sched2 S; S.tileBytes = 256L * 512 * 2; S.G = F.G; S.c = F.bid;
        S.j0 = pg8::JobD{(const char*)(F.ws + WS_DFTMC), (const char*)(F.ws + WS_TFC), 1, 2, 8, 0, 1024L * 256 * 2}; S.j1 = S.j0;
        S.n0 = 16; S.total = 16;
        EpiDft E{(bf16_t*)(F.ws + WS_F) + (size_t)ML * 512, 256, 512};
        pg8::gemm_phase(F.lds, 512, S, E, F.tid);
    }
#endif
    if (F.bid < 128) {
        __syncthreads();
        const int cr = (F.bid & 7) * 16 + (F.bid >> 3);
        convert_weights<5, 11>(F, F.l, cr, 128);
    }
}
DI void phase_g3(const Frame& F) {
    const unsigned char* W = F.ws + WS_W; const int nM = (F.l == NL - 1 ? ML : MT) / 256;
    pg8::Sched3 S; S.tileBytes = 256L * 512 * 2; S.G = F.G; S.c = F.bid; S.ntiles = nM * 4;
    S.j = pg8::JobD{(const char*)(F.ws + WS_F), (const char*)(W + W_FO), nM, 4, 1, 0, 0};
    S.A1 = (const char*)(F.ws + WS_AM); S.B1 = (const char*)(W + W_MO); S.A2 = (const char*)(F.ws + WS_QG); S.B2 = (const char*)(W + W_GO);
    EpiG3 E{F};
    pg8::gemm_phase(F.lds, 512, S, E, F.tid);
    if (F.l + 1 < NL && F.bid >= 32) {
        __syncthreads();
        convert_weights<0, 5>(F, F.l + 1, F.bid - 32, F.G - 32); fold_fourier(F, F.l + 1, F.bid - 32, F.G - 32);
    }
}
DI void phase_g4(const Frame& F) {
    const unsigned char* W = F.ws + WS_W; const int nM = (F.l == NL - 1 ? ML : MT) / 256;
    pg8::Sched2 S; S.tileBytes = 256L * 1024 * 2; S.G = F.G; S.c = F.bid;
    S.j0 = pg8::JobD{(const char*)(F.ws + WS_HB), (const char*)(W + W_O), nM, 4, 1, 0, 0}; S.j1 = S.j0; S.n0 = nM * 4; S.total = S.n0;
    EpiRes E{F, 2, true};
    pg8::gemm_phase(F.lds, 1024, S, E, F.tid);
}
DI void phase_g5(const Frame& F) {
    const unsigned char* W = F.ws + WS_W; const int nM = (F.l == NL - 1 ? ML : MT) / 256;
    pg8::Sched2 S; S.tileBytes = 256L * 1024 * 2; S.G = F.G; S.c = F.bid;
    S.j0 = pg8::JobD{(const char*)(F.ws + WS_HB), (const char*)(W + W_1), nM, 16, 1, 0, 0}; S.j1 = S.j0; S.n0 = nM * 16; S.total = S.n0;
    EpiW1 E{F};
    pg8::gemm_phase(F.lds, 1024, S, E, F.tid);
#ifdef PROBE_G5
    pg8::gemm_phase(F.lds, 1024, S, E, F.tid);
#endif
}
DI void phase_g6(const Frame& F) {
    const unsigned char* W = F.ws + WS_W;
    {
        pg8::Sched2 S; S.tileBytes = 256L * 4096 * 2; S.G = F.G; S.c = F.bid;
        S.j0 = pg8::JobD{(const char*)(F.ws + WS_U), (const char*)(W + W_2), ML / 256, 4, 1, 0, 0}; S.j1 = S.j0; S.n0 = (ML / 256) * 4; S.total = S.n0;
        EpiRes E{F, 5, false};
        pg8::gemm_phase(F.lds, 4096, S, E, F.tid);
    }
    if (F.l < NL - 1) {
        pg8::Sched2 S; S.tileBytes = 256L * 4096 * 2; S.G = F.G; S.c = F.bid;
        S.j0 = pg8::JobD{(const char*)(F.ws + WS_U) + (size_t)ML * 4096 * 2, (const char*)(W + W_2), MC / 256, 4, 8, 512 * 2, 512 * 2}; S.j1 = S.j0; S.n0 = (MC / 256) * 4 * 8; S.total = S.n0;
        EpiSlab E{(float*)(F.ws + WS_KN)};
        pg8::gemm_phase<4096>(F.lds, 512, S, E, F.tid);
    }
}

constexpr int N_PHASES = 2 + 9 * NL;
template <int ONLY>
__global__ void __launch_bounds__(512, 2) fwd_kernel(Params prm) {
    extern __shared__ __attribute__((aligned(16))) unsigned char lds_raw[];
    Frame F;
    F.P = &prm; F.ws = prm.ws; F.lds = (LAS unsigned char*)lds_raw;
    F.tid = threadIdx.x; F.lane = F.tid & 63; F.wave = __builtin_amdgcn_readfirstlane(F.tid >> 6);
    F.G = gridDim.x; F.bid = blockIdx.x; F.vcu = (F.G % 8 == 0) ? (F.bid % 8) * (F.G / 8) + F.bid / 8 : F.bid; F.l = 0;
    volatile LAS unsigned* MISC = (volatile LAS unsigned*)(F.lds + MISC_OFF);
    for (int u = F.tid; u < (LDS_BYTES - RING_BYTES) / 4; u += 512) ((LAS unsigned*)(F.lds + RING_BYTES))[u] = 0u;
    __syncthreads();
#if MK_ONE_LAUNCH
    const int lo = 0, hi = N_PHASES;
#else
    const int lo = prm.ph_lo, hi = prm.ph_hi;
#endif
    XcdBarrier bar; bar.bar = (unsigned*)(F.ws + WS_CTL) + 4096; bar.x = 0; bar.st = nullptr;
    if (hi - lo > 1) {
        bar = xcd_barrier_post((unsigned*)(F.ws + WS_CTL) + 4096, MISC + 8);
        cg::this_grid().sync();
        if (threadIdx.x == 0) { unsigned nloc, nx; xcd_barrier_complete(bar.bar, bar.x, nloc, nx); bar.st[0] = nloc; bar.st[1] = nx; }
        __syncthreads();
    }
    const int wave_s = __builtin_amdgcn_readfirstlane(threadIdx.x >> 6);
    for (int ph = lo; ph < hi; ++ph) {
        { int lane_; asm volatile("v_mbcnt_lo_u32_b32 %0, -1, 0\n\tv_mbcnt_hi_u32_b32 %0, -1, %0" : "=v"(lane_));
          int z_ = 0, b_ = blockIdx.x, g_ = gridDim.x, t_ = wave_s * 64 + lane_;
#if (OPQ_MASK & 1)
          asm volatile("" : "+s"(z_));
#endif
#if (OPQ_MASK & 2)
          asm volatile("" : "+s"(b_), "+s"(g_));
#endif
#if (OPQ_MASK & 4)
          asm volatile("" : "+v"(t_));
#endif
          F.ws = prm.ws + z_; F.zo = z_;
          b_ &= 1023; g_ &= 1023; F.bid = b_; F.G = g_; F.vcu = (g_ % 8 == 0) ? (b_ % 8) * (g_ / 8) + b_ / 8 : b_; F.tid = t_ & 511; F.lane = t_ & 63; F.wave = __builtin_amdgcn_readfirstlane((t_ & 511) >> 6); }
        if constexpr (ONLY >= 0) {
            F.l = ph < 2 ? 0 : (ph - 2) / 9;
            if constexpr (ONLY == 100) prologue_a(F);
            else if constexpr (ONLY == 101) prologue_b(F);
            else if constexpr (ONLY == 0) phase_g1(F);
            else if constexpr (ONLY == 1) phase_g2(F);
            else if constexpr (ONLY == 2) phase_att(F);
            else if constexpr (ONLY == 3) phase_g3(F);
            else if constexpr (ONLY == 4) phase_g4(F);
            else if constexpr (ONLY == 5) ln_phase(F, 0);
            else if constexpr (ONLY == 6) phase_g5(F);
            else if constexpr (ONLY == 7) phase_g6(F);
            else ln_phase(F, 1);
            continue;
        }
        if (ph == 0) prologue_a(F);
        else if (ph == 1) prologue_b(F);
        else {
            const int q = ph - 2; F.l = q / 9; const int sub = q - F.l * 9;
            switch (sub) {
            case 0: phase_g1(F); break;
            case 1: phase_g2(F); break;
            case 2: phase_att(F); break;
            case 3: phase_g3(F); break;
            case 4: phase_g4(F); break;
            case 5: ln_phase(F, 0); break;
            case 6: phase_g5(F); break;
            case 7: phase_g6(F); break;
            default: ln_phase(F, 1); break;
            }
        }
        if (ph + 1 < hi) { XcdBarrier b2; b2.bar = (unsigned*)(F.ws + WS_CTL) + 4096; b2.x = xb_xcc_id(); b2.st = (volatile LAS unsigned*)(F.lds + MISC_OFF) + 8; xcd_barrier(b2, F.tid); }
    }
}

extern "C" void kernel_launch(void* const* d_in, const int* in_sizes, int n_in, void* d_out, int out_size, void* d_ws, size_t ws_size, hipStream_t stream) {
    static int grid = 0;
    if (grid == 0) {
        if (n_in != 25 || out_size != ML * D || ws_size < WS_END) { fprintf(stderr, "kernel_launch: unexpected shapes (n_in %d out %d ws %zu)\n", n_in, out_size, ws_size); grid = -1; return; }
        int dev = 0, cus = 0, per_cu = 0;
        (void)hipGetDevice(&dev); (void)hipDeviceGetAttribute(&cus, hipDeviceAttributeMultiprocessorCount, dev);
#if MK_ONE_LAUNCH
        (void)hipFuncSetAttribute((const void*)fwd_kernel<-1>, hipFuncAttributeMaxDynamicSharedMemorySize, LDS_BYTES);
        (void)hipOccupancyMaxActiveBlocksPerMultiprocessor(&per_cu, (const void*)fwd_kernel<-1>, 512, LDS_BYTES);
#else
        (void)hipFuncSetAttribute((const void*)fwd_kernel<100>, hipFuncAttributeMaxDynamicSharedMemorySize, LDS_BYTES);
        (void)hipFuncSetAttribute((const void*)fwd_kernel<101>, hipFuncAttributeMaxDynamicSharedMemorySize, LDS_BYTES);
        (void)hipFuncSetAttribute((const void*)fwd_kernel<0>, hipFuncAttributeMaxDynamicSharedMemorySize, LDS_BYTES);
        (void)hipFuncSetAttribute((const void*)fwd_kernel<1>, hipFuncAttributeMaxDynamicSharedMemorySize, LDS_BYTES);
        (void)hipFuncSetAttribute((const void*)fwd_kernel<2>, hipFuncAttributeMaxDynamicSharedMemorySize, LDS_BYTES);
        (void)hipFuncSetAttribute((const void*)fwd_kernel<3>, hipFuncAttributeMaxDynamicSharedMemorySize, LDS_BYTES);
        (void)hipFuncSetAttribute((const void*)fwd_kernel<4>, hipFuncAttributeMaxDynamicSharedMemorySize, LDS_BYTES);
        (void)hipFuncSetAttribute((const void*)fwd_kernel<5>, hipFuncAttributeMaxDynamicSharedMemorySize, LDS_BYTES);
        (void)hipFuncSetAttribute((const void*)fwd_kernel<6>, hipFuncAttributeMaxDynamicSharedMemorySize, LDS_BYTES);
        (void)hipFuncSetAttribute((const void*)fwd_kernel<7>, hipFuncAttributeMaxDynamicSharedMemorySize, LDS_BYTES);
        (void)hipFuncSetAttribute((const void*)fwd_kernel<8>, hipFuncAttributeMaxDynamicSharedMemorySize, LDS_BYTES);
#endif
        (void)hipGetLastError();
        if (per_cu < 1) per_cu = 1;
        grid = cus;
        if (grid != 256) fprintf(stderr, "kernel_launch: grid %d (expected 256)\n", grid);
    }
    if (grid < 0) return;
    (void)hipMemsetAsync((char*)d_ws + WS_CTL, 0, CTL_BYTES, stream);
    Params p{};
    for (int i = 0; i < 25; ++i) p.in[i] = (const float*)d_in[i];
    p.out = (float*)d_out; p.ws = (unsigned char*)d_ws;
#if MK_ONE_LAUNCH
    p.ph_lo = 0; p.ph_hi = N_PHASES;
    void* args[] = {&p};
    hipError_t e = hipLaunchCooperativeKernel((const void*)fwd_kernel<-1>, dim3(grid), dim3(512), args, LDS_BYTES, stream);
    if (e != hipSuccess) fprintf(stderr, "cooperative launch failed: %s\n", hipGetErrorString(e));
#else
    for (int ph = 0; ph < N_PHASES; ++ph) {
        p.ph_lo = ph; p.ph_hi = ph + 1;
        const int sub = ph < 2 ? 100 + ph : (ph - 2) % 9;
        switch (sub) {
        case 100: hipLaunchKernelGGL(fwd_kernel<100>, dim3(grid), dim3(512), LDS_BYTES, stream, p); break;
        case 101: hipLaunchKernelGGL(fwd_kernel<101>, dim3(grid), dim3(512), LDS_BYTES, stream, p); break;
        case 0: hipLaunchKernelGGL(fwd_kernel<0>, dim3(grid), dim3(512), LDS_BYTES, stream, p); break;
        case 1: hipLaunchKernelGGL(fwd_kernel<1>, dim3(grid), dim3(512), LDS_BYTES, stream, p); break;
        case 2: hipLaunchKernelGGL(fwd_kernel<2>, dim3(grid), dim3(512), LDS_BYTES, stream, p); break;
        case 3: hipLaunchKernelGGL(fwd_kernel<3>, dim3(grid), dim3(512), LDS_BYTES, stream, p); break;
        case 4: hipLaunchKernelGGL(fwd_kernel<4>, dim3(grid), dim3(512), LDS_BYTES, stream, p); break;
        case 5: hipLaunchKernelGGL(fwd_kernel<5>, dim3(grid), dim3(512), LDS_BYTES, stream, p); break;
        case 6: hipLaunchKernelGGL(fwd_kernel<6>, dim3(grid), dim3(512), LDS_BYTES, stream, p); break;
        case 7: hipLaunchKernelGGL(fwd_kernel<7>, dim3(grid), dim3(512), LDS_BYTES, stream, p); break;
        default: hipLaunchKernelGGL(fwd_kernel<8>, dim3(grid), dim3(512), LDS_BYTES, stream, p); break;
        }
    }
#endif
}
```

```cpp
#include <hip/hip_runtime.h>
#include <hip/hip_cooperative_groups.h>
#include <cstdio>
#include <cstdint>
namespace cg = cooperative_groups;

#define LAS __attribute__((address_space(3)))
#define DI __device__ __forceinline__
typedef unsigned short bf16_t;
typedef short bf16x8 __attribute__((ext_vector_type(8)));
typedef short s16x4 __attribute__((ext_vector_type(4)));
typedef float f32x2 __attribute__((ext_vector_type(2)));
typedef float f32x4 __attribute__((ext_vector_type(4)));
typedef float f32x16 __attribute__((ext_vector_type(16)));
typedef unsigned u32x4 __attribute__((ext_vector_type(4)));
typedef unsigned u32x2 __attribute__((ext_vector_type(2)));
typedef __bf16 bf16x2_t __attribute__((ext_vector_type(2)));

#ifndef MK_ONE_LAUNCH
#define MK_ONE_LAUNCH 1
#endif
#ifndef OPQ_MASK
#if MK_ONE_LAUNCH
#define OPQ_MASK 7
#else
#define OPQ_MASK 0
#endif
#endif

constexpr int D = 1024, NB = 8, SEQ = 2048, CTXL = 256, NL = 4;
constexpr int ML = NB * SEQ, MC = NB * CTXL, MT = ML + MC;
constexpr int DFF = 4096, INC = 4896;
constexpr float EPS = 1e-6f;
constexpr float ALPHA = 1.6817928305074290f;
constexpr float QS_MLA = (float)(0.10206207261596575 * 1.4426950408889634);
constexpr float QS_GQA = (float)(0.125 * 1.4426950408889634);
constexpr int NIN = 4352;

constexpr size_t MiB = 1u << 20;
constexpr size_t WS_CTL = 0, CTL_BYTES = 65536;
constexpr size_t WS_MOD = 1 * MiB;
constexpr size_t WS_ROPEM = 2 * MiB;
constexpr size_t WS_ROPEG = 2 * MiB + 262144;
constexpr size_t WS_SSKV = 3 * MiB, WS_SSQ = 3 * MiB + 524288;
constexpr size_t WS_DFTMC = 4 * MiB;
constexpr size_t WS_ST1 = 4 * MiB + 524288, WS_ST2 = 4 * MiB + 786432;
constexpr size_t WS_DFTM = 5 * MiB;
constexpr size_t WS_W = 21 * MiB;
constexpr size_t W_IN = 0, W_KR = 8 * MiB + 524288, W_T = 9 * MiB, W_UKV = 11 * MiB, W_UQ = 11 * MiB + 524288, W_FO = 12 * MiB, W_MO = 13 * MiB,
                 W_GO = 14 * MiB, W_O = 15 * MiB, W_1 = 17 * MiB, W_2 = 25 * MiB;
constexpr size_t WS_XC = 54 * MiB;
constexpr size_t WS_HB = 62 * MiB;
constexpr size_t WS_CKV = 98 * MiB, WS_CQ = 107 * MiB, WS_KG = 116 * MiB, WS_VG = 120 * MiB + 524288, WS_QG = 125 * MiB, WS_KR = 143 * MiB;
constexpr size_t WS_KN = 145 * MiB, WS_VM = 163 * MiB, WS_QM = 181 * MiB;
constexpr size_t WS_F = 208 * MiB, WS_AM = 226 * MiB;
constexpr size_t WS_GATE = 244 * MiB, WS_TF = 352 * MiB, WS_TFC = 384 * MiB, WS_U = 244 * MiB;
constexpr size_t WS_END = 388 * MiB;

constexpr int LDS_BYTES = 147456, RING_BYTES = 131072, MISC_OFF = RING_BYTES + 320;

struct Params {
    const float* in[25];
    float* out;
    unsigned char* ws;
    int ph_lo, ph_hi;
};
enum { I_X = 0, I_C, I_CTX, I_CCTX, I_WADA, I_BADA, I_WIN, I_BGATE, I_MQG, I_MKVG, I_WUQ, I_WUK, I_WUV, I_GQG, I_GKG, I_WFO, I_WMO, I_WGO, I_WO,
       I_LN1G, I_LN1B, I_W1, I_W2, I_LN2G, I_LN2B };

DI unsigned pk2(float lo, float hi) { f32x2 v = {lo, hi}; bf16x2_t b = __builtin_convertvector(v, bf16x2_t); return __builtin_bit_cast(unsigned, b); }
DI u32x4 pk8(const f32x4& a, const f32x4& b) { u32x4 w; w.x = pk2(a[0], a[1]); w.y = pk2(a[2], a[3]); w.z = pk2(b[0], b[1]); w.w = pk2(b[2], b[3]); return w; }
DI float bf2f(unsigned short h) { return __uint_as_float((unsigned)h << 16); }
DI void unpk8(const u32x4& w, float* f) {
    f[0] = __uint_as_float(w.x << 16); f[1] = __uint_as_float(w.x & 0xffff0000u); f[2] = __uint_as_float(w.y << 16); f[3] = __uint_as_float(w.y & 0xffff0000u);
    f[4] = __uint_as_float(w.z << 16); f[5] = __uint_as_float(w.z & 0xffff0000u); f[6] = __uint_as_float(w.w << 16); f[7] = __uint_as_float(w.w & 0xffff0000u);
}
DI float shx(float v, int m, int lane) { return __int_as_float(__builtin_amdgcn_ds_bpermute((lane ^ m) << 2, __float_as_int(v))); }
DI float wave_sum(float v, int lane) {
#pragma unroll
    for (int o = 1; o < 64; o <<= 1) v += shx(v, o, lane);
    return v;
}

#define XB_TMO      128
#define XB_XCNT(j)  (256  + 64 * (j))
#define XB_XSUB(j)  (1280 + 64 * (j))
#define XB_XGEN(j)  (2304 + 64 * (j))
#define XB_TOP      3328
#define XB_TOPGEN   3392
#define XB_SPIN_CAP (1u << 22)
DI unsigned xb_ld(unsigned* p)              { return __hip_atomic_load(p, __ATOMIC_RELAXED, __HIP_MEMORY_SCOPE_AGENT); }
DI unsigned xb_add(unsigned* p, unsigned v) { return __hip_atomic_fetch_add(p, v, __ATOMIC_RELAXED, __HIP_MEMORY_SCOPE_AGENT); }
DI unsigned xb_xcc_id() { return (unsigned)__builtin_amdgcn_s_getreg((3 << 11) | 20) & 0xFu; }
#define XB_SPIN(cond, bar) do { unsigned _sp = 0; while (cond) { __builtin_amdgcn_s_sleep(1); \
    if ((++_sp & 255u) == 0u) { if (xb_ld(&(bar)[XB_TMO])) break; if (_sp > XB_SPIN_CAP) { atomicAdd(&(bar)[XB_TMO], 1u); break; } } } } while (0)
struct XcdBarrier { unsigned* bar; unsigned x; volatile LAS unsigned* st; };
DI XcdBarrier xcd_barrier_post(unsigned* bar, volatile LAS unsigned* st) {
    XcdBarrier b; b.bar = bar; b.x = xb_xcc_id(); b.st = st;
    if (threadIdx.x == 0) (void)xb_add(&bar[XB_XCNT(b.x)], 1u);
    return b;
}
DI void xcd_barrier_complete(unsigned* bar, unsigned x, unsigned& nloc, unsigned& nx) {
    const unsigned G = gridDim.x * gridDim.y * gridDim.z;
    unsigned sum, cnt, mine, sp = 0u;
    for (;;) {
        sum = 0u; cnt = 0u; mine = 0u;
#pragma unroll
        for (unsigned j = 0; j < 16; ++j) { const unsigned c = xb_ld(&bar[XB_XCNT(j)]); sum += c; cnt += (c > 0u) ? 1u : 0u; mine = (j == x) ? c : mine; }
        if (sum == G) break;
        __builtin_amdgcn_s_sleep(1);
        if ((++sp & 255u) == 0u) { if (xb_ld(&bar[XB_TMO])) break; if (sp > XB_SPIN_CAP) { atomicAdd(&bar[XB_TMO], 1u); break; } }
    }
    nloc = mine > 0u ? mine : 1u; nx = cnt > 0u ? cnt : 1u;
}
DI void xcd_barrier(const XcdBarrier& b, const int tid) {
    asm volatile("s_waitcnt vmcnt(0)" ::: "memory");
    __syncthreads();
    if (tid == 0) {
        unsigned* bar = b.bar;
        __builtin_amdgcn_s_waitcnt(0);
        unsigned nloc = b.st[0], nx = b.st[1];
        const unsigned old = xb_add(&bar[XB_XSUB(b.x)], 1u);
        const unsigned gen = old / nloc;
        if (old + 1u == (gen + 1u) * nloc) {
            __builtin_amdgcn_fence(__ATOMIC_RELEASE, "agent");
            asm volatile("s_waitcnt vmcnt(0)" ::: "memory");
            const unsigned og = xb_add(&bar[XB_TOP], 1u);
            const unsigned tg = og / nx;
            if (og + 1u == (tg + 1u) * nx) xb_add(&bar[XB_TOPGEN], 1u);
            else XB_SPIN(xb_ld(&bar[XB_TOPGEN]) == tg, bar);
            __builtin_amdgcn_fence(__ATOMIC_ACQUIRE, "agent");
            xb_add(&bar[XB_XGEN(b.x)], 1u);
            asm volatile("s_waitcnt vmcnt(0)" ::: "memory");
        } else {
            XB_SPIN(xb_ld(&bar[XB_XGEN(b.x)]) == gen, bar);
            __builtin_amdgcn_fence(__ATOMIC_ACQUIRE, "agent");
            asm volatile("s_waitcnt vmcnt(0)" ::: "memory");
        }
    }
    __syncthreads();
}

namespace pg8 {
constexpr int BM = 256, BK = 64, HALF = 128, HTB = HALF * BK * 2;
DI int lds_byte(int r, int c) { const int st = (r >> 4) * 2 + (c >> 5), rr = r & 15, cc = c & 31, ob = rr * 64 + cc * 2; return st * 1024 + (ob ^ (((ob >> 9) & 1) << 5)); }
DI void stage_rc(int b, int& R, int& C) { const int st = b / 1024, sb = b % 1024, swz = sb ^ (((sb >> 9) & 1) << 5); R = (st >> 1) * 16 + swz / 64; C = (st & 1) * 32 + (swz % 64) / 2; }
DI int perm32(int rho) { const int n = rho >> 4, i = rho & 15; return 8 * (i >> 2) + 4 * n + (i & 3); }

struct Unit { const char* A; const char* B; int job, pm, pn, z, seg; bool last; };
struct JobD { const char* A; const char* B; int nM, nN, nZ; long Az, Bz; };
DI void decode(const JobD& j, int t, long tileBytes, int jobid, Unit& u) {
    const int nMt = j.nM * j.nZ, nwg = nMt * j.nN;
    int wg; { const int q = nwg >> 3, r = nwg & 7, xcd = t & 7, off = t >> 3; wg = (xcd < r ? xcd * (q + 1) : r * (q + 1) + (xcd - r) * q) + off; }
    const int nig = 8 * j.nN, gid = wg / nig, fm = gid * 8, gsz = (nMt - fm) < 8 ? (nMt - fm) : 8;
    const int rem = wg - gid * nig, pn = rem / gsz, pmt = fm + (rem - pn * gsz);
    const int z = pmt / j.nM, pm = pmt - z * j.nM;
    u.A = j.A + (long)z * j.Az + (long)pm * tileBytes; u.B = j.B + (long)z * j.Bz + (long)pn * tileBytes;
    u.job = jobid; u.pm = pm; u.pn = pn; u.z = z; u.seg = 0; u.last = true;
}
struct Sched2 {
    JobD j0, j1; int n0, total, G, c; long tileBytes;
    DI bool next(int i, Unit& u) const {
        const long L = (long)i * G + c; if (L >= total) return false;
        if ((int)L < n0) decode(j0, (int)L, tileBytes, 0, u); else decode(j1, (int)L - n0, tileBytes, 1, u);
        return true;
    }
};
struct Sched3 {
    JobD j; const char* A1; const char* A2; const char* B1; const char* B2; int ntiles, G, c; long tileBytes;
    DI bool next(int i, Unit& u) const {
        const int ti = i / 3, seg = i - ti * 3; const long L = (long)ti * G + c; if (L >= ntiles) return false;
        decode(j, (int)L, tileBytes, 0, u);
        if (seg == 1) { u.A = A1 + (u.A - j.A); u.B = B1 + (u.B - j.B); }
        if (seg == 2) { u.A = A2 + (u.A - j.A); u.B = B2 + (u.B - j.B); }
        u.seg = seg; u.last = (seg == 2);
        return true;
    }
};

typedef f32x4 Acc[2][2][4][2];
template <int PITCH = 0, class Epi, class Sched>
DI void gemm_phase(LAS unsigned char* lds, const int K_, const Sched& S, const Epi& E, const int tid_in) {
    int Kq = K_; asm volatile("" : "+s"(Kq)); const int K = Kq & 0x1fc0;
    int tid_ = tid_in;
#ifndef NO_OPQ_TID
    asm volatile("" : "+v"(tid_));
#endif
    const int tid = tid_ & 511, wid = __builtin_amdgcn_readfirstlane(tid >> 6), lane = tid & 63, wr = wid >> 2, wc = wid & 3, fr = lane & 15, fq = lane >> 4;
    const int nt = K / BK;
    unsigned voffA[2], voffB[2];
#pragma unroll
    for (int i = 0; i < 2; ++i) { int R, C; stage_rc(tid * 16 + i * 8192, R, C); const int Rb = (R & ~31) + perm32(R & 31);
        voffA[i] = (unsigned)(R * (PITCH ? PITCH : K) + C) * 2u; voffB[i] = (unsigned)(Rb * (PITCH ? PITCH : K) + C) * 2u; }
    const size_t kstep = (size_t)(BK * 2);
    const size_t hstep = (size_t)HALF * (PITCH ? PITCH : K) * 2;
    const unsigned ldsw = (unsigned)wid * 1024u;
    const int aoff = lds_byte(wr * 64 + fr, fq * 8), boff = lds_byte(wc * 32 + fr, fq * 8);
#define PG8_SA(b, h) (((b) * 2 + (h)) * HTB)
#define PG8_SB(b, h) ((4 + (b) * 2 + (h)) * HTB)
#define PG8_STAGE(bufoff, gbase, voff) do { _Pragma("unroll") for (int _i = 0; _i < 2; ++_i) \
        __builtin_amdgcn_global_load_lds((const unsigned*)((const char*)(gbase) + (voff)[_i]), (LAS unsigned*)(lds + (bufoff) + ldsw + _i * 8192), 16, 0, 0); } while (0)
#define PG8_LDA(dst, b, h) do { _Pragma("unroll") for (int m = 0; m < 4; ++m) _Pragma("unroll") for (int k = 0; k < 2; ++k) dst[m][k] = *(const LAS bf16x8*)(lds + PG8_SA(b, h) + aoff + m * 2048 + k * 1024); } while (0)
#define PG8_LDB(dst, b, h) do { _Pragma("unroll") for (int n = 0; n < 2; ++n) _Pragma("unroll") for (int k = 0; k < 2; ++k) dst[n][k] = *(const LAS bf16x8*)(lds + PG8_SB(b, h) + boff + n * 2048 + k * 1024); } while (0)
#define PG8_MMA(ai, bj, At, Bt) do { __builtin_amdgcn_s_setprio(1); _Pragma("unroll") for (int m = 0; m < 4; ++m) _Pragma("unroll") for (int n = 0; n < 2; ++n) _Pragma("unroll") for (int k = 0; k < 2; ++k) \
        acc[ai][bj][m][n] = __builtin_amdgcn_mfma_f32_16x16x32_bf16(Bt[n][k], At[m][k], acc[ai][bj][m][n], 0, 0, 0); __builtin_amdgcn_s_setprio(0); } while (0)
#define PG8_WAIT_V(n) asm volatile("s_waitcnt vmcnt(" #n ")" ::: "memory")
#define PG8_WAIT_L(n) asm volatile("s_waitcnt lgkmcnt(" #n ")" ::: "memory")
#define PG8_BAR __builtin_amdgcn_s_barrier()
#define PG8_SCHED __builtin_amdgcn_sched_barrier(0)
    Unit cur, nxt; int ui = 0;
    if (!S.next(0, cur)) return;
    Acc acc;
#pragma unroll
    for (int a = 0; a < 2; ++a)
#pragma unroll
        for (int b = 0; b < 2; ++b)
#pragma unroll
            for (int m = 0; m < 4; ++m)
#pragma unroll
                for (int n = 0; n < 2; ++n) acc[a][b][m][n] = (f32x4){0.f, 0.f, 0.f, 0.f};
    bf16x8 At[4][2], B0[2][2], B1[2][2];
    const char* cA = cur.A; const char* cB = cur.B;
    PG8_STAGE(PG8_SB(0, 0), cB, voffB); PG8_STAGE(PG8_SB(0, 1), cB + hstep, voffB); PG8_STAGE(PG8_SA(0, 0), cA, voffA); PG8_STAGE(PG8_SA(0, 1), cA + hstep, voffA);
    if (wr == 1) PG8_BAR;
    PG8_WAIT_V(2); PG8_BAR;
    PG8_STAGE(PG8_SB(1, 0), cB + kstep, voffB); PG8_STAGE(PG8_SA(1, 0), cA + kstep, voffA); PG8_STAGE(PG8_SB(1, 1), cB + hstep + kstep, voffB);
    PG8_WAIT_V(6); PG8_BAR;
    for (;;) {
        const bool has_next = S.next(ui + 1, nxt);
        const char* nA = has_next ? nxt.A : cA; const char* nB = has_next ? nxt.B : cB;
        for (int t = 0; t < nt; t += 2) {
            const bool last = (t == nt - 2);
            const char* a1 = cA + (size_t)(t + 1) * kstep;
            const char* a2 = last ? nA : cA + (size_t)(t + 2) * kstep; const char* b2 = last ? nB : cB + (size_t)(t + 2) * kstep;
            const char* a3 = a2 + kstep; const char* b3 = b2 + kstep;
            PG8_LDB(B0, 0, 0); PG8_LDB(B1, 0, 1); PG8_SCHED; PG8_LDA(At, 0, 0); PG8_STAGE(PG8_SA(1, 1), a1 + hstep, voffA);
            PG8_WAIT_V(8); PG8_WAIT_L(0); PG8_BAR; PG8_MMA(0, 0, At, B0); PG8_MMA(0, 1, At, B1); PG8_BAR; PG8_SCHED;
            PG8_LDA(At, 0, 1); PG8_STAGE(PG8_SB(0, 0), b2, voffB); PG8_STAGE(PG8_SB(0, 1), b2 + hstep, voffB); PG8_STAGE(PG8_SA(0, 0), a2, voffA);
            PG8_WAIT_V(8); PG8_WAIT_L(0); PG8_BAR; PG8_MMA(1, 0, At, B0); PG8_MMA(1, 1, At, B1); PG8_BAR; PG8_SCHED;
            PG8_LDB(B0, 1, 0); PG8_LDB(B1, 1, 1); PG8_SCHED; PG8_LDA(At, 1, 0); PG8_STAGE(PG8_SA(0, 1), a2 + hstep, voffA);
            PG8_WAIT_V(8); PG8_WAIT_L(0); PG8_BAR; PG8_MMA(0, 0, At, B0); PG8_MMA(0, 1, At, B1); PG8_BAR; PG8_SCHED;
            PG8_LDA(At, 1, 1); PG8_STAGE(PG8_SB(1, 0), b3, voffB); PG8_STAGE(PG8_SB(1, 1), b3 + hstep, voffB); PG8_STAGE(PG8_SA(1, 0), a3, voffA);
            PG8_WAIT_V(8); PG8_WAIT_L(0); PG8_BAR; PG8_MMA(1, 0, At, B0); PG8_MMA(1, 1, At, B1); PG8_BAR; PG8_SCHED;
        }
        if (wr == 0) PG8_BAR;
        E(acc, cur, wr, wc, fr, fq);
        if (!has_next) break;
        if (cur.last) {
#pragma unroll
            for (int a = 0; a < 2; ++a)
#pragma unroll
                for (int b = 0; b < 2; ++b)
#pragma unroll
                    for (int m = 0; m < 4; ++m)
#pragma unroll
                        for (int n = 0; n < 2; ++n) acc[a][b][m][n] = (f32x4){0.f, 0.f, 0.f, 0.f};
        }
        cur = nxt; cA = nA; cB = nB; ++ui;
        if (wr == 1) PG8_BAR;
    }
    PG8_WAIT_V(0);
    PG8_BAR;
#undef PG8_SA
#undef PG8_SB
#undef PG8_STAGE
#undef PG8_LDA
#undef PG8_LDB
#undef PG8_MMA
#undef PG8_WAIT_V
#undef PG8_WAIT_L
#undef PG8_BAR
#undef PG8_SCHED
}
}
using pg8::Acc; using pg8::Unit;

struct Frame {
    const Params* P;
    unsigned char* ws;
    LAS unsigned char* lds;
    int tid, lane, wave, G, bid, vcu;
    int l;
    int zo;
};
DI const float* pin(const Frame& F, int idx) { return F.P->in[idx + F.zo]; }
DI const float* inl(const Frame& F, int idx, size_t per_layer) { return pin(F, idx) + (size_t)F.l * per_layer; }
DI const float* modp(const Frame& F, int l, int mr, int which) { return (const float*)(F.ws + WS_MOD) + ((size_t)(l * 9 + mr) * 6 + which) * 1024; }
DI int modrow_of_tile(int row0) { return row0 < ML ? (row0 >> 11) : 8; }
DI float* xrow_ptr(const Frame& F, int row) { return row < ML ? F.P->out + (size_t)row * D : (float*)(F.ws + WS_XC) + (size_t)(row - ML) * D; }
DI const float* xin_ptr(const Frame& F, int row) {
    if (F.l == 0) return row < ML ? pin(F, I_X) + (size_t)row * D : pin(F, I_CTX) + (size_t)(row - ML) * D;
    return xrow_ptr(F, row);
}

#define EPI_ROWS(ai, m) (128 * (ai) + 64 * wr + 16 * (m) + fr)
#define EPI_COL8(bj) (128 * (bj) + 32 * wc + 8 * fq)
#define FOR_AI_M _Pragma("unroll") for (int ai = 0; ai < 2; ++ai) _Pragma("unroll") for (int m = 0; m < 4; ++m)
#define ROW_FENCE asm volatile("" ::: "memory")

struct EpiG1 {
    const Frame& F;
    DI void operator()(Acc& acc, const Unit& u, int wr, int wc, int fr, int fq) const {
        unsigned char* ws = F.ws;
        if (u.job == 1) {
            bf16_t* base; int ld;
            if (u.pn < 64) { base = (bf16_t*)(ws + WS_TF) + (size_t)(u.pn >> 3) * 1024 * 2048 + (u.pn & 7) * 256; ld = 2048; }
            else { base = (bf16_t*)(ws + WS_TFC) + (size_t)(u.pn - 64) * 1024 * 256; ld = 256; }
            FOR_AI_M { const int r = u.pm * 256 + EPI_ROWS(ai, m);
#pragma unroll
                for (int bj = 0; bj < 2; ++bj) *(u32x4*)(base + (size_t)r * ld + EPI_COL8(bj)) = pk8(acc[ai][bj][m][0], acc[ai][bj][m][1]); }
            return;
        }
        const int row0 = u.pm * 256;
        if (u.pn <= 1) {
            bf16_t* dst = (bf16_t*)(ws + (u.pn == 0 ? WS_CKV : WS_CQ)); float* ss = (float*)(ws + (u.pn == 0 ? WS_SSKV : WS_SSQ));
            FOR_AI_M { const int r = row0 + EPI_ROWS(ai, m); float s = 0.f;
#pragma unroll
                for (int bj = 0; bj < 2; ++bj) { const f32x4 a = acc[ai][bj][m][0], b = acc[ai][bj][m][1];
                    s += (a[0] * a[0] + a[1] * a[1]) + (a[2] * a[2] + a[3] * a[3]) + (b[0] * b[0] + b[1] * b[1]) + (b[2] * b[2] + b[3] * b[3]);
                    *(u32x4*)(dst + (size_t)r * 256 + EPI_COL8(bj)) = pk8(a, b); }
                s += shx(s, 16, fr + 16 * fq); s += shx(s, 32, fr + 16 * fq);
                if (fq == 0) ss[(size_t)r * 4 + wc] = s; }
            return;
        }
        if (u.pn >= 5) {
            const int cb = (u.pn - 5) * 256; const float* bg = inl(F, I_BGATE, 3072) + cb; bf16_t* dst = (bf16_t*)(ws + WS_GATE) + cb;
            f32x4 bv[2][2];
#pragma unroll
            for (int bj = 0; bj < 2; ++bj) { bv[bj][0] = *(const f32x4*)(bg + EPI_COL8(bj)); bv[bj][1] = *(const f32x4*)(bg + EPI_COL8(bj) + 4); }
            FOR_AI_M { const int r = row0 + EPI_ROWS(ai, m);
#pragma unroll
                for (int bj = 0; bj < 2; ++bj) { f32x4 a = acc[ai][bj][m][0] + bv[bj][0], b = acc[ai][bj][m][1] + bv[bj][1];
#pragma unroll
                    for (int e = 0; e < 4; ++e) { a[e] = __builtin_amdgcn_rcpf(1.f + __builtin_amdgcn_exp2f(-1.4426950408889634f * a[e])); b[e] = __builtin_amdgcn_rcpf(1.f + __builtin_amdgcn_exp2f(-1.4426950408889634f * b[e])); }
                    *(u32x4*)(dst + (size_t)r * 3072 + EPI_COL8(bj)) = pk8(a, b); } }
            return;
        }
        const bool is_q = (u.pn >= 3);
        const bool is_v = (!is_q) && (wc >= 2);
        const float* gain = is_q ? inl(F, I_GQG, 64) : inl(F, I_GKG, 64);
        f32x4 gv[2][2];
#pragma unroll
        for (int bj = 0; bj < 2; ++bj) { gv[bj][0] = *(const f32x4*)(gain + 32 * bj + 8 * fq); gv[bj][1] = *(const f32x4*)(gain + 32 * bj + 8 * fq + 4); }
        bf16_t* dst; int ld, colb;
        if (is_q) { dst = (bf16_t*)(ws + WS_QG); ld = 512; colb = ((u.pn - 3) * 4 + wc) * 64; }
        else if (!is_v) { dst = (bf16_t*)(ws + WS_KG); ld = 128; colb = wc * 64; }
        else { dst = (bf16_t*)(ws + WS_VG); ld = 128; colb = (wc - 2) * 64; }
        const bool rope = (row0 < ML);
        const float* rg = (const float*)(ws + WS_ROPEG);
        const float qs = is_q ? QS_GQA : 1.f;
        FOR_AI_M { const int r = row0 + EPI_ROWS(ai, m);
            f32x4 x[2][2];
#pragma unroll
            for (int bj = 0; bj < 2; ++bj) { x[bj][0] = acc[ai][bj][m][0]; x[bj][1] = acc[ai][bj][m][1]; }
            if (!is_v) {
                float s = 0.f;
#pragma unroll
                for (int bj = 0; bj < 2; ++bj)
#pragma unroll
                    for (int n = 0; n < 2; ++n) s += (x[bj][n][0] * x[bj][n][0] + x[bj][n][1] * x[bj][n][1]) + (x[bj][n][2] * x[bj][n][2] + x[bj][n][3] * x[bj][n][3]);
                s += shx(s, 16, fr + 16 * fq); s += shx(s, 32, fr + 16 * fq);
                const float rstd = 1.f / sqrtf(s * (1.f / 64.f) + EPS);
#pragma unroll
                for (int bj = 0; bj < 2; ++bj)
#pragma unroll
                    for (int n = 0; n < 2; ++n) x[bj][n] = x[bj][n] * rstd * gv[bj][n];
                if (rope) {
                    const float* rr = rg + (size_t)(r & 2047) * 64 + 8 * fq;
#pragma unroll
                    for (int n = 0; n < 2; ++n) { const f32x4 cs = *(const f32x4*)(rr + 4 * n), sn = *(const f32x4*)(rr + 32 + 4 * n);
                        const f32x4 x1 = x[0][n], x2 = x[1][n]; x[0][n] = x1 * cs - x2 * sn; x[1][n] = x1 * sn + x2 * cs; }
                }
#pragma unroll
                for (int bj = 0; bj < 2; ++bj)
#pragma unroll
                    for (int n = 0; n < 2; ++n) x[bj][n] = x[bj][n] * qs;
            }
#pragma unroll
            for (int bj = 0; bj < 2; ++bj) *(u32x4*)(dst + (size_t)r * ld + colb + 32 * bj + 8 * fq) = pk8(x[bj][0], x[bj][1]);
            if (m & 1) ROW_FENCE;
        }
    }
};

struct EpiG2 {
    const Frame& F;
    DI void operator()(Acc& acc, const Unit& u, int wr, int wc, int fr, int fq) const {
        unsigned char* ws = F.ws; const int row0 = u.pm * 256;
        const float* ss = (const float*)(ws + (u.job == 0 ? WS_SSKV : WS_SSQ));
        bf16_t* dst; int ld; float sc = 1.f;
        if (u.job == 0) { dst = (bf16_t*)(ws + (u.pn < 2 ? WS_KN : WS_VM)) + (u.pn & 1) * 256; ld = 512; }
        else { dst = (bf16_t*)(ws + WS_QM); ld = 768; sc = QS_MLA; }
        const bool ropet = (u.job == 1 && u.pn == 2);
        const bool rope = ropet && row0 < ML;
        const float* rm = (const float*)(ws + WS_ROPEM) + 4 * fq;
        int colv[2];
#pragma unroll
        for (int bj = 0; bj < 2; ++bj) {
            if (u.job == 0) colv[bj] = EPI_COL8(bj);
            else if (!ropet) { const int c = u.pn * 256 + EPI_COL8(bj); colv[bj] = (c >> 6) * 96 + (c & 63); }
            else { const int c = EPI_COL8(bj); colv[bj] = (c >> 5) * 96 + 64 + (c & 31); }
        }
        FOR_AI_M { const int r = row0 + EPI_ROWS(ai, m);
            const f32x4 s4 = *(const f32x4*)(ss + (size_t)r * 4);
            const float rstd = sc * __builtin_amdgcn_rsqf(((s4[0] + s4[1]) + (s4[2] + s4[3])) * (1.f / 256.f) + EPS);
            f32x4 cs = {1.f, 1.f, 1.f, 1.f}, sn = {0.f, 0.f, 0.f, 0.f};
            if (rope) { const float* rr = rm + (size_t)(r & 2047) * 32; cs = *(const f32x4*)rr; sn = *(const f32x4*)(rr + 16); }
#pragma unroll
            for (int bj = 0; bj < 2; ++bj) {
                const f32x4 x1 = acc[ai][bj][m][0] * rstd, x2 = acc[ai][bj][m][1] * rstd;
                f32x4 a = x1, b = x2;
                if (ropet) { a = x1 * cs - x2 * sn; b = x1 * sn + x2 * cs; }
                *(u32x4*)(dst + (size_t)r * ld + colv[bj]) = pk8(a, b);
            }
            ROW_FENCE;
        }
    }
};

struct EpiDft {
    bf16_t* dst; int zrows, ld;
    DI void operator()(Acc& acc, const Unit& u, int wr, int wc, int fr, int fq) const {
        FOR_AI_M { const int r = u.z * zrows + u.pm * 256 + EPI_ROWS(ai, m);
#pragma unroll
            for (int bj = 0; bj < 2; ++bj) *(u32x4*)(dst + (size_t)r * ld + u.pn * 256 + EPI_COL8(bj)) = pk8(acc[ai][bj][m][0], acc[ai][bj][m][1]); }
    }
};

struct EpiG3 {
    const Frame& F;
    DI void operator()(Acc& acc, const Unit& u, int wr, int wc, int fr, int fq) const {
        const bf16_t* gate = (const bf16_t*)(F.ws + WS_GATE); bf16_t* Y = (bf16_t*)(F.ws + WS_HB);
        const int row0 = u.pm * 256, col0 = u.pn * 256;
        const int s1 = u.seg < 2 ? u.seg + 1 : u.seg;
#pragma unroll
        for (int aim = 0; aim < 4; ++aim) { const int ai = aim >> 1, mb = (aim & 1) * 2;
            u32x4 ga[4][2], gb[4][2];
#pragma unroll
            for (int m = mb; m < mb + 2; ++m)
#pragma unroll
                for (int bj = 0; bj < 2; ++bj) { const size_t o = (size_t)(row0 + EPI_ROWS(ai, m)) * 3072 + col0 + EPI_COL8(bj);
                    ga[m][bj] = *(const u32x4*)(gate + o + u.seg * 1024); if (u.seg < 2) gb[m][bj] = *(const u32x4*)(gate + o + s1 * 1024); }
#pragma unroll
            for (int m = mb; m < mb + 2; ++m) { const int r = row0 + EPI_ROWS(ai, m);
#pragma unroll
                for (int bj = 0; bj < 2; ++bj) {
                    float g0[8]; unpk8(ga[m][bj], g0);
                    if (u.seg < 2) { float g1[8]; unpk8(gb[m][bj], g1);
#pragma unroll
                        for (int e = 0; e < 8; ++e) g0[e] = g0[e] * __builtin_amdgcn_rcpf(fmaxf(g1[e], 1e-20f)); }
#pragma unroll
                    for (int e = 0; e < 4; ++e) { acc[ai][bj][m][0][e] *= g0[e]; acc[ai][bj][m][1][e] *= g0[4 + e]; }
                    if (u.seg == 2) *(u32x4*)(Y + (size_t)r * 1024 + col0 + EPI_COL8(bj)) = pk8(acc[ai][bj][m][0], acc[ai][bj][m][1]);
                }
            }
            ROW_FENCE;
        }
    }
};

struct EpiRes {
    const Frame& F; int which; bool from_input;
    int lnmode;
    DI void operator()(Acc& acc, const Unit& u, int wr, int wc, int fr, int fq) const {
        const int row0 = u.pm * 256, col0 = u.pn * 256;
        const float* g = modp(F, F.l, modrow_of_tile(row0), which) + col0;
        const bool ln = (lnmode != 0) && row0 < ML;
        const float* st = (const float*)(F.ws + (lnmode == 1 ? WS_ST1 : WS_ST2));
        const float* lg = lnmode == 1 ? pin(F, I_LN1G) + F.l * 1024 : pin(F, I_LN2G) + (F.l > 0 ? F.l - 1 : 0) * 1024;
        const float* lb = lnmode == 1 ? pin(F, I_LN1B) + F.l * 1024 : pin(F, I_LN2B) + (F.l > 0 ? F.l - 1 : 0) * 1024;
        {
#pragma unroll
            for (int bj = 0; bj < 2; ++bj) {
                f32x4 gv0 = *(const f32x4*)(g + EPI_COL8(bj)), gv1 = *(const f32x4*)(g + EPI_COL8(bj) + 4);
                f32x4 c0 = {0.f, 0.f, 0.f, 0.f}, c1 = {0.f, 0.f, 0.f, 0.f};
                if (ln) { c0 = *(const f32x4*)(lb + col0 + EPI_COL8(bj)) * ALPHA; c1 = *(const f32x4*)(lb + col0 + EPI_COL8(bj) + 4) * ALPHA; }
#pragma unroll
                for (int ai = 0; ai < 2; ++ai)
#pragma unroll
                    for (int m = 0; m < 4; ++m) { acc[ai][bj][m][0] = acc[ai][bj][m][0] * gv0 + c0; acc[ai][bj][m][1] = acc[ai][bj][m][1] * gv1 + c1; }
            }
        }
        f32x4 la[2][2];
#pragma unroll
        for (int bj = 0; bj < 2; ++bj) {
#pragma unroll
            for (int n = 0; n < 2; ++n) la[bj][n] = (f32x4){ALPHA, ALPHA, ALPHA, ALPHA};
            if (ln) {
#pragma unroll
                for (int n = 0; n < 2; ++n) la[bj][n] = *(const f32x4*)(lg + col0 + EPI_COL8(bj) + 4 * n) * ALPHA; } }
        const float* xib = (from_input ? xin_ptr(F, row0) : xrow_ptr(F, row0)) + col0; float* xob = xrow_ptr(F, row0) + col0;
#pragma unroll
        for (int aim = 0; aim < 8; ++aim) { const int ai = aim >> 2, m = aim & 3;
            f32x4 xa[2][2]; f32x2 sv = {0.f, 1.f};
            if (ln) sv = *(const f32x2*)(st + 2 * (size_t)(row0 + EPI_ROWS(ai, m)));
#pragma unroll
            for (int bj = 0; bj < 2; ++bj) { const float* p = xib + (size_t)EPI_ROWS(ai, m) * D + EPI_COL8(bj); xa[bj][0] = *(const f32x4*)p; xa[bj][1] = *(const f32x4*)(p + 4); }
#pragma unroll
            for (int bj = 0; bj < 2; ++bj) { float* p = xob + (size_t)EPI_ROWS(ai, m) * D + EPI_COL8(bj);
                *(f32x4*)p = ((xa[bj][0] - sv[0]) * sv[1]) * la[bj][0] + acc[ai][bj][m][0];
                *(f32x4*)(p + 4) = ((xa[bj][1] - sv[0]) * sv[1]) * la[bj][1] + acc[ai][bj][m][1]; }
            if (m & 1) ROW_FENCE;
        }
    }
};

struct EpiSlab {
    float* slab;
    DI void operator()(Acc& acc, const Unit& u, int wr, int wc, int fr, int fq) const {
        FOR_AI_M { const int r = u.z * MC + u.pm * 256 + EPI_ROWS(ai, m);
#pragma unroll
            for (int bj = 0; bj < 2; ++bj) { float* o = slab + (size_t)r * 1024 + u.pn * 256 + EPI_COL8(bj);
                *(f32x4*)o = acc[ai][bj][m][0]; *(f32x4*)(o + 4) = acc[ai][bj][m][1]; } }
    }
};

struct EpiW1 {
    const Frame& F;
    DI void operator()(Acc& acc, const Unit& u, int wr, int wc, int fr, int fq) const {
        bf16_t* U = (bf16_t*)(F.ws + WS_U);
        FOR_AI_M { const int r = u.pm * 256 + EPI_ROWS(ai, m);
#pragma unroll
            for (int bj = 0; bj < 2; ++bj) { f32x4 a = acc[ai][bj][m][0], b = acc[ai][bj][m][1];
#pragma unroll
                for (int e = 0; e < 4; ++e) { const float x = fmaxf(a[e], 0.f), y = fmaxf(b[e], 0.f); a[e] = x * x; b[e] = y * y; }
                *(u32x4*)(U + (size_t)r * DFF + u.pn * 256 + EPI_COL8(bj)) = pk8(a, b); } }
    }
};

#define MFMA32(a, b, c) __builtin_amdgcn_mfma_f32_32x32x16_bf16((a), (b), (c), 0, 0, 0)
constexpr int ATT_BUF = 22528;
constexpr int ATT_KR = 9216, ATT_V = 14336;
template <int KIND>
DI void attn_unit(const Frame& F, int qrow0, int head, int ctx_row0, int lat_row0, int ntiles) {
    constexpr int ND = KIND == 0 ? 6 : 4;
    unsigned char* ws = F.ws; LAS unsigned char* lds = F.lds;
    int tid_ = F.tid; asm volatile("" : "+v"(tid_));
    const int tid = tid_ & 511, lane = tid & 63, w = __builtin_amdgcn_readfirstlane(tid >> 6), r32 = lane & 31, h5 = lane >> 5;
    const bf16_t *Kp, *Vp, *Qp; bf16_t* Op; int ldk, ldq, ldo;
    if (KIND == 0) { Kp = (const bf16_t*)(ws + WS_KN) + head * 64; Vp = (const bf16_t*)(ws + WS_VM) + head * 64; ldk = 512; Qp = (const bf16_t*)(ws + WS_QM) + head * 96; ldq = 768;
                     Op = (bf16_t*)(ws + WS_AM) + head * 64; ldo = 512; }
    else { Kp = (const bf16_t*)(ws + WS_KG) + (head >> 2) * 64; Vp = (const bf16_t*)(ws + WS_VG) + (head >> 2) * 64; ldk = 128; Qp = (const bf16_t*)(ws + WS_QG) + head * 64; ldq = 512;
           Op = (bf16_t*)(ws + WS_QG) + head * 64; ldo = 512; }
    const bf16_t* Krp = (const bf16_t*)(ws + WS_KR);
    bf16x8 qf[ND];
    { const bf16_t* qr = Qp + (size_t)(qrow0 + 32 * w + r32) * ldq + 8 * h5;
#pragma unroll
      for (int ds = 0; ds < ND; ++ds) qf[ds] = *(const bf16x8*)(qr + 16 * ds); }
    const int skey = tid >> 3, sch = tid & 7;
    const int skey_r = (tid & 255) >> 2, sch_r = tid & 3;
    const unsigned kdst = skey * 144 + sch * 16;
    const unsigned vdst = ATT_V + (sch >> 2) * 4096 + skey * 64 + (sch & 3) * 16;
    const unsigned rdst = ATT_KR + skey_r * 80 + sch_r * 16;
    u32x4 kreg, vreg, rreg;
#define ATT_KEYROW(t) ((t) < 4 ? ctx_row0 + 64 * (t) : lat_row0 + 64 * ((t) - 4))
#define ATT_LOAD(t) do { const int kr_ = ATT_KEYROW(t); kreg = *(const u32x4*)(Kp + (size_t)(kr_ + skey) * ldk + sch * 8); vreg = *(const u32x4*)(Vp + (size_t)(kr_ + skey) * ldk + sch * 8); \
        if (KIND == 0 && tid < 256) rreg = *(const u32x4*)(Krp + (size_t)(kr_ + skey_r) * 32 + sch_r * 8); } while (0)
#define ATT_STORE(buf) do { LAS unsigned char* b_ = lds + (buf) * ATT_BUF; *(LAS u32x4*)(b_ + kdst) = kreg; *(LAS u32x4*)(b_ + vdst) = vreg; \
        if (KIND == 0 && tid < 256) *(LAS u32x4*)(b_ + rdst) = rreg; } while (0)
    const unsigned kbase = r32 * 144 + h5 * 16, rbase = ATT_KR + r32 * 80 + h5 * 16;
    const unsigned voff = ATT_V + (4 * h5 + ((lane & 15) >> 2)) * 64 + ((lane >> 4) & 1) * 32 + (lane & 3) * 8;
    float mref = 0.f, lsum = 0.f;
    f32x16 o0, o1;
#pragma unroll
    for (int i = 0; i < 16; ++i) { o0[i] = 0.f; o1[i] = 0.f; }
#define ATT_LOADK(t) do { const int kr_ = ATT_KEYROW(t); kreg = *(const u32x4*)(Kp + (size_t)(kr_ + skey) * ldk + sch * 8); \
        if (KIND == 0 && tid < 256) rreg = *(const u32x4*)(Krp + (size_t)(kr_ + skey_r) * 32 + sch_r * 8); } while (0)
#define ATT_LOADV(t) do { const int kr_ = ATT_KEYROW(t); vreg = *(const u32x4*)(Vp + (size_t)(kr_ + skey) * ldk + sch * 8); } while (0)
#define ATT_STOREK(buf) do { LAS unsigned char* b_ = lds + (buf) * ATT_BUF; *(LAS u32x4*)(b_ + kdst) = kreg; if (KIND == 0 && tid < 256) *(LAS u32x4*)(b_ + rdst) = rreg; } while (0)
#define ATT_STOREV(buf) do { LAS unsigned char* b_ = lds + (buf) * ATT_BUF; *(LAS u32x4*)(b_ + vdst) = vreg; } while (0)
#define ATT_KFRAG(buf) do { LAS unsigned char* kq_ = lds + (buf) * ATT_BUF; \
        _Pragma("unroll") for (int ds = 0; ds < ND; ++ds) { \
            const unsigned o_ = ds < 4 ? kbase + ds * 32 : rbase + (ds - 4) * 32; const unsigned p_ = ds < 4 ? 32 * 144 : 32 * 80; \
            kf[0][ds] = *(const LAS bf16x8*)(kq_ + o_); kf[1][ds] = *(const LAS bf16x8*)(kq_ + o_ + p_); } } while (0)
#define ATT_QKM(S0, S1, C) do { \
        _Pragma("unroll") for (int ds = 0; ds < ND; ++ds) { \
            if (ds == 0) { S0 = MFMA32(kf[0][0], qf[0], C); S1 = MFMA32(kf[1][0], qf[0], C); } else { S0 = MFMA32(kf[0][ds], qf[ds], S0); S1 = MFMA32(kf[1][ds], qf[ds], S1); } } } while (0)
#define ATT_VFRAG(dst, vb, kb) do { \
        _Pragma("unroll") for (int s = 0; s < 2; ++s) _Pragma("unroll") for (int db = 0; db < 2; ++db) { \
            const unsigned a_ = voff + db * 4096 + (32 * (kb) + 16 * s) * 64; \
            const s16x4 lo = __builtin_bit_cast(s16x4, __builtin_amdgcn_ds_read_tr16_b64_v4i16((LAS s16x4*)((vb) + a_))); \
            const s16x4 hi = __builtin_bit_cast(s16x4, __builtin_amdgcn_ds_read_tr16_b64_v4i16((LAS s16x4*)((vb) + a_ + 512))); \
            dst[s][db] = __builtin_shufflevector(lo, hi, 0, 1, 2, 3, 4, 5, 6, 7); } } while (0)
    bf16x8 kf[2][ND];
    f32x16 s0, s1, n0, n1, negm;
#pragma unroll
    for (int i = 0; i < 16; ++i) negm[i] = 0.f;
#define ATT_LOADK2(t, KR_, RR_) do { const int kr_ = ATT_KEYROW(t); KR_ = *(const u32x4*)(Kp + (size_t)(kr_ + skey) * ldk + sch * 8); \
        if (KIND == 0 && tid < 256) RR_ = *(const u32x4*)(Krp + (size_t)(kr_ + skey_r) * 32 + sch_r * 8); } while (0)
#define ATT_LOADV2(t, VR_) do { const int kr_ = ATT_KEYROW(t); VR_ = *(const u32x4*)(Vp + (size_t)(kr_ + skey) * ldk + sch * 8); } while (0)
#define ATT_STOREK2(buf, KR_, RR_) do { LAS unsigned char* b_ = lds + (buf) * ATT_BUF; *(LAS u32x4*)(b_ + kdst) = KR_; if (KIND == 0 && tid < 256) *(LAS u32x4*)(b_ + rdst) = RR_; } while (0)
#define ATT_STOREV2(buf, VR_) do { LAS unsigned char* b_ = lds + (buf) * ATT_BUF; *(LAS u32x4*)(b_ + vdst) = VR_; } while (0)
#define ATT_BODY(t, KS, VS, RS, KL, VL, RL, C0, C1, N0, N1) do { \
        const bool more = (t + 1 < ntiles), more2 = (t + 2 < ntiles); \
        if (t + 3 < ntiles) ATT_LOADK2(t + 3, KL, RL); \
        if (more2) ATT_LOADV2(t + 2, VL); \
        LAS unsigned char* kb_ = lds + (t & 1) * ATT_BUF; \
        bf16x8 va[2][2], vb2[2][2]; \
        if (more) ATT_KFRAG((t + 1) & 1); \
        __builtin_amdgcn_sched_barrier(0); \
        if (more) { f32x16 ng_; _Pragma("unroll") for (int i = 0; i < 16; ++i) ng_[i] = -mref; ATT_QKM(N0, N1, ng_); } \
        float psa = 0.f, psb = 0.f; \
        _Pragma("unroll") for (int i = 0; i < 16; ++i) { C0[i] = __builtin_amdgcn_exp2f(C0[i]); C1[i] = __builtin_amdgcn_exp2f(C1[i]); psa += C0[i]; psb += C1[i]; } \
        psa += psb; \
        if (__builtin_expect(__any(psa > BIGP), 0)) { \
            float mx = fmaxf(C0[0], C1[0]); \
            _Pragma("unroll") for (int i = 1; i < 16; ++i) mx = fmaxf(mx, fmaxf(C0[i], C1[i])); \
            { auto rr = __builtin_amdgcn_permlane32_swap(__float_as_uint(mx), __float_as_uint(mx), false, false); mx = fmaxf(__uint_as_float(rr[0]), __uint_as_float(rr[1])); } \
            const float dl = mx > 1.f ? ceilf(__log2f(mx)) : 0.f; const float f = __builtin_amdgcn_exp2f(-dl); \
            mref += dl; lsum *= f; psa *= f; \
            _Pragma("unroll") for (int i = 0; i < 16; ++i) { C0[i] *= f; C1[i] *= f; o0[i] *= f; o1[i] *= f; N0[i] -= dl; N1[i] -= dl; } \
        } \
        lsum += psa; \
        bf16x8 pf[2][2]; \
        _Pragma("unroll") for (int s = 0; s < 2; ++s) { \
            u32x4 a, b; \
            a.x = pk2(C0[8 * s + 0], C0[8 * s + 1]); a.y = pk2(C0[8 * s + 2], C0[8 * s + 3]); a.z = pk2(C0[8 * s + 4], C0[8 * s + 5]); a.w = pk2(C0[8 * s + 6], C0[8 * s + 7]); \
            b.x = pk2(C1[8 * s + 0], C1[8 * s + 1]); b.y = pk2(C1[8 * s + 2], C1[8 * s + 3]); b.z = pk2(C1[8 * s + 4], C1[8 * s + 5]); b.w = pk2(C1[8 * s + 6], C1[8 * s + 7]); \
            pf[0][s] = __builtin_bit_cast(bf16x8, a); pf[1][s] = __builtin_bit_cast(bf16x8, b); \
        } \
        ATT_VFRAG(va, kb_, 0); ATT_VFRAG(vb2, kb_, 1); \
        _Pragma("unroll") for (int s = 0; s < 2; ++s) { o0 = MFMA32(va[s][0], pf[0][s], o0); o1 = MFMA32(va[s][1], pf[0][s], o1); } \
        _Pragma("unroll") for (int s = 0; s < 2; ++s) { o0 = MFMA32(vb2[s][0], pf[1][s], o0); o1 = MFMA32(vb2[s][1], pf[1][s], o1); } \
        __builtin_amdgcn_sched_barrier(0); \
        if (more2) ATT_STOREK2(t & 1, KS, RS); \
        if (more) ATT_STOREV2((t + 1) & 1, VS); \
        asm volatile("s_waitcnt lgkmcnt(0)\n\ts_barrier" ::: "memory"); \
    } while (0)
    constexpr float BIGP = 65536.f;
    u32x4 kreg2, vreg2, rreg2;
    ATT_LOADK(0); ATT_LOADV(0); ATT_STOREK(0); ATT_STOREV(0);
    ATT_LOADK(1); ATT_STOREK(1);
    __syncthreads();
    ATT_LOADK2(2, kreg, rreg); ATT_LOADV2(1, vreg);
    ATT_KFRAG(0); ATT_QKM(s0, s1, negm);
    {
        float mx = fmaxf(s0[0], s1[0]);
#pragma unroll
        for (int i = 1; i < 16; ++i) mx = fmaxf(mx, fmaxf(s0[i], s1[i]));
        { auto rr = __builtin_amdgcn_permlane32_swap(__float_as_uint(mx), __float_as_uint(mx), false, false); mx = fmaxf(__uint_as_float(rr[0]), __uint_as_float(rr[1])); }
        mref = mx;
#pragma unroll
        for (int i = 0; i < 16; ++i) { s0[i] -= mx; s1[i] -= mx; }
    }
    for (int t2 = 0; t2 < ntiles; t2 += 2) {
        { const int t = t2; ATT_BODY(t, kreg, vreg, rreg, kreg2, vreg2, rreg2, s0, s1, n0, n1); }
        { const int t = t2 + 1; ATT_BODY(t, kreg2, vreg2, rreg2, kreg, vreg, rreg, n0, n1, s0, s1); }
    }
    { auto rr = __builtin_amdgcn_permlane32_swap(__float_as_uint(lsum), __float_as_uint(lsum), false, false); lsum = __uint_as_float(rr[0]) + __uint_as_float(rr[1]); }
    const float inv = 1.f / lsum;
    {
        LAS unsigned char* stg = lds + 49152 + w * 4608;
        LAS unsigned char* mine = stg + r32 * 144 + 8 * h5;
#pragma unroll
        for (int g = 0; g < 4; ++g) {
            u32x2 a, b;
            a.x = pk2(o0[4 * g] * inv, o0[4 * g + 1] * inv); a.y = pk2(o0[4 * g + 2] * inv, o0[4 * g + 3] * inv);
            b.x = pk2(o1[4 * g] * inv, o1[4 * g + 1] * inv); b.y = pk2(o1[4 * g + 2] * inv, o1[4 * g + 3] * inv);
            *(LAS u32x2*)(mine + 16 * g) = a; *(LAS u32x2*)(mine + 64 + 16 * g) = b;
        }
        asm volatile("s_waitcnt lgkmcnt(0)" ::: "memory");
        bf16_t* ob = Op + (size_t)(qrow0 + 32 * w) * ldo;
#pragma unroll
        for (int it = 0; it < 4; ++it) { const int row = it * 8 + (lane >> 3), ch = lane & 7;
            const u32x4 v = *(const LAS u32x4*)(stg + row * 144 + ch * 16);
            *(u32x4*)(ob + (size_t)row * ldo + ch * 8) = v; }
    }
#undef ATT_LOADK
#undef ATT_LOADV
#undef ATT_STOREK
#undef ATT_STOREV
#undef ATT_KFRAG
#undef ATT_BODY
#undef ATT_LOADK2
#undef ATT_LOADV2
#undef ATT_STOREK2
#undef ATT_STOREV2
#undef ATT_QKM
#undef ATT_VFRAG
#undef ATT_KEYROW
#undef ATT_LOAD
#undef ATT_STORE
}

DI void wave_sum2(float& a, float& b, int lane) {
#pragma unroll
    for (int o = 1; o < 64; o <<= 1) { const float ta = shx(a, o, lane), tb = shx(b, o, lane); a += ta; b += tb; }
}
DI void ln_row_v(const Frame& F, f32x4 (&v)[4], float* xout, const float* g, const float* b, const float* sh, const float* sc, bf16_t* hout, const float* slab, const float* gres, float* stat = nullptr) {
    if (slab) {
#pragma unroll
        for (int j = 0; j < 4; ++j) { f32x4 a = ((const f32x4*)slab)[F.lane + 64 * j];
#pragma unroll
            for (int z = 1; z < 8; ++z) a += ((const f32x4*)(slab + (size_t)z * MC * 1024))[F.lane + 64 * j];
            v[j] = v[j] * ALPHA + ((const f32x4*)gres)[F.lane + 64 * j] * a; }
    }
    if (g) {
        float s = 0.f, s2 = 0.f;
#pragma unroll
        for (int j = 0; j < 4; ++j) { s += (v[j][0] + v[j][1]) + (v[j][2] + v[j][3]); s2 += (v[j][0] * v[j][0] + v[j][1] * v[j][1]) + (v[j][2] * v[j][2] + v[j][3] * v[j][3]); }
        wave_sum2(s, s2, F.lane);
        const float mean = s * (1.f / D); const float rstd = 1.f / sqrtf(fmaxf(s2 * (1.f / D) - mean * mean, 0.f) + EPS);
        if (stat && F.lane == 0) { f32x2 sv = {mean, rstd}; *(f32x2*)stat = sv; }
#pragma unroll
        for (int j = 0; j < 4; ++j) { const f32x4 gg = ((const f32x4*)g)[F.lane + 64 * j], bb = ((const f32x4*)b)[F.lane + 64 * j];
            v[j] = (v[j] - mean) * rstd * gg + bb; if (xout) ((f32x4*)xout)[F.lane + 64 * j] = v[j]; }
    }
    if (hout) {
        float s = 0.f, s2 = 0.f;
#pragma unroll
        for (int j = 0; j < 4; ++j) { s += (v[j][0] + v[j][1]) + (v[j][2] + v[j][3]); s2 += (v[j][0] * v[j][0] + v[j][1] * v[j][1]) + (v[j][2] * v[j][2] + v[j][3] * v[j][3]); }
        wave_sum2(s, s2, F.lane);
        const float mean = s * (1.f / D); const float rstd = 1.f / sqrtf(fmaxf(s2 * (1.f / D) - mean * mean, 0.f) + EPS);
#pragma unroll
        for (int j = 0; j < 4; ++j) { const f32x4 hh = ((const f32x4*)sh)[F.lane + 64 * j], cc = ((const f32x4*)sc)[F.lane + 64 * j];
            const f32x4 o = (v[j] - mean) * rstd * (cc + 1.f) + hh; u32x2 wv; wv.x = pk2(o[0], o[1]); wv.y = pk2(o[2], o[3]);
            ((u32x2*)hout)[F.lane + 64 * j] = wv; }
    }
}
DI void ln_load(const Frame& F, const float* xin, f32x4 (&v)[4]) {
    const f32x4* xr = (const f32x4*)xin + F.lane;
#pragma unroll
    for (int j = 0; j < 4; ++j) v[j] = xr[64 * j];
}
DI void ln_row(const Frame& F, const float* xin, float* xout, const float* g, const float* b, const float* sh, const float* sc, bf16_t* hout, const float* slab = nullptr, const float* gres = nullptr) {
    f32x4 v[4]; ln_load(F, xin, v);
    ln_row_v(F, v, xout, g, b, sh, sc, hout, slab, gres);
}

DI int srcmap(int kind, int n) {
    switch (kind) {
    case 0: {
        if (n < 256) return n;
        if (n < 512) return 1056 + (n - 256);
        if (n < 768) { const int c = n - 512, slot = (c & 127) >> 5, d = 32 * (c >> 7) + (c & 31); return slot < 2 ? 288 + slot * 64 + d : 416 + (slot - 2) * 64 + d; }
        if (n < 1280) { const int t = (n - 768) >> 8, c = (n - 768) & 255, slot = (c & 127) >> 5, d = 32 * (c >> 7) + (c & 31); return 1312 + (4 * t + slot) * 64 + d; }
        return 1824 + (n - 1280); }
    case 1: { const int half = (n & 7) >> 2, i = 4 * (n >> 3) + (n & 3); return 256 + half * 16 + i; }
    case 2: {
        if (n < 512) return (n >> 6) * 96 + (n & 63);
        const int c = n - 512, hd = c >> 5, j = c & 31, half = (j & 7) >> 2, i = 4 * (j >> 3) + (j & 3); return hd * 96 + 64 + half * 16 + i; }
    default: return n;
    }
}
DI void conv_item(const float* W, int K, int ld, int kind, const float* gain, bf16_t* WT, int item, int nblk, LAS float* scr, int lane) {
    const int kb = item / nblk, nb = item % nblk, k0 = 64 * kb, n0 = 32 * nb;
    const int sc_ = srcmap(kind, n0 + (lane & 31));
    float wv[32];
#pragma unroll
    for (int i = 0; i < 32; ++i) wv[i] = W[(size_t)(k0 + 2 * i + (lane >> 5)) * ld + sc_];
    if (gain) {
#pragma unroll
        for (int i = 0; i < 32; ++i) wv[i] *= gain[k0 + 2 * i + (lane >> 5)];
    }
#pragma unroll
    for (int i = 0; i < 32; ++i) scr[(2 * i + (lane >> 5)) * 33 + (lane & 31)] = wv[i];
    asm volatile("s_waitcnt lgkmcnt(0)" ::: "memory");
    const int c = lane & 7;
#pragma unroll
    for (int j = 0; j < 4; ++j) { const int n = (lane >> 3) + 8 * j; const LAS float* s = scr + (8 * c) * 33 + n;
        u32x4 o; o.x = pk2(s[0 * 33], s[1 * 33]); o.y = pk2(s[2 * 33], s[3 * 33]); o.z = pk2(s[4 * 33], s[5 * 33]); o.w = pk2(s[6 * 33], s[7 * 33]);
        *(u32x4*)(WT + (size_t)(n0 + n) * K + k0 + 8 * c) = o; }
    asm volatile("s_waitcnt lgkmcnt(0)" ::: "memory");
}
template <int Q0, int Q1>
DI void convert_weights(const Frame& F, int l, int crank, int ncu) {
    LAS float* scr = (LAS float*)(F.lds + F.wave * 16384);
    unsigned char* W = F.ws + WS_W;
    const int gw = crank * 8 + F.wave, NGW = ncu * 8;
    const float* w_in = pin(F, I_WIN) + (size_t)l * D * INC;
    struct It { const float* src; int K, ld, kind, N; const float* gain; size_t dst; };
    const It its[11] = {
        {w_in, 1024, INC, 0, NIN, nullptr, W_IN},
        {w_in, 1024, INC, 1, 32, nullptr, W_KR},
        {pin(F, I_WUK) + (size_t)l * 256 * 512, 256, 512, 9, 512, pin(F, I_MKVG) + l * 256, W_UKV},
        {pin(F, I_WUV) + (size_t)l * 256 * 512, 256, 512, 9, 512, pin(F, I_MKVG) + l * 256, W_UKV + 512 * 256 * 2},
        {pin(F, I_WUQ) + (size_t)l * 256 * 768, 256, 768, 2, 768, pin(F, I_MQG) + l * 256, W_UQ},
        {pin(F, I_WFO) + (size_t)l * 512 * 1024, 512, 1024, 9, 1024, nullptr, W_FO},
        {pin(F, I_WMO) + (size_t)l * 512 * 1024, 512, 1024, 9, 1024, nullptr, W_MO},
        {pin(F, I_WGO) + (size_t)l * 512 * 1024, 512, 1024, 9, 1024, nullptr, W_GO},
        {pin(F, I_WO) + (size_t)l * 1024 * 1024, 1024, 1024, 9, 1024, nullptr, W_O},
        {pin(F, I_W1) + (size_t)l * 1024 * 4096, 1024, 4096, 9, 4096, nullptr, W_1},
        {pin(F, I_W2) + (size_t)l * 4096 * 1024, 4096, 1024, 9, 1024, nullptr, W_2}};
    int base = 0;
#pragma unroll
    for (int q = Q0; q < Q1; ++q) {
        const int nblk = its[q].N / 32, nit = (its[q].K / 64) * nblk;
        int first = (gw - base) % NGW; if (first < 0) first += NGW;
        for (int it = first; it < nit; it += NGW) conv_item(its[q].src, its[q].K, its[q].ld, its[q].kind, its[q].gain, (bf16_t*)(W + its[q].dst), it, nblk, scr, F.lane);
        base = (base + nit) % NGW;
    }
}
DI void fold_fourier(const Frame& F, int l, int crank, int ncu) {
    __syncthreads();
    LAS float* u = (LAS float*)F.lds;
    LAS float* T = (LAS float*)(F.lds + 32768);
    if (F.tid < 128) T[F.tid] = cospif((float)F.tid * (1.f / 64.f));
    const float* w_in = pin(F, I_WIN) + (size_t)l * D * INC;
    bf16_t* WT = (bf16_t*)(F.ws + WS_W + W_T);
    for (int item = crank; item < 256; item += ncu) {
        const int g = item >> 6, k0 = (item & 63) * 16;
        __syncthreads();
        for (int e = F.tid; e < 16 * 128; e += 512) { const int kk = e >> 7, c = e & 127; u[kk * 129 + c] = w_in[(size_t)(k0 + kk) * INC + 544 + g * 128 + c]; }
        __syncthreads();
        const int kk = F.tid & 15, grp = F.tid >> 4;
        float a[8];
#pragma unroll
        for (int o = 0; o < 8; ++o) a[o] = 0.f;
        for (int c = 0; c < 128; ++c) { const float uv = u[kk * 129 + c];
#pragma unroll
            for (int o = 0; o < 8; ++o) { const int mcs = grp * 8 + o, mm = mcs >> 1, cs = mcs & 1; a[o] += uv * T[(mm * c - 32 * cs) & 127]; } }
#pragma unroll
        for (int o = 0; o < 8; ++o) { const int mcs = grp * 8 + o; unsigned short hv = (unsigned short)(pk2(a[o], 0.f) & 0xffffu); WT[(size_t)(g * 256 + mcs) * 1024 + k0 + kk] = hv; }
    }
    __syncthreads();
}
DI void krope_phase(const Frame& F, int crank, int ncu) {
    const bf16_t* H = (const bf16_t*)(F.ws + WS_HB); const bf16_t* Wk = (const bf16_t*)(F.ws + WS_W + W_KR); bf16_t* KR = (bf16_t*)(F.ws + WS_KR);
    const float* rm = (const float*)(F.ws + WS_ROPEM);
    const int r32 = F.lane & 31, h5 = F.lane >> 5, w = F.wave;
    LAS float* part = (LAS float*)F.lds;
    for (int it = crank; it < MT / 32; it += ncu) {
        const int row0 = it * 32;
        f32x16 acc;
#pragma unroll
        for (int i = 0; i < 16; ++i) acc[i] = 0.f;
        const bf16_t* hp = H + (size_t)(row0 + r32) * 1024 + 8 * h5 + 128 * w; const bf16_t* wp = Wk + (size_t)r32 * 1024 + 8 * h5 + 128 * w;
        bf16x8 a[8], b[8];
#pragma unroll
        for (int q = 0; q < 8; ++q) { a[q] = *(const bf16x8*)(wp + 16 * q); b[q] = *(const bf16x8*)(hp + 16 * q); }
#pragma unroll
        for (int q = 0; q < 8; ++q) acc = MFMA32(a[q], b[q], acc);
        __syncthreads();
#pragma unroll
        for (int i = 0; i < 16; ++i) part[(w * 16 + i) * 64 + F.lane] = acc[i];
        __syncthreads();
        if (w == 0) {
#pragma unroll
            for (int i = 0; i < 16; ++i) { float sacc = 0.f;
#pragma unroll
                for (int q = 0; q < 8; ++q) sacc += part[(q * 16 + i) * 64 + F.lane];
                acc[i] = sacc; }
            const int row = row0 + r32;
            f32x16 oth;
#pragma unroll
            for (int i = 0; i < 16; ++i) oth[i] = shx(acc[i], 32, F.lane);
            u32x2 wv[4];
#pragma unroll
            for (int g = 0; g < 4; ++g) { float o[4];
#pragma unroll
                for (int e = 0; e < 4; ++e) { const int i = 4 * g + e; float x1 = h5 ? oth[i] : acc[i], x2 = h5 ? acc[i] : oth[i]; float cs = 1.f, sn = 0.f;
                    if (row < ML) { cs = rm[(size_t)(row & 2047) * 32 + i]; sn = rm[(size_t)(row & 2047) * 32 + 16 + i]; }
                    o[e] = h5 ? (x1 * sn + x2 * cs) : (x1 * cs - x2 * sn); }
                wv[g].x = pk2(o[0], o[1]); wv[g].y = pk2(o[2], o[3]); }
#pragma unroll
            for (int g = 0; g < 4; ++g) *(u32x2*)(KR + (size_t)row * 32 + 8 * g + 4 * h5) = wv[g];
        }
    }
    __syncthreads();
}

DI void prologue_a(const Frame& F) {
    unsigned char* ws = F.ws;
    convert_weights<0, 5>(F, 0, F.vcu, F.G);
    fold_fourier(F, 0, F.bid, F.G);
    { const int gt = F.bid * 512 + F.tid, NT = F.G * 512;
      float* rm = (float*)(ws + WS_ROPEM); float* rg = (float*)(ws + WS_ROPEG);
      for (int e = gt; e < 2048 * 16; e += NT) { const int pos = e >> 4, i = e & 15; const float fr_ = powf(10000.f, -(float)(i & 7) / 8.f); const float p_ = (i < 8) ? (float)(pos >> 6) : (float)(pos & 63);
          float sn, cs; sincosf(p_ * fr_, &sn, &cs); rm[pos * 32 + i] = cs; rm[pos * 32 + 16 + i] = sn; }
      for (int e = gt; e < 2048 * 32; e += NT) { const int pos = e >> 5, i = e & 31; const float fr_ = powf(10000.f, -(float)(i & 15) / 16.f); const float p_ = (i < 16) ? (float)(pos >> 6) : (float)(pos & 63);
          float sn, cs; sincosf(p_ * fr_, &sn, &cs); rg[pos * 64 + i] = cs; rg[pos * 64 + 32 + i] = sn; }
      bf16_t* dm = (bf16_t*)(ws + WS_DFTM);
      for (int e = gt; e < 2048 * 1024; e += NT) { const int k = e >> 10, j2 = (e & 1023) * 2; unsigned wv[2];
#pragma unroll
          for (int q = 0; q < 2; ++q) { const int j = j2 + q * 2048; float v0, v1; { const int jj = j & 2047; const float a0 = (float)((k * jj) & 2047) * (1.f / 1024.f), a1 = (float)((k * (jj + 1)) & 2047) * (1.f / 1024.f);
              if (j < 2048) { v0 = cospif(a0); v1 = cospif(a1); } else { v0 = -sinpif(a0); v1 = -sinpif(a1); } }
              wv[q] = pk2(v0 * (1.f / 512.f), v1 * (1.f / 512.f)); }
          *(unsigned*)(dm + (size_t)k * 4096 + j2) = wv[0]; *(unsigned*)(dm + (size_t)k * 4096 + 2048 + j2) = wv[1]; }
      bf16_t* dc = (bf16_t*)(ws + WS_DFTMC); const float sc = 0.005524271728019903f;
      for (int e = gt; e < 256 * 512; e += NT) { const int k = e >> 9, j = e & 511, jj = j & 255; const float a0 = (float)((k * jj) & 255) * (1.f / 128.f);
          const float v = (j < 256) ? cospif(a0) : -sinpif(a0); dc[e] = (unsigned short)(pk2(v * sc, 0.f) & 0xffffu); }
    }
    { __syncthreads();
      LAS float* sl = (LAS float*)F.lds;
      LAS float* red = (LAS float*)(F.lds + 36864);
      for (int e = F.tid; e < 9 * 1024; e += 512) { const int r = e >> 10, k = e & 1023; const float c = r < 8 ? pin(F, I_C)[r * 1024 + k] : pin(F, I_CCTX)[k]; sl[e] = c / (1.f + __expf(-c)); }
      __syncthreads();
      const int col = F.tid & 63, kg = F.tid >> 6;
      for (int item = F.bid; item < 4 * 96; item += F.G) {
          const int l = item / 96, cb = (item % 96) * 64;
          const float* wa = pin(F, I_WADA) + (size_t)l * 1024 * 6144 + cb + col;
          float a[9];
#pragma unroll
          for (int r = 0; r < 9; ++r) a[r] = 0.f;
          for (int k0 = kg * 128; k0 < kg * 128 + 128; k0 += 16) { float wv[16];
#pragma unroll
              for (int q = 0; q < 16; ++q) wv[q] = wa[(size_t)(k0 + q) * 6144];
#pragma unroll
              for (int q = 0; q < 16; ++q)
#pragma unroll
                  for (int r = 0; r < 9; ++r) a[r] += sl[r * 1024 + k0 + q] * wv[q]; }
#pragma unroll
          for (int r = 0; r < 9; ++r) red[(kg * 9 + r) * 64 + col] = a[r];
          __syncthreads();
          for (int e = F.tid; e < 9 * 64; e += 512) { const int r = e >> 6, c2 = e & 63; float s = pin(F, I_BADA)[l * 6144 + cb + c2];
#pragma unroll
              for (int q = 0; q < 8; ++q) s += red[(q * 9 + r) * 64 + c2];
              ((float*)(ws + WS_MOD))[(size_t)(l * 9 + r) * 6144 + cb + c2] = s; }
          __syncthreads();
      }
    }
}
DI void prologue_b(const Frame& F) {
    const int gw = F.vcu * 8 + F.wave, NGW = F.G * 8;
    bf16_t* H = (bf16_t*)(F.ws + WS_HB);
    for (int row = gw; row < MT; row += NGW) {
        const int mr = row < ML ? (row >> 11) : 8;
        const float* xi = row < ML ? pin(F, I_X) + (size_t)row * D : pin(F, I_CTX) + (size_t)(row - ML) * D;
        ln_row(F, xi, nullptr, nullptr, nullptr, modp(F, 0, mr, 0), modp(F, 0, mr, 1), H + (size_t)row * D);
    }
}
DI void ln_phase(const Frame& F, int which) {
    const int gw = F.vcu * 8 + F.wave, NGW = F.G * 8; const int l = F.l;
    const int nrows = (l == NL - 1) ? ML : MT;
    bf16_t* H = (bf16_t*)(F.ws + WS_HB);
    const float* g = pin(F, which == 0 ? I_LN1G : I_LN2G) + l * 1024; const float* b = pin(F, which == 0 ? I_LN1B : I_LN2B) + l * 1024;
    const bool wh = !(which == 1 && l == NL - 1);
    f32x4 vc[4], vn[4];
    if (gw < nrows) ln_load(F, xrow_ptr(F, gw), vc);
    for (int row = gw; row < nrows; row += NGW) {
        if (row + NGW < nrows) ln_load(F, xrow_ptr(F, row + NGW), vn);
        const int mr = row < ML ? (row >> 11) : 8;
        const float* sh = which == 0 ? modp(F, l, mr, 3) : modp(F, l + 1 < NL ? l + 1 : l, mr, 0);
        const float* sc = which == 0 ? modp(F, l, mr, 4) : modp(F, l + 1 < NL ? l + 1 : l, mr, 1);
        const bool sl = (which == 1 && row >= ML);
        const bool st_only = row < ML && !(which == 1 && l == NL - 1);
        float* stp = st_only ? (float*)(F.ws + (which == 0 ? WS_ST1 : WS_ST2)) + 2 * (size_t)row : nullptr;
        ln_row_v(F, vc, st_only ? nullptr : xrow_ptr(F, row), g, b, sh, sc, wh ? H + (size_t)row * D : nullptr, sl ? (const float*)(F.ws + WS_KN) + (size_t)(row - ML) * 1024 : nullptr, modp(F, l, mr, 5), stp);
#pragma unroll
        for (int j = 0; j < 4; ++j) vc[j] = vn[j];
    }
}

DI void phase_g1(const Frame& F) {
    const unsigned char* W = F.ws + WS_W; const char* H = (const char*)(F.ws + WS_HB);
    pg8::Sched2 S; S.tileBytes = 256L * 1024 * 2; S.G = F.G; S.c = F.bid;
    S.j0 = pg8::JobD{H, (const char*)(W + W_IN), MT / 256, NIN / 256, 1, 0, 0};
    S.j1 = pg8::JobD{(const char*)(W + W_T), H, 4, MT / 256, 1, 0, 0};
    S.n0 = (MT / 256) * (NIN / 256); S.total = S.n0 + 4 * (MT / 256);
    krope_phase(F, F.bid, F.G);
    EpiG1 E{F};
    pg8::gemm_phase(F.lds, 1024, S, E, F.tid);
}
DI void phase_g2(const Frame& F) {
    const unsigned char* W = F.ws + WS_W;
    pg8::Sched2 S; S.tileBytes = 256L * 256 * 2; S.G = F.G; S.c = F.bid;
    S.j0 = pg8::JobD{(const char*)(F.ws + WS_CKV), (const char*)(W + W_UKV), MT / 256, 4, 1, 0, 0};
    S.j1 = pg8::JobD{(const char*)(F.ws + WS_CQ), (const char*)(W + W_UQ), MT / 256, 3, 1, 0, 0};
    S.n0 = (MT / 256) * 4; S.total = S.n0 + (MT / 256) * 3;
    EpiG2 E{F};
    pg8::gemm_phase(F.lds, 256, S, E, F.tid);
}
DI void phase_att(const Frame& F) {
    const bool lastl = (F.l == NL - 1);
    const int nun = (!lastl && F.vcu < 128) ? 5 : 4;
#pragma unroll 1
    for (int i = 0; i < nun; ++i) {
        int kind, b, h, q0, nt;
        if (i < 4) { const int idx = (i >> 1) * 256 + F.vcu; kind = i & 1; b = idx >> 6; h = (idx >> 3) & 7; q0 = b * SEQ + (idx & 7) * 256; nt = 36; }
        else { const int idx = F.vcu >> 1; kind = F.vcu & 1; b = idx >> 3; h = idx & 7; q0 = ML + b * CTXL; nt = 4; }
        if (kind == 0) attn_unit<0>(F, q0, h, ML + b * CTXL, b * SEQ, nt);
        else attn_unit<1>(F, q0, h, ML + b * CTXL, b * SEQ, nt);
    }
    __syncthreads();
#ifndef NO_DFT
    {
        pg8::Sched2 S; S.tileBytes = 256L * 4096 * 2; S.G = F.G; S.c = (F.bid + 128) & 255;
        S.j0 = pg8::JobD{(const char*)(F.ws + WS_DFTM), (const char*)(F.ws + WS_TF), 8, 2, 8, 0, 1024L * 2048 * 2}; S.j1 = S.j0;
        S.n0 = 128; S.total = 128;
        EpiDft E{(bf16_t*)(F.ws + WS_F), 2048, 512};
        pg8::gemm_phase(F.lds, 4096, S, E, F.tid);
#ifdef PROBE_DFT
        pg8::gemm_phase(F.lds, 4096, S, E, F.tid);
#endif
    }
    if (!lastl) {
        pg8::Sched2 S; S.tileBytes = 256L * 512 * 2; S.G = F.G; S.c = F.bid;
        S.j0 = pg8::JobD{(const char*)(F.ws + WS_DFTMC), (const char*)(F.ws + WS_TFC), 1, 2, 8, 0, 1024L * 256 * 2}; S.j1 = S.j0;
        S.n0 = 16; S.total = 16;
        EpiDft E{(bf16_t*)(F.ws + WS_F) + (size_t)ML * 512, 256, 512};
        pg8::gemm_phase(F.lds, 512, S, E, F.tid);
    }
#endif
    if (F.bid < 128) {
        __syncthreads();
        const int cr = (F.bid & 7) * 16 + (F.bid >> 3);
        convert_weights<5, 11>(F, F.l, cr, 128);
    }
}
DI void phase_g3(const Frame& F) {
    const unsigned char* W = F.ws + WS_W; const int nM = (F.l == NL - 1 ? ML : MT) / 256;
    pg8::Sched3 S; S.tileBytes = 256L * 512 * 2; S.G = F.G; S.c = F.bid; S.ntiles = nM * 4;
    S.j = pg8::JobD{(const char*)(F.ws + WS_F), (const char*)(W + W_FO), nM, 4, 1, 0, 0};
    S.A1 = (const char*)(F.ws + WS_AM); S.B1 = (const char*)(W + W_MO); S.A2 = (const char*)(F.ws + WS_QG); S.B2 = (const char*)(W + W_GO);
    EpiG3 E{F};
    pg8::gemm_phase(F.lds, 512, S, E, F.tid);
    if (F.l + 1 < NL && F.bid >= 32) {
        __syncthreads();
        convert_weights<0, 5>(F, F.l + 1, F.bid - 32, F.G - 32); fold_fourier(F, F.l + 1, F.bid - 32, F.G - 32);
    }
}
DI void phase_g4(const Frame& F) {
    const unsigned char* W = F.ws + WS_W; const int nM = (F.l == NL - 1 ? ML : MT) / 256;
    pg8::Sched2 S; S.tileBytes = 256L * 1024 * 2; S.G = F.G; S.c = F.bid;
    S.j0 = pg8::JobD{(const char*)(F.ws + WS_HB), (const char*)(W + W_O), nM, 4, 1, 0, 0}; S.j1 = S.j0; S.n0 = nM * 4; S.total = S.n0;
    EpiRes E{F, 2, true, F.l > 0 ? 2 : 0};
    pg8::gemm_phase(F.lds, 1024, S, E, F.tid);
}
DI void phase_g5(const Frame& F) {
    const unsigned char* W = F.ws + WS_W; const int nM = (F.l == NL - 1 ? ML : MT) / 256;
    pg8::Sched2 S; S.tileBytes = 256L * 1024 * 2; S.G = F.G; S.c = F.bid;
    S.j0 = pg8::JobD{(const char*)(F.ws + WS_HB), (const char*)(W + W_1), nM, 16, 1, 0, 0}; S.j1 = S.j0; S.n0 = nM * 16; S.total = S.n0;
    EpiW1 E{F};
    pg8::gemm_phase(F.lds, 1024, S, E, F.tid);
#ifdef PROBE_G5
    pg8::gemm_phase(F.lds, 1024, S, E, F.tid);
#endif
}
DI void phase_g6(const Frame& F) {
    const unsigned char* W = F.ws + WS_W;
    {
        pg8::Sched2 S; S.tileBytes = 256L * 4096 * 2; S.G = F.G; S.c = F.bid;
        S.j0 = pg8::JobD{(const char*)(F.ws + WS_U), (const char*)(W + W_2), ML / 256, 4, 1, 0, 0}; S.j1 = S.j0; S.n0 = (ML / 256) * 4; S.total = S.n0;
        EpiRes E{F, 5, false, 1};
        pg8::gemm_phase(F.lds, 4096, S, E, F.tid);
    }
    if (F.l < NL - 1) {
        pg8::Sched2 S; S.tileBytes = 256L * 4096 * 2; S.G = F.G; S.c = F.bid;
        S.j0 = pg8::JobD{(const char*)(F.ws + WS_U) + (size_t)ML * 4096 * 2, (const char*)(W + W_2), MC / 256, 4, 8, 512 * 2, 512 * 2}; S.j1 = S.j0; S.n0 = (MC / 256) * 4 * 8; S.total = S.n0;
        EpiSlab E{(float*)(F.ws + WS_KN)};
        pg8::gemm_phase<4096>(F.lds, 512, S, E, F.tid);
    }
}

constexpr int N_PHASES = 2 + 9 * NL;
template <int ONLY>
__global__ void __launch_bounds__(512, 2) fwd_kernel(Params prm) {
    extern __shared__ __attribute__((aligned(16))) unsigned char lds_raw[];
    Frame F;
    F.P = &prm; F.ws = prm.ws; F.lds = (LAS unsigned char*)lds_raw;
    F.tid = threadIdx.x; F.lane = F.tid & 63; F.wave = __builtin_amdgcn_readfirstlane(F.tid >> 6);
    F.G = gridDim.x; F.bid = blockIdx.x; F.vcu = (F.G % 8 == 0) ? (F.bid % 8) * (F.G / 8) + F.bid / 8 : F.bid; F.l = 0;
    volatile LAS unsigned* MISC = (volatile LAS unsigned*)(F.lds + MISC_OFF);
    for (int u = F.tid; u < (LDS_BYTES - RING_BYTES) / 4; u += 512) ((LAS unsigned*)(F.lds + RING_BYTES))[u] = 0u;
    __syncthreads();
#if MK_ONE_LAUNCH
    const int lo = 0, hi = N_PHASES;
#else
    const int lo = prm.ph_lo, hi = prm.ph_hi;
#endif
    XcdBarrier bar; bar.bar = (unsigned*)(F.ws + WS_CTL) + 4096; bar.x = 0; bar.st = nullptr;
    if (hi - lo > 1) {
        bar = xcd_barrier_post((unsigned*)(F.ws + WS_CTL) + 4096, MISC + 8);
        cg::this_grid().sync();
        if (threadIdx.x == 0) { unsigned nloc, nx; xcd_barrier_complete(bar.bar, bar.x, nloc, nx); bar.st[0] = nloc; bar.st[1] = nx; }
        __syncthreads();
    }
    const int wave_s = __builtin_amdgcn_readfirstlane(threadIdx.x >> 6);
    for (int ph = lo; ph < hi; ++ph) {
        { int lane_; asm volatile("v_mbcnt_lo_u32_b32 %0, -1, 0\n\tv_mbcnt_hi_u32_b32 %0, -1, %0" : "=v"(lane_));
          int z_ = 0, b_ = blockIdx.x, g_ = gridDim.x, t_ = wave_s * 64 + lane_;
#if (OPQ_MASK & 1)
          asm volatile("" : "+s"(z_));
#endif
#if (OPQ_MASK & 2)
          asm volatile("" : "+s"(b_), "+s"(g_));
#endif
#if (OPQ_MASK & 4)
          asm volatile("" : "+v"(t_));
#endif
          F.ws = prm.ws + z_; F.zo = z_;
          b_ &= 1023; g_ &= 1023; F.bid = b_; F.G = g_; F.vcu = (g_ % 8 == 0) ? (b_ % 8) * (g_ / 8) + b_ / 8 : b_; F.tid = t_ & 511; F.lane = t_ & 63; F.wave = __builtin_amdgcn_readfirstlane((t_ & 511) >> 6); }
        if constexpr (ONLY >= 0) {
            F.l = ph < 2 ? 0 : (ph - 2) / 9;
            if constexpr (ONLY == 100) prologue_a(F);
            else if constexpr (ONLY == 101) prologue_b(F);
            else if constexpr (ONLY == 0) phase_g1(F);
            else if constexpr (ONLY == 1) phase_g2(F);
            else if constexpr (ONLY == 2) phase_att(F);
            else if constexpr (ONLY == 3) phase_g3(F);
            else if constexpr (ONLY == 4) phase_g4(F);
            else if constexpr (ONLY == 5) ln_phase(F, 0);
            else if constexpr (ONLY == 6) phase_g5(F);
            else if constexpr (ONLY == 7) phase_g6(F);
            else ln_phase(F, 1);
            continue;
        }
        if (ph == 0) prologue_a(F);
        else if (ph == 1) prologue_b(F);
        else {
            const int q = ph - 2; F.l = q / 9; const int sub = q - F.l * 9;
            switch (sub) {
            case 0: phase_g1(F); break;
            case 1: phase_g2(F); break;
            case 2: phase_att(F); break;
            case 3: phase_g3(F); break;
            case 4: phase_g4(F); break;
            case 5: ln_phase(F, 0); break;
            case 6: phase_g5(F); break;
            case 7: phase_g6(F); break;
            default: ln_phase(F, 1); break;
            }
        }
        if (ph + 1 < hi) { XcdBarrier b2; b2.bar = (unsigned*)(F.ws + WS_CTL) + 4096; b2.x = xb_xcc_id(); b2.st = (volatile LAS unsigned*)(F.lds + MISC_OFF) + 8; xcd_barrier(b2, F.tid); }
    }
}

extern "C" void kernel_launch(void* const* d_in, const int* in_sizes, int n_in, void* d_out, int out_size, void* d_ws, size_t ws_size, hipStream_t stream) {
    static int grid = 0;
    if (grid == 0) {
        if (n_in != 25 || out_size != ML * D || ws_size < WS_END) { fprintf(stderr, "kernel_launch: unexpected shapes (n_in %d out %d ws %zu)\n", n_in, out_size, ws_size); grid = -1; return; }
        int dev = 0, cus = 0, per_cu = 0;
        (void)hipGetDevice(&dev); (void)hipDeviceGetAttribute(&cus, hipDeviceAttributeMultiprocessorCount, dev);
#if MK_ONE_LAUNCH
        (void)hipFuncSetAttribute((const void*)fwd_kernel<-1>, hipFuncAttributeMaxDynamicSharedMemorySize, LDS_BYTES);
        (void)hipOccupancyMaxActiveBlocksPerMultiprocessor(&per_cu, (const void*)fwd_kernel<-1>, 512, LDS_BYTES);
#else
        (void)hipFuncSetAttribute((const void*)fwd_kernel<100>, hipFuncAttributeMaxDynamicSharedMemorySize, LDS_BYTES);
        (void)hipFuncSetAttribute((const void*)fwd_kernel<101>, hipFuncAttributeMaxDynamicSharedMemorySize, LDS_BYTES);
        (void)hipFuncSetAttribute((const void*)fwd_kernel<0>, hipFuncAttributeMaxDynamicSharedMemorySize, LDS_BYTES);
        (void)hipFuncSetAttribute((const void*)fwd_kernel<1>, hipFuncAttributeMaxDynamicSharedMemorySize, LDS_BYTES);
        (void)hipFuncSetAttribute((const void*)fwd_kernel<2>, hipFuncAttributeMaxDynamicSharedMemorySize, LDS_BYTES);
        (void)hipFuncSetAttribute((const void*)fwd_kernel<3>, hipFuncAttributeMaxDynamicSharedMemorySize, LDS_BYTES);
        (void)hipFuncSetAttribute((const void*)fwd_kernel<4>, hipFuncAttributeMaxDynamicSharedMemorySize, LDS_BYTES);
        (void)hipFuncSetAttribute((const void*)fwd_kernel<5>, hipFuncAttributeMaxDynamicSharedMemorySize, LDS_BYTES);
        (void)hipFuncSetAttribute((const void*)fwd_kernel<6>, hipFuncAttributeMaxDynamicSharedMemorySize, LDS_BYTES);
        (void)hipFuncSetAttribute((const void*)fwd_kernel<7>, hipFuncAttributeMaxDynamicSharedMemorySize, LDS_BYTES);
        (void)hipFuncSetAttribute((const void*)fwd_kernel<8>, hipFuncAttributeMaxDynamicSharedMemorySize, LDS_BYTES);
#endif
        (void)hipGetLastError();
        if (per_cu < 1) per_cu = 1;
        grid = cus;
        if (grid != 256) fprintf(stderr, "kernel_launch: grid %d (expected 256)\n", grid);
    }
    if (grid < 0) return;
    (void)hipMemsetAsync((char*)d_ws + WS_CTL, 0, CTL_BYTES, stream);
    Params p{};
    for (int i = 0; i < 25; ++i) p.in[i] = (const float*)d_in[i];
    p.out = (float*)d_out; p.ws = (unsigned char*)d_ws;
#if MK_ONE_LAUNCH
    p.ph_lo = 0; p.ph_hi = N_PHASES;
    void* args[] = {&p};
    hipError_t e = hipLaunchCooperativeKernel((const void*)fwd_kernel<-1>, dim3(grid), dim3(512), args, LDS_BYTES, stream);
    if (e != hipSuccess) fprintf(stderr, "cooperative launch failed: %s\n", hipGetErrorString(e));
#else
    for (int ph = 0; ph < N_PHASES; ++ph) {
        p.ph_lo = ph; p.ph_hi = ph + 1;
        const int sub = ph < 2 ? 100 + ph : (ph - 2) % 9;
        switch (sub) {
        case 100: hipLaunchKernelGGL(fwd_kernel<100>, dim3(grid), dim3(512), LDS_BYTES, stream, p); break;
        case 101: hipLaunchKernelGGL(fwd_kernel<101>, dim3(grid), dim3(512), LDS_BYTES, stream, p); break;
        case 0: hipLaunchKernelGGL(fwd_kernel<0>, dim3(grid), dim3(512), LDS_BYTES, stream, p); break;
        case 1: hipLaunchKernelGGL(fwd_kernel<1>, dim3(grid), dim3(512), LDS_BYTES, stream, p); break;
        case 2: hipLaunchKernelGGL(fwd_kernel<2>, dim3(grid), dim3(512), LDS_BYTES, stream, p); break;
        case 3: hipLaunchKernelGGL(fwd_kernel<3>, dim3(grid), dim3(512), LDS_BYTES, stream, p); break;
        case 4: hipLaunchKernelGGL(fwd_kernel<4>, dim3(grid), dim3(512), LDS_BYTES, stream, p); break;
        case 5: hipLaunchKernelGGL(fwd_kernel<5>, dim3(grid), dim3(512), LDS_BYTES, stream, p); break;
        case 6: hipLaunchKernelGGL(fwd_kernel<6>, dim3(grid), dim3(512), LDS_BYTES, stream, p); break;
        case 7: hipLaunchKernelGGL(fwd_kernel<7>, dim3(grid), dim3(512), LDS_BYTES, stream, p); break;
        default: hipLaunchKernelGGL(fwd_kernel<8>, dim3(grid), dim3(512), LDS_BYTES, stream, p); break;
        }
    }
#endif
}
```

```cpp
#include <hip/hip_runtime.h>
#include <hip/hip_cooperative_groups.h>
#include <cstdio>
#include <cstdint>
namespace cg = cooperative_groups;

#ifndef IGLP_K
#define IGLP_K 2
#endif
#define LAS __attribute__((address_space(3)))
#define DI __device__ __forceinline__
typedef unsigned short bf16_t;
typedef short bf16x8 __attribute__((ext_vector_type(8)));
typedef short s16x4 __attribute__((ext_vector_type(4)));
typedef float f32x2 __attribute__((ext_vector_type(2)));
typedef float f32x4 __attribute__((ext_vector_type(4)));
typedef float f32x16 __attribute__((ext_vector_type(16)));
typedef unsigned u32x4 __attribute__((ext_vector_type(4)));
typedef unsigned u32x2 __attribute__((ext_vector_type(2)));
typedef __bf16 bf16x2_t __attribute__((ext_vector_type(2)));

#ifndef MK_ONE_LAUNCH
#define MK_ONE_LAUNCH 1
#endif
#ifndef OPQ_MASK
#if MK_ONE_LAUNCH
#define OPQ_MASK 7
#else
#define OPQ_MASK 0
#endif
#endif

constexpr int D = 1024, NB = 8, SEQ = 2048, CTXL = 256, NL = 4;
constexpr int ML = NB * SEQ, MC = NB * CTXL, MT = ML + MC;
constexpr int DFF = 4096, INC = 4896;
constexpr float EPS = 1e-6f;
constexpr float ALPHA = 1.6817928305074290f;
constexpr float QS_MLA = (float)(0.10206207261596575 * 1.4426950408889634);
constexpr float QS_GQA = (float)(0.125 * 1.4426950408889634);
constexpr int NIN = 4352;

constexpr size_t MiB = 1u << 20;
constexpr size_t WS_CTL = 0, CTL_BYTES = 65536;
constexpr size_t WS_MOD = 1 * MiB;
constexpr size_t WS_ROPEM = 2 * MiB;
constexpr size_t WS_ROPEG = 2 * MiB + 262144;
constexpr size_t WS_SSKV = 3 * MiB, WS_SSQ = 3 * MiB + 524288;
constexpr size_t WS_DFTMC = 4 * MiB;
constexpr size_t WS_ST1 = 4 * MiB + 524288, WS_ST2 = 4 * MiB + 786432;
constexpr size_t WS_DFTM = 5 * MiB;
constexpr size_t WS_W = 21 * MiB;
constexpr size_t W_IN = 0, W_KR = 8 * MiB + 524288, W_T = 9 * MiB, W_UKV = 11 * MiB, W_UQ = 11 * MiB + 524288, W_FO = 12 * MiB, W_MO = 13 * MiB,
                 W_GO = 14 * MiB, W_O = 15 * MiB, W_1 = 17 * MiB, W_2 = 25 * MiB;
constexpr size_t WS_XC = 54 * MiB;
constexpr size_t WS_HB = 62 * MiB;
constexpr size_t WS_CKV = 98 * MiB, WS_CQ = 107 * MiB, WS_KG = 116 * MiB, WS_VG = 120 * MiB + 524288, WS_QG = 125 * MiB, WS_KR = 143 * MiB;
constexpr size_t WS_KN = 145 * MiB, WS_VM = 163 * MiB, WS_QM = 181 * MiB;
constexpr size_t WS_F = 208 * MiB, WS_AM = 226 * MiB;
constexpr size_t WS_GATE = 244 * MiB, WS_TF = 352 * MiB, WS_TFC = 384 * MiB, WS_U = 244 * MiB;
constexpr size_t WS_END = 388 * MiB;

constexpr int LDS_BYTES = 147456, RING_BYTES = 131072, MISC_OFF = RING_BYTES + 320;

struct Params {
    const float* in[25];
    float* out;
    unsigned char* ws;
    int ph_lo, ph_hi;
};
enum { I_X = 0, I_C, I_CTX, I_CCTX, I_WADA, I_BADA, I_WIN, I_BGATE, I_MQG, I_MKVG, I_WUQ, I_WUK, I_WUV, I_GQG, I_GKG, I_WFO, I_WMO, I_WGO, I_WO,
       I_LN1G, I_LN1B, I_W1, I_W2, I_LN2G, I_LN2B };

DI unsigned pk2(float lo, float hi) { f32x2 v = {lo, hi}; bf16x2_t b = __builtin_convertvector(v, bf16x2_t); return __builtin_bit_cast(unsigned, b); }
DI u32x4 pk8(const f32x4& a, const f32x4& b) { u32x4 w; w.x = pk2(a[0], a[1]); w.y = pk2(a[2], a[3]); w.z = pk2(b[0], b[1]); w.w = pk2(b[2], b[3]); return w; }
DI float bf2f(unsigned short h) { return __uint_as_float((unsigned)h << 16); }
DI void unpk8(const u32x4& w, float* f) {
    f[0] = __uint_as_float(w.x << 16); f[1] = __uint_as_float(w.x & 0xffff0000u); f[2] = __uint_as_float(w.y << 16); f[3] = __uint_as_float(w.y & 0xffff0000u);
    f[4] = __uint_as_float(w.z << 16); f[5] = __uint_as_float(w.z & 0xffff0000u); f[6] = __uint_as_float(w.w << 16); f[7] = __uint_as_float(w.w & 0xffff0000u);
}
DI float shx(float v, int m, int lane) { return __int_as_float(__builtin_amdgcn_ds_bpermute((lane ^ m) << 2, __float_as_int(v))); }
DI float wave_sum(float v, int lane) {
#pragma unroll
    for (int o = 1; o < 64; o <<= 1) v += shx(v, o, lane);
    return v;
}

#define XB_TMO      128
#define XB_XCNT(j)  (256  + 64 * (j))
#define XB_XSUB(j)  (1280 + 64 * (j))
#define XB_XGEN(j)  (2304 + 64 * (j))
#define XB_TOP      3328
#define XB_TOPGEN   3392
#define XB_SPIN_CAP (1u << 22)
DI unsigned xb_ld(unsigned* p)              { return __hip_atomic_load(p, __ATOMIC_RELAXED, __HIP_MEMORY_SCOPE_AGENT); }
DI unsigned xb_add(unsigned* p, unsigned v) { return __hip_atomic_fetch_add(p, v, __ATOMIC_RELAXED, __HIP_MEMORY_SCOPE_AGENT); }
DI unsigned xb_xcc_id() { return (unsigned)__builtin_amdgcn_s_getreg((3 << 11) | 20) & 0xFu; }
#define XB_SPIN(cond, bar) do { unsigned _sp = 0; while (cond) { __builtin_amdgcn_s_sleep(1); \
    if ((++_sp & 255u) == 0u) { if (xb_ld(&(bar)[XB_TMO])) break; if (_sp > XB_SPIN_CAP) { atomicAdd(&(bar)[XB_TMO], 1u); break; } } } } while (0)
struct XcdBarrier { unsigned* bar; unsigned x; volatile LAS unsigned* st; };
DI XcdBarrier xcd_barrier_post(unsigned* bar, volatile LAS unsigned* st) {
    XcdBarrier b; b.bar = bar; b.x = xb_xcc_id(); b.st = st;
    if (threadIdx.x == 0) (void)xb_add(&bar[XB_XCNT(b.x)], 1u);
    return b;
}
DI void xcd_barrier_complete(unsigned* bar, unsigned x, unsigned& nloc, unsigned& nx) {
    const unsigned G = gridDim.x * gridDim.y * gridDim.z;
    unsigned sum, cnt, mine, sp = 0u;
    for (;;) {
        sum = 0u; cnt = 0u; mine = 0u;
#pragma unroll
        for (unsigned j = 0; j < 16; ++j) { const unsigned c = xb_ld(&bar[XB_XCNT(j)]); sum += c; cnt += (c > 0u) ? 1u : 0u; mine = (j == x) ? c : mine; }
        if (sum == G) break;
        __builtin_amdgcn_s_sleep(1);
        if ((++sp & 255u) == 0u) { if (xb_ld(&bar[XB_TMO])) break; if (sp > XB_SPIN_CAP) { atomicAdd(&bar[XB_TMO], 1u); break; } }
    }
    nloc = mine > 0u ? mine : 1u; nx = cnt > 0u ? cnt : 1u;
}
DI void xcd_barrier(const XcdBarrier& b, const int tid) {
    asm volatile("s_waitcnt vmcnt(0)" ::: "memory");
    __syncthreads();
    if (tid == 0) {
        unsigned* bar = b.bar;
        __builtin_amdgcn_s_waitcnt(0);
        unsigned nloc = b.st[0], nx = b.st[1];
        const unsigned old = xb_add(&bar[XB_XSUB(b.x)], 1u);
        const unsigned gen = old / nloc;
        if (old + 1u == (gen + 1u) * nloc) {
            __builtin_amdgcn_fence(__ATOMIC_RELEASE, "agent");
            asm volatile("s_waitcnt vmcnt(0)" ::: "memory");
            const unsigned og = xb_add(&bar[XB_TOP], 1u);
            const unsigned tg = og / nx;
            if (og + 1u == (tg + 1u) * nx) xb_add(&bar[XB_TOPGEN], 1u);
            else XB_SPIN(xb_ld(&bar[XB_TOPGEN]) == tg, bar);
            __builtin_amdgcn_fence(__ATOMIC_ACQUIRE, "agent");
            xb_add(&bar[XB_XGEN(b.x)], 1u);
            asm volatile("s_waitcnt vmcnt(0)" ::: "memory");
        } else {
            XB_SPIN(xb_ld(&bar[XB_XGEN(b.x)]) == gen, bar);
            __builtin_amdgcn_fence(__ATOMIC_ACQUIRE, "agent");
            asm volatile("s_waitcnt vmcnt(0)" ::: "memory");
        }
    }
    __syncthreads();
}

namespace pg8 {
constexpr int BM = 256, BK = 64, HALF = 128, HTB = HALF * BK * 2;
DI int lds_byte(int r, int c) { const int st = (r >> 4) * 2 + (c >> 5), rr = r & 15, cc = c & 31, ob = rr * 64 + cc * 2; return st * 1024 + (ob ^ (((ob >> 9) & 1) << 5)); }
DI void stage_rc(int b, int& R, int& C) { const int st = b / 1024, sb = b % 1024, swz = sb ^ (((sb >> 9) & 1) << 5); R = (st >> 1) * 16 + swz / 64; C = (st & 1) * 32 + (swz % 64) / 2; }
DI int perm32(int rho) { const int n = rho >> 4, i = rho & 15; return 8 * (i >> 2) + 4 * n + (i & 3); }

struct Unit { const char* A; const char* B; int job, pm, pn, z, seg; bool last; };
struct JobD { const char* A; const char* B; int nM, nN, nZ; long Az, Bz; };
DI void decode(const JobD& j, int t, long tileBytes, int jobid, Unit& u) {
    const int nMt = j.nM * j.nZ, nwg = nMt * j.nN;
    int wg; { const int q = nwg >> 3, r = nwg & 7, xcd = t & 7, off = t >> 3; wg = (xcd < r ? xcd * (q + 1) : r * (q + 1) + (xcd - r) * q) + off; }
    const int nig = 8 * j.nN, gid = wg / nig, fm = gid * 8, gsz = (nMt - fm) < 8 ? (nMt - fm) : 8;
    const int rem = wg - gid * nig, pn = rem / gsz, pmt = fm + (rem - pn * gsz);
    const int z = pmt / j.nM, pm = pmt - z * j.nM;
    u.A = j.A + (long)z * j.Az + (long)pm * tileBytes; u.B = j.B + (long)z * j.Bz + (long)pn * tileBytes;
    u.job = jobid; u.pm = pm; u.pn = pn; u.z = z; u.seg = 0; u.last = true;
}
struct Sched2 {
    JobD j0, j1; int n0, total, G, c; long tileBytes;
    DI bool next(int i, Unit& u) const {
        const long L = (long)i * G + c; if (L >= total) return false;
        if ((int)L < n0) decode(j0, (int)L, tileBytes, 0, u); else decode(j1, (int)L - n0, tileBytes, 1, u);
        return true;
    }
};
struct Sched3 {
    JobD j; const char* A1; const char* A2; const char* B1; const char* B2; int ntiles, G, c; long tileBytes;
    DI bool next(int i, Unit& u) const {
        const int ti = i / 3, seg = i - ti * 3; const long L = (long)ti * G + c; if (L >= ntiles) return false;
        decode(j, (int)L, tileBytes, 0, u);
        if (seg == 1) { u.A = A1 + (u.A - j.A); u.B = B1 + (u.B - j.B); }
        if (seg == 2) { u.A = A2 + (u.A - j.A); u.B = B2 + (u.B - j.B); }
        u.seg = seg; u.last = (seg == 2);
        return true;
    }
};

typedef f32x4 Acc[2][2][4][2];
template <int PITCH = 0, class Epi, class Sched>
DI void gemm_phase(LAS unsigned char* lds, const int K_, const Sched& S, const Epi& E, const int tid_in) {
    int Kq = K_; asm volatile("" : "+s"(Kq)); const int K = Kq & 0x1fc0;
    int tid_ = tid_in;
#ifndef NO_OPQ_TID
    asm volatile("" : "+v"(tid_));
#endif
    const int tid = tid_ & 511, wid = __builtin_amdgcn_readfirstlane(tid >> 6), lane = tid & 63, wr = wid >> 2, wc = wid & 3, fr = lane & 15, fq = lane >> 4;
    const int nt = K / BK;
    unsigned voffA[2], voffB[2];
#pragma unroll
    for (int i = 0; i < 2; ++i) { int R, C; stage_rc(tid * 16 + i * 8192, R, C); const int Rb = (R & ~31) + perm32(R & 31);
        voffA[i] = (unsigned)(R * (PITCH ? PITCH : K) + C) * 2u; voffB[i] = (unsigned)(Rb * (PITCH ? PITCH : K) + C) * 2u; }
    const size_t kstep = (size_t)(BK * 2);
    const size_t hstep = (size_t)HALF * (PITCH ? PITCH : K) * 2;
    const unsigned ldsw = (unsigned)wid * 1024u;
    const int aoff = lds_byte(wr * 64 + fr, fq * 8), boff = lds_byte(wc * 32 + fr, fq * 8);
#define PG8_SA(b, h) (((b) * 2 + (h)) * HTB)
#define PG8_SB(b, h) ((4 + (b) * 2 + (h)) * HTB)
#define PG8_STAGE(bufoff, gbase, voff) do { _Pragma("unroll") for (int _i = 0; _i < 2; ++_i) \
        __builtin_amdgcn_global_load_lds((const unsigned*)((const char*)(gbase) + (voff)[_i]), (LAS unsigned*)(lds + (bufoff) + ldsw + _i * 8192), 16, 0, 0); } while (0)
#define PG8_LDA(dst, b, h) do { _Pragma("unroll") for (int m = 0; m < 4; ++m) _Pragma("unroll") for (int k = 0; k < 2; ++k) dst[m][k] = *(const LAS bf16x8*)(lds + PG8_SA(b, h) + aoff + m * 2048 + k * 1024); } while (0)
#define PG8_LDB(dst, b, h) do { _Pragma("unroll") for (int n = 0; n < 2; ++n) _Pragma("unroll") for (int k = 0; k < 2; ++k) dst[n][k] = *(const LAS bf16x8*)(lds + PG8_SB(b, h) + boff + n * 2048 + k * 1024); } while (0)
#define PG8_MMA(ai, bj, At, Bt) do { __builtin_amdgcn_s_setprio(1); _Pragma("unroll") for (int m = 0; m < 4; ++m) _Pragma("unroll") for (int n = 0; n < 2; ++n) _Pragma("unroll") for (int k = 0; k < 2; ++k) \
        acc[ai][bj][m][n] = __builtin_amdgcn_mfma_f32_16x16x32_bf16(Bt[n][k], At[m][k], acc[ai][bj][m][n], 0, 0, 0); __builtin_amdgcn_s_setprio(0); } while (0)
#define PG8_WAIT_V(n) asm volatile("s_waitcnt vmcnt(" #n ")" ::: "memory")
#define PG8_WAIT_L(n) asm volatile("s_waitcnt lgkmcnt(" #n ")" ::: "memory")
#define PG8_BAR __builtin_amdgcn_s_barrier()
#define PG8_SCHED __builtin_amdgcn_sched_barrier(0)
    Unit cur, nxt; int ui = 0;
    if (!S.next(0, cur)) return;
    Acc acc;
#pragma unroll
    for (int a = 0; a < 2; ++a)
#pragma unroll
        for (int b = 0; b < 2; ++b)
#pragma unroll
            for (int m = 0; m < 4; ++m)
#pragma unroll
                for (int n = 0; n < 2; ++n) acc[a][b][m][n] = (f32x4){0.f, 0.f, 0.f, 0.f};
    bf16x8 At[4][2], B0[2][2], B1[2][2];
    const char* cA = cur.A; const char* cB = cur.B;
    PG8_STAGE(PG8_SB(0, 0), cB, voffB); PG8_STAGE(PG8_SB(0, 1), cB + hstep, voffB); PG8_STAGE(PG8_SA(0, 0), cA, voffA); PG8_STAGE(PG8_SA(0, 1), cA + hstep, voffA);
    if (wr == 1) PG8_BAR;
    PG8_WAIT_V(2); PG8_BAR;
    PG8_STAGE(PG8_SB(1, 0), cB + kstep, voffB); PG8_STAGE(PG8_SA(1, 0), cA + kstep, voffA); PG8_STAGE(PG8_SB(1, 1), cB + hstep + kstep, voffB);
    PG8_WAIT_V(6); PG8_BAR;
    for (;;) {
        const bool has_next = S.next(ui + 1, nxt);
        const char* nA = has_next ? nxt.A : cA; const char* nB = has_next ? nxt.B : cB;
        for (int t = 0; t < nt; t += 2) {
            const bool last = (t == nt - 2);
            const char* a1 = cA + (size_t)(t + 1) * kstep;
            const char* a2 = last ? nA : cA + (size_t)(t + 2) * kstep; const char* b2 = last ? nB : cB + (size_t)(t + 2) * kstep;
            const char* a3 = a2 + kstep; const char* b3 = b2 + kstep;
            PG8_LDB(B0, 0, 0); PG8_LDB(B1, 0, 1); PG8_SCHED; PG8_LDA(At, 0, 0); PG8_STAGE(PG8_SA(1, 1), a1 + hstep, voffA);
            PG8_WAIT_V(8); PG8_WAIT_L(0); PG8_BAR; PG8_MMA(0, 0, At, B0); PG8_MMA(0, 1, At, B1); PG8_BAR; PG8_SCHED;
            PG8_LDA(At, 0, 1); PG8_STAGE(PG8_SB(0, 0), b2, voffB); PG8_STAGE(PG8_SB(0, 1), b2 + hstep, voffB); PG8_STAGE(PG8_SA(0, 0), a2, voffA);
            PG8_WAIT_V(8); PG8_WAIT_L(0); PG8_BAR; PG8_MMA(1, 0, At, B0); PG8_MMA(1, 1, At, B1); PG8_BAR; PG8_SCHED;
            PG8_LDB(B0, 1, 0); PG8_LDB(B1, 1, 1); PG8_SCHED; PG8_LDA(At, 1, 0); PG8_STAGE(PG8_SA(0, 1), a2 + hstep, voffA);
            PG8_WAIT_V(8); PG8_WAIT_L(0); PG8_BAR; PG8_MMA(0, 0, At, B0); PG8_MMA(0, 1, At, B1); PG8_BAR; PG8_SCHED;
            PG8_LDA(At, 1, 1); PG8_STAGE(PG8_SB(1, 0), b3, voffB); PG8_STAGE(PG8_SB(1, 1), b3 + hstep, voffB); PG8_STAGE(PG8_SA(1, 0), a3, voffA);
            PG8_WAIT_V(8); PG8_WAIT_L(0); PG8_BAR; PG8_MMA(1, 0, At, B0); PG8_MMA(1, 1, At, B1); PG8_BAR; PG8_SCHED;
        }
        if (wr == 0) PG8_BAR;
        E(acc, cur, wr, wc, fr, fq);
        if (!has_next) break;
        if (cur.last) {
#pragma unroll
            for (int a = 0; a < 2; ++a)
#pragma unroll
                for (int b = 0; b < 2; ++b)
#pragma unroll
                    for (int m = 0; m < 4; ++m)
#pragma unroll
                        for (int n = 0; n < 2; ++n) acc[a][b][m][n] = (f32x4){0.f, 0.f, 0.f, 0.f};
        }
        cur = nxt; cA = nA; cB = nB; ++ui;
        if (wr == 1) PG8_BAR;
    }
    PG8_WAIT_V(0);
    PG8_BAR;
#undef PG8_SA
#undef PG8_SB
#undef PG8_STAGE
#undef PG8_LDA
#undef PG8_LDB
#undef PG8_MMA
#undef PG8_WAIT_V
#undef PG8_WAIT_L
#undef PG8_BAR
#undef PG8_SCHED
}
}
using pg8::Acc; using pg8::Unit;

struct Frame {
    const Params* P;
    unsigned char* ws;
    LAS unsigned char* lds;
    int tid, lane, wave, G, bid, vcu;
    int l;
    int zo;
};
DI const float* pin(const Frame& F, int idx) { return F.P->in[idx + F.zo]; }
DI const float* inl(const Frame& F, int idx, size_t per_layer) { return pin(F, idx) + (size_t)F.l * per_layer; }
DI const float* modp(const Frame& F, int l, int mr, int which) { return (const float*)(F.ws + WS_MOD) + ((size_t)(l * 9 + mr) * 6 + which) * 1024; }
DI int modrow_of_tile(int row0) { return row0 < ML ? (row0 >> 11) : 8; }
DI float* xrow_ptr(const Frame& F, int row) { return row < ML ? F.P->out + (size_t)row * D : (float*)(F.ws + WS_XC) + (size_t)(row - ML) * D; }
DI const float* xin_ptr(const Frame& F, int row) {
    if (F.l == 0) return row < ML ? pin(F, I_X) + (size_t)row * D : pin(F, I_CTX) + (size_t)(row - ML) * D;
    return xrow_ptr(F, row);
}

#define EPI_ROWS(ai, m) (128 * (ai) + 64 * wr + 16 * (m) + fr)
#define EPI_COL8(bj) (128 * (bj) + 32 * wc + 8 * fq)
#define FOR_AI_M _Pragma("unroll") for (int ai = 0; ai < 2; ++ai) _Pragma("unroll") for (int m = 0; m < 4; ++m)
#define ROW_FENCE asm volatile("" ::: "memory")

struct EpiG1 {
    const Frame& F;
    DI void operator()(Acc& acc, const Unit& u, int wr, int wc, int fr, int fq) const {
        unsigned char* ws = F.ws;
        if (u.job == 1) {
            bf16_t* base; int ld;
            if (u.pn < 64) { base = (bf16_t*)(ws + WS_TF) + (size_t)(u.pn >> 3) * 1024 * 2048 + (u.pn & 7) * 256; ld = 2048; }
            else { base = (bf16_t*)(ws + WS_TFC) + (size_t)(u.pn - 64) * 1024 * 256; ld = 256; }
            FOR_AI_M { const int r = u.pm * 256 + EPI_ROWS(ai, m);
#pragma unroll
                for (int bj = 0; bj < 2; ++bj) *(u32x4*)(base + (size_t)r * ld + EPI_COL8(bj)) = pk8(acc[ai][bj][m][0], acc[ai][bj][m][1]); }
            return;
        }
        const int row0 = u.pm * 256;
        if (u.pn <= 1) {
            bf16_t* dst = (bf16_t*)(ws + (u.pn == 0 ? WS_CKV : WS_CQ)); float* ss = (float*)(ws + (u.pn == 0 ? WS_SSKV : WS_SSQ));
            FOR_AI_M { const int r = row0 + EPI_ROWS(ai, m); float s = 0.f;
#pragma unroll
                for (int bj = 0; bj < 2; ++bj) { const f32x4 a = acc[ai][bj][m][0], b = acc[ai][bj][m][1];
                    s += (a[0] * a[0] + a[1] * a[1]) + (a[2] * a[2] + a[3] * a[3]) + (b[0] * b[0] + b[1] * b[1]) + (b[2] * b[2] + b[3] * b[3]);
                    *(u32x4*)(dst + (size_t)r * 256 + EPI_COL8(bj)) = pk8(a, b); }
                s += shx(s, 16, fr + 16 * fq); s += shx(s, 32, fr + 16 * fq);
                if (fq == 0) ss[(size_t)r * 4 + wc] = s; }
            return;
        }
        if (u.pn >= 5) {
            const int cb = (u.pn - 5) * 256; const float* bg = inl(F, I_BGATE, 3072) + cb; bf16_t* dst = (bf16_t*)(ws + WS_GATE) + cb;
            f32x4 bv[2][2];
#pragma unroll
            for (int bj = 0; bj < 2; ++bj) { bv[bj][0] = *(const f32x4*)(bg + EPI_COL8(bj)); bv[bj][1] = *(const f32x4*)(bg + EPI_COL8(bj) + 4); }
            FOR_AI_M { const int r = row0 + EPI_ROWS(ai, m);
#pragma unroll
                for (int bj = 0; bj < 2; ++bj) { f32x4 a = acc[ai][bj][m][0] + bv[bj][0], b = acc[ai][bj][m][1] + bv[bj][1];
#pragma unroll
                    for (int e = 0; e < 4; ++e) { a[e] = __builtin_amdgcn_rcpf(1.f + __builtin_amdgcn_exp2f(-1.4426950408889634f * a[e])); b[e] = __builtin_amdgcn_rcpf(1.f + __builtin_amdgcn_exp2f(-1.4426950408889634f * b[e])); }
                    *(u32x4*)(dst + (size_t)r * 3072 + EPI_COL8(bj)) = pk8(a, b); } }
            return;
        }
        const bool is_q = (u.pn >= 3);
        const bool is_v = (!is_q) && (wc >= 2);
        const float* gain = is_q ? inl(F, I_GQG, 64) : inl(F, I_GKG, 64);
        f32x4 gv[2][2];
#pragma unroll
        for (int bj = 0; bj < 2; ++bj) { gv[bj][0] = *(const f32x4*)(gain + 32 * bj + 8 * fq); gv[bj][1] = *(const f32x4*)(gain + 32 * bj + 8 * fq + 4); }
        bf16_t* dst; int ld, colb;
        if (is_q) { dst = (bf16_t*)(ws + WS_QG); ld = 512; colb = ((u.pn - 3) * 4 + wc) * 64; }
        else if (!is_v) { dst = (bf16_t*)(ws + WS_KG); ld = 128; colb = wc * 64; }
        else { dst = (bf16_t*)(ws + WS_VG); ld = 128; colb = (wc - 2) * 64; }
        const bool rope = (row0 < ML);
        const float* rg = (const float*)(ws + WS_ROPEG);
        const float qs = is_q ? QS_GQA : 1.f;
        FOR_AI_M { const int r = row0 + EPI_ROWS(ai, m);
            f32x4 x[2][2];
#pragma unroll
            for (int bj = 0; bj < 2; ++bj) { x[bj][0] = acc[ai][bj][m][0]; x[bj][1] = acc[ai][bj][m][1]; }
            if (!is_v) {
                float s = 0.f;
#pragma unroll
                for (int bj = 0; bj < 2; ++bj)
#pragma unroll
                    for (int n = 0; n < 2; ++n) s += (x[bj][n][0] * x[bj][n][0] + x[bj][n][1] * x[bj][n][1]) + (x[bj][n][2] * x[bj][n][2] + x[bj][n][3] * x[bj][n][3]);
                s += shx(s, 16, fr + 16 * fq); s += shx(s, 32, fr + 16 * fq);
                const float rstd = 1.f / sqrtf(s * (1.f / 64.f) + EPS);
#pragma unroll
                for (int bj = 0; bj < 2; ++bj)
#pragma unroll
                    for (int n = 0; n < 2; ++n) x[bj][n] = x[bj][n] * rstd * gv[bj][n];
                if (rope) {
                    const float* rr = rg + (size_t)(r & 2047) * 64 + 8 * fq;
#pragma unroll
                    for (int n = 0; n < 2; ++n) { const f32x4 cs = *(const f32x4*)(rr + 4 * n), sn = *(const f32x4*)(rr + 32 + 4 * n);
                        const f32x4 x1 = x[0][n], x2 = x[1][n]; x[0][n] = x1 * cs - x2 * sn; x[1][n] = x1 * sn + x2 * cs; }
                }
#pragma unroll
                for (int bj = 0; bj < 2; ++bj)
#pragma unroll
                    for (int n = 0; n < 2; ++n) x[bj][n] = x[bj][n] * qs;
            }
#pragma unroll
            for (int bj = 0; bj < 2; ++bj) *(u32x4*)(dst + (size_t)r * ld + colb + 32 * bj + 8 * fq) = pk8(x[bj][0], x[bj][1]);
            if (m & 1) ROW_FENCE;
        }
    }
};

struct EpiG2 {
    const Frame& F;
    DI void operator()(Acc& acc, const Unit& u, int wr, int wc, int fr, int fq) const {
        unsigned char* ws = F.ws; const int row0 = u.pm * 256;
        const float* ss = (const float*)(ws + (u.job == 0 ? WS_SSKV : WS_SSQ));
        bf16_t* dst; int ld; float sc = 1.f;
        if (u.job == 0) { dst = (bf16_t*)(ws + (u.pn < 2 ? WS_KN : WS_VM)) + (u.pn & 1) * 256; ld = 512; }
        else { dst = (bf16_t*)(ws + WS_QM); ld = 768; sc = QS_MLA; }
        const bool ropet = (u.job == 1 && u.pn == 2);
        const bool rope = ropet && row0 < ML;
        const float* rm = (const float*)(ws + WS_ROPEM) + 4 * fq;
        int colv[2];
#pragma unroll
        for (int bj = 0; bj < 2; ++bj) {
            if (u.job == 0) colv[bj] = EPI_COL8(bj);
            else if (!ropet) { const int c = u.pn * 256 + EPI_COL8(bj); colv[bj] = (c >> 6) * 96 + (c & 63); }
            else { const int c = EPI_COL8(bj); colv[bj] = (c >> 5) * 96 + 64 + (c & 31); }
        }
        FOR_AI_M { const int r = row0 + EPI_ROWS(ai, m);
            const f32x4 s4 = *(const f32x4*)(ss + (size_t)r * 4);
            const float rstd = sc * __builtin_amdgcn_rsqf(((s4[0] + s4[1]) + (s4[2] + s4[3])) * (1.f / 256.f) + EPS);
            f32x4 cs = {1.f, 1.f, 1.f, 1.f}, sn = {0.f, 0.f, 0.f, 0.f};
            if (rope) { const float* rr = rm + (size_t)(r & 2047) * 32; cs = *(const f32x4*)rr; sn = *(const f32x4*)(rr + 16); }
#pragma unroll
            for (int bj = 0; bj < 2; ++bj) {
                const f32x4 x1 = acc[ai][bj][m][0] * rstd, x2 = acc[ai][bj][m][1] * rstd;
                f32x4 a = x1, b = x2;
                if (ropet) { a = x1 * cs - x2 * sn; b = x1 * sn + x2 * cs; }
                *(u32x4*)(dst + (size_t)r * ld + colv[bj]) = pk8(a, b);
            }
            ROW_FENCE;
        }
    }
};

struct EpiDft {
    bf16_t* dst; int zrows, ld;
    DI void operator()(Acc& acc, const Unit& u, int wr, int wc, int fr, int fq) const {
        FOR_AI_M { const int r = u.z * zrows + u.pm * 256 + EPI_ROWS(ai, m);
#pragma unroll
            for (int bj = 0; bj < 2; ++bj) *(u32x4*)(dst + (size_t)r * ld + u.pn * 256 + EPI_COL8(bj)) = pk8(acc[ai][bj][m][0], acc[ai][bj][m][1]); }
    }
};

struct EpiG3 {
    const Frame& F;
    DI void operator()(Acc& acc, const Unit& u, int wr, int wc, int fr, int fq) const {
        const bf16_t* gate = (const bf16_t*)(F.ws + WS_GATE); bf16_t* Y = (bf16_t*)(F.ws + WS_HB);
        const int row0 = u.pm * 256, col0 = u.pn * 256;
        const int s1 = u.seg < 2 ? u.seg + 1 : u.seg;
#pragma unroll
        for (int aim = 0; aim < 4; ++aim) { const int ai = aim >> 1, mb = (aim & 1) * 2;
            u32x4 ga[4][2], gb[4][2];
#pragma unroll
            for (int m = mb; m < mb + 2; ++m)
#pragma unroll
                for (int bj = 0; bj < 2; ++bj) { const size_t o = (size_t)(row0 + EPI_ROWS(ai, m)) * 3072 + col0 + EPI_COL8(bj);
                    ga[m][bj] = *(const u32x4*)(gate + o + u.seg * 1024); if (u.seg < 2) gb[m][bj] = *(const u32x4*)(gate + o + s1 * 1024); }
#pragma unroll
            for (int m = mb; m < mb + 2; ++m) { const int r = row0 + EPI_ROWS(ai, m);
#pragma unroll
                for (int bj = 0; bj < 2; ++bj) {
                    float g0[8]; unpk8(ga[m][bj], g0);
                    if (u.seg < 2) { float g1[8]; unpk8(gb[m][bj], g1);
#pragma unroll
                        for (int e = 0; e < 8; ++e) g0[e] = g0[e] * __builtin_amdgcn_rcpf(fmaxf(g1[e], 1e-20f)); }
#pragma unroll
                    for (int e = 0; e < 4; ++e) { acc[ai][bj][m][0][e] *= g0[e]; acc[ai][bj][m][1][e] *= g0[4 + e]; }
                    if (u.seg == 2) *(u32x4*)(Y + (size_t)r * 1024 + col0 + EPI_COL8(bj)) = pk8(acc[ai][bj][m][0], acc[ai][bj][m][1]);
                }
            }
            ROW_FENCE;
        }
    }
};

struct EpiRes {
    const Frame& F; int which; bool from_input;
    int lnmode;
    DI void operator()(Acc& acc, const Unit& u, int wr, int wc, int fr, int fq) const {
        const int row0 = u.pm * 256, col0 = u.pn * 256;
        const float* g = modp(F, F.l, modrow_of_tile(row0), which) + col0;
        const bool ln = (lnmode != 0) && row0 < ML;
        const float* st = (const float*)(F.ws + (lnmode == 1 ? WS_ST1 : WS_ST2));
        const float* lg = lnmode == 1 ? pin(F, I_LN1G) + F.l * 1024 : pin(F, I_LN2G) + (F.l > 0 ? F.l - 1 : 0) * 1024;
        const float* lb = lnmode == 1 ? pin(F, I_LN1B) + F.l * 1024 : pin(F, I_LN2B) + (F.l > 0 ? F.l - 1 : 0) * 1024;
        {
#pragma unroll
            for (int bj = 0; bj < 2; ++bj) {
                f32x4 gv0 = *(const f32x4*)(g + EPI_COL8(bj)), gv1 = *(const f32x4*)(g + EPI_COL8(bj) + 4);
                f32x4 c0 = {0.f, 0.f, 0.f, 0.f}, c1 = {0.f, 0.f, 0.f, 0.f};
                if (ln) { c0 = *(const f32x4*)(lb + col0 + EPI_COL8(bj)) * ALPHA; c1 = *(const f32x4*)(lb + col0 + EPI_COL8(bj) + 4) * ALPHA; }
#pragma unroll
                for (int ai = 0; ai < 2; ++ai)
#pragma unroll
                    for (int m = 0; m < 4; ++m) { acc[ai][bj][m][0] = acc[ai][bj][m][0] * gv0 + c0; acc[ai][bj][m][1] = acc[ai][bj][m][1] * gv1 + c1; }
            }
        }
        f32x4 la[2][2];
#pragma unroll
        for (int bj = 0; bj < 2; ++bj) {
#pragma unroll
            for (int n = 0; n < 2; ++n) la[bj][n] = (f32x4){ALPHA, ALPHA, ALPHA, ALPHA};
            if (ln) {
#pragma unroll
                for (int n = 0; n < 2; ++n) la[bj][n] = *(const f32x4*)(lg + col0 + EPI_COL8(bj) + 4 * n) * ALPHA; } }
        const float* xib = (from_input ? xin_ptr(F, row0) : xrow_ptr(F, row0)) + col0; float* xob = xrow_ptr(F, row0) + col0;
#pragma unroll
        for (int aim = 0; aim < 8; ++aim) { const int ai = aim >> 2, m = aim & 3;
            f32x4 xa[2][2]; f32x2 sv = {0.f, 1.f};
            if (ln) sv = *(const f32x2*)(st + 2 * (size_t)(row0 + EPI_ROWS(ai, m)));
#pragma unroll
            for (int bj = 0; bj < 2; ++bj) { const float* p = xib + (size_t)EPI_ROWS(ai, m) * D + EPI_COL8(bj); xa[bj][0] = *(const f32x4*)p; xa[bj][1] = *(const f32x4*)(p + 4); }
#pragma unroll
            for (int bj = 0; bj < 2; ++bj) { float* p = xob + (size_t)EPI_ROWS(ai, m) * D + EPI_COL8(bj);
                *(f32x4*)p = ((xa[bj][0] - sv[0]) * sv[1]) * la[bj][0] + acc[ai][bj][m][0];
                *(f32x4*)(p + 4) = ((xa[bj][1] - sv[0]) * sv[1]) * la[bj][1] + acc[ai][bj][m][1]; }
            if (m & 1) ROW_FENCE;
        }
    }
};

struct EpiSlab {
    float* slab;
    DI void operator()(Acc& acc, const Unit& u, int wr, int wc, int fr, int fq) const {
        FOR_AI_M { const int r = u.z * MC + u.pm * 256 + EPI_ROWS(ai, m);
#pragma unroll
            for (int bj = 0; bj < 2; ++bj) { float* o = slab + (size_t)r * 1024 + u.pn * 256 + EPI_COL8(bj);
                *(f32x4*)o = acc[ai][bj][m][0]; *(f32x4*)(o + 4) = acc[ai][bj][m][1]; } }
    }
};

struct EpiW1 {
    const Frame& F;
    DI void operator()(Acc& acc, const Unit& u, int wr, int wc, int fr, int fq) const {
        bf16_t* U = (bf16_t*)(F.ws + WS_U);
        FOR_AI_M { const int r = u.pm * 256 + EPI_ROWS(ai, m);
#pragma unroll
            for (int bj = 0; bj < 2; ++bj) { f32x4 a = acc[ai][bj][m][0], b = acc[ai][bj][m][1];
#pragma unroll
                for (int e = 0; e < 4; ++e) { const float x = fmaxf(a[e], 0.f), y = fmaxf(b[e], 0.f); a[e] = x * x; b[e] = y * y; }
                *(u32x4*)(U + (size_t)r * DFF + u.pn * 256 + EPI_COL8(bj)) = pk8(a, b); } }
    }
};

#define MFMA32(a, b, c) __builtin_amdgcn_mfma_f32_32x32x16_bf16((a), (b), (c), 0, 0, 0)
constexpr int ATT_BUF = 22528;
constexpr int ATT_KR = 9216, ATT_V = 14336;
template <int KIND>
DI void attn_unit(const Frame& F, int qrow0, int head, int ctx_row0, int lat_row0, int ntiles) {
    constexpr int ND = KIND == 0 ? 6 : 4;
    unsigned char* ws = F.ws; LAS unsigned char* lds = F.lds;
    int tid_ = F.tid; asm volatile("" : "+v"(tid_));
    const int tid = tid_ & 511, lane = tid & 63, w = __builtin_amdgcn_readfirstlane(tid >> 6), r32 = lane & 31, h5 = lane >> 5;
    const bf16_t *Kp, *Vp, *Qp; bf16_t* Op; int ldk, ldq, ldo;
    if (KIND == 0) { Kp = (const bf16_t*)(ws + WS_KN) + head * 64; Vp = (const bf16_t*)(ws + WS_VM) + head * 64; ldk = 512; Qp = (const bf16_t*)(ws + WS_QM) + head * 96; ldq = 768;
                     Op = (bf16_t*)(ws + WS_AM) + head * 64; ldo = 512; }
    else { Kp = (const bf16_t*)(ws + WS_KG) + (head >> 2) * 64; Vp = (const bf16_t*)(ws + WS_VG) + (head >> 2) * 64; ldk = 128; Qp = (const bf16_t*)(ws + WS_QG) + head * 64; ldq = 512;
           Op = (bf16_t*)(ws + WS_QG) + head * 64; ldo = 512; }
    const bf16_t* Krp = (const bf16_t*)(ws + WS_KR);
    bf16x8 qf[ND];
    { const bf16_t* qr = Qp + (size_t)(qrow0 + 32 * w + r32) * ldq + 8 * h5;
#pragma unroll
      for (int ds = 0; ds < ND; ++ds) qf[ds] = *(const bf16x8*)(qr + 16 * ds); }
    const int skey = tid >> 3, sch = tid & 7;
    const int skey_r = (tid & 255) >> 2, sch_r = tid & 3;
    const unsigned kdst = skey * 144 + sch * 16;
    const unsigned vdst = ATT_V + (sch >> 2) * 4096 + skey * 64 + (sch & 3) * 16;
    const unsigned rdst = ATT_KR + skey_r * 80 + sch_r * 16;
    u32x4 kreg, vreg, rreg;
#define ATT_KEYROW(t) ((t) < 4 ? ctx_row0 + 64 * (t) : lat_row0 + 64 * ((t) - 4))
#define ATT_LOAD(t) do { const int kr_ = ATT_KEYROW(t); kreg = *(const u32x4*)(Kp + (size_t)(kr_ + skey) * ldk + sch * 8); vreg = *(const u32x4*)(Vp + (size_t)(kr_ + skey) * ldk + sch * 8); \
        if (KIND == 0 && tid < 256) rreg = *(const u32x4*)(Krp + (size_t)(kr_ + skey_r) * 32 + sch_r * 8); } while (0)
#define ATT_STORE(buf) do { LAS unsigned char* b_ = lds + (buf) * ATT_BUF; *(LAS u32x4*)(b_ + kdst) = kreg; *(LAS u32x4*)(b_ + vdst) = vreg; \
        if (KIND == 0 && tid < 256) *(LAS u32x4*)(b_ + rdst) = rreg; } while (0)
    const unsigned kbase = r32 * 144 + h5 * 16, rbase = ATT_KR + r32 * 80 + h5 * 16;
    const unsigned voff = ATT_V + (4 * h5 + ((lane & 15) >> 2)) * 64 + ((lane >> 4) & 1) * 32 + (lane & 3) * 8;
    float mref = 0.f, lsum = 0.f;
    f32x16 o0, o1;
#pragma unroll
    for (int i = 0; i < 16; ++i) { o0[i] = 0.f; o1[i] = 0.f; }
#define ATT_LOADK(t) do { const int kr_ = ATT_KEYROW(t); kreg = *(const u32x4*)(Kp + (size_t)(kr_ + skey) * ldk + sch * 8); \
        if (KIND == 0 && tid < 256) rreg = *(const u32x4*)(Krp + (size_t)(kr_ + skey_r) * 32 + sch_r * 8); } while (0)
#define ATT_LOADV(t) do { const int kr_ = ATT_KEYROW(t); vreg = *(const u32x4*)(Vp + (size_t)(kr_ + skey) * ldk + sch * 8); } while (0)
#define ATT_STOREK(buf) do { LAS unsigned char* b_ = lds + (buf) * ATT_BUF; *(LAS u32x4*)(b_ + kdst) = kreg; if (KIND == 0 && tid < 256) *(LAS u32x4*)(b_ + rdst) = rreg; } while (0)
#define ATT_STOREV(buf) do { LAS unsigned char* b_ = lds + (buf) * ATT_BUF; *(LAS u32x4*)(b_ + vdst) = vreg; } while (0)
#define ATT_KFRAG(buf) do { LAS unsigned char* kq_ = lds + (buf) * ATT_BUF; \
        _Pragma("unroll") for (int ds = 0; ds < ND; ++ds) { \
            const unsigned o_ = ds < 4 ? kbase + ds * 32 : rbase + (ds - 4) * 32; const unsigned p_ = ds < 4 ? 32 * 144 : 32 * 80; \
            kf[0][ds] = *(const LAS bf16x8*)(kq_ + o_); kf[1][ds] = *(const LAS bf16x8*)(kq_ + o_ + p_); } } while (0)
#define ATT_QKM(S0, S1, C) do { \
        _Pragma("unroll") for (int ds = 0; ds < ND; ++ds) { \
            if (ds == 0) { S0 = MFMA32(kf[0][0], qf[0], C); S1 = MFMA32(kf[1][0], qf[0], C); } else { S0 = MFMA32(kf[0][ds], qf[ds], S0); S1 = MFMA32(kf[1][ds], qf[ds], S1); } } } while (0)
#define ATT_VFRAG(dst, vb, kb) do { \
        _Pragma("unroll") for (int s = 0; s < 2; ++s) _Pragma("unroll") for (int db = 0; db < 2; ++db) { \
            const unsigned a_ = voff + db * 4096 + (32 * (kb) + 16 * s) * 64; \
            const s16x4 lo = __builtin_bit_cast(s16x4, __builtin_amdgcn_ds_read_tr16_b64_v4i16((LAS s16x4*)((vb) + a_))); \
            const s16x4 hi = __builtin_bit_cast(s16x4, __builtin_amdgcn_ds_read_tr16_b64_v4i16((LAS s16x4*)((vb) + a_ + 512))); \
            dst[s][db] = __builtin_shufflevector(lo, hi, 0, 1, 2, 3, 4, 5, 6, 7); } } while (0)
    bf16x8 kf[2][ND];
    f32x16 s0, s1, n0, n1, negm;
#pragma unroll
    for (int i = 0; i < 16; ++i) negm[i] = 0.f;
#define ATT_LOADK2(t, KR_, RR_) do { const int kr_ = ATT_KEYROW(t); KR_ = *(const u32x4*)(Kp + (size_t)(kr_ + skey) * ldk + sch * 8); \
        if (KIND == 0 && tid < 256) RR_ = *(const u32x4*)(Krp + (size_t)(kr_ + skey_r) * 32 + sch_r * 8); } while (0)
#define ATT_LOADV2(t, VR_) do { const int kr_ = ATT_KEYROW(t); VR_ = *(const u32x4*)(Vp + (size_t)(kr_ + skey) * ldk + sch * 8); } while (0)
#define ATT_STOREK2(buf, KR_, RR_) do { LAS unsigned char* b_ = lds + (buf) * ATT_BUF; *(LAS u32x4*)(b_ + kdst) = KR_; if (KIND == 0 && tid < 256) *(LAS u32x4*)(b_ + rdst) = RR_; } while (0)
#define ATT_STOREV2(buf, VR_) do { LAS unsigned char* b_ = lds + (buf) * ATT_BUF; *(LAS u32x4*)(b_ + vdst) = VR_; } while (0)
#define ATT_BODY(t, KS, VS, RS, KL, VL, RL, C0, C1, N0, N1) do { \
        const bool more = (t + 1 < ntiles), more2 = (t + 2 < ntiles); \
        if (t + 3 < ntiles) ATT_LOADK2(t + 3, KL, RL); \
        if (more2) ATT_LOADV2(t + 2, VL); \
        LAS unsigned char* kb_ = lds + (t & 1) * ATT_BUF; \
        bf16x8 va[2][2], vb2[2][2]; \
        if (more) ATT_KFRAG((t + 1) & 1); \
        __builtin_amdgcn_sched_barrier(0); \
        __builtin_amdgcn_iglp_opt(IGLP_K); \
        if (more) { f32x16 ng_; _Pragma("unroll") for (int i = 0; i < 16; ++i) ng_[i] = -mref; ATT_QKM(N0, N1, ng_); } \
        float psa = 0.f, psb = 0.f; \
        _Pragma("unroll") for (int i = 0; i < 16; ++i) { C0[i] = __builtin_amdgcn_exp2f(C0[i]); C1[i] = __builtin_amdgcn_exp2f(C1[i]); psa += C0[i]; psb += C1[i]; } \
        psa += psb; \
        if (__builtin_expect(__any(psa > BIGP), 0)) { \
            float mx = fmaxf(C0[0], C1[0]); \
            _Pragma("unroll") for (int i = 1; i < 16; ++i) mx = fmaxf(mx, fmaxf(C0[i], C1[i])); \
            { auto rr = __builtin_amdgcn_permlane32_swap(__float_as_uint(mx), __float_as_uint(mx), false, false); mx = fmaxf(__uint_as_float(rr[0]), __uint_as_float(rr[1])); } \
            const float dl = mx > 1.f ? ceilf(__log2f(mx)) : 0.f; const float f = __builtin_amdgcn_exp2f(-dl); \
            mref += dl; lsum *= f; psa *= f; \
            _Pragma("unroll") for (int i = 0; i < 16; ++i) { C0[i] *= f; C1[i] *= f; o0[i] *= f; o1[i] *= f; N0[i] -= dl; N1[i] -= dl; } \
        } \
        lsum += psa; \
        bf16x8 pf[2][2]; \
        _Pragma("unroll") for (int s = 0; s < 2; ++s) { \
            u32x4 a, b; \
            a.x = pk2(C0[8 * s + 0], C0[8 * s + 1]); a.y = pk2(C0[8 * s + 2], C0[8 * s + 3]); a.z = pk2(C0[8 * s + 4], C0[8 * s + 5]); a.w = pk2(C0[8 * s + 6], C0[8 * s + 7]); \
            b.x = pk2(C1[8 * s + 0], C1[8 * s + 1]); b.y = pk2(C1[8 * s + 2], C1[8 * s + 3]); b.z = pk2(C1[8 * s + 4], C1[8 * s + 5]); b.w = pk2(C1[8 * s + 6], C1[8 * s + 7]); \
            pf[0][s] = __builtin_bit_cast(bf16x8, a); pf[1][s] = __builtin_bit_cast(bf16x8, b); \
        } \
        ATT_VFRAG(va, kb_, 0); ATT_VFRAG(vb2, kb_, 1); \
        _Pragma("unroll") for (int s = 0; s < 2; ++s) { o0 = MFMA32(va[s][0], pf[0][s], o0); o1 = MFMA32(va[s][1], pf[0][s], o1); } \
        _Pragma("unroll") for (int s = 0; s < 2; ++s) { o0 = MFMA32(vb2[s][0], pf[1][s], o0); o1 = MFMA32(vb2[s][1], pf[1][s], o1); } \
        __builtin_amdgcn_sched_barrier(0); \
        if (more2) ATT_STOREK2(t & 1, KS, RS); \
        if (more) ATT_STOREV2((t + 1) & 1, VS); \
        asm volatile("s_waitcnt lgkmcnt(0)\n\ts_barrier" ::: "memory"); \
    } while (0)
    constexpr float BIGP = 65536.f;
    u32x4 kreg2, vreg2, rreg2;
    ATT_LOADK(0); ATT_LOADV(0); ATT_STOREK(0); ATT_STOREV(0);
    ATT_LOADK(1); ATT_STOREK(1);
    __syncthreads();
    ATT_LOADK2(2, kreg, rreg); ATT_LOADV2(1, vreg);
    ATT_KFRAG(0); ATT_QKM(s0, s1, negm);
    {
        float mx = fmaxf(s0[0], s1[0]);
#pragma unroll
        for (int i = 1; i < 16; ++i) mx = fmaxf(mx, fmaxf(s0[i], s1[i]));
        { auto rr = __builtin_amdgcn_permlane32_swap(__float_as_uint(mx), __float_as_uint(mx), false, false); mx = fmaxf(__uint_as_float(rr[0]), __uint_as_float(rr[1])); }
        mref = mx;
#pragma unroll
        for (int i = 0; i < 16; ++i) { s0[i] -= mx; s1[i] -= mx; }
    }
    for (int t2 = 0; t2 < ntiles; t2 += 2) {
        { const int t = t2; ATT_BODY(t, kreg, vreg, rreg, kreg2, vreg2, rreg2, s0, s1, n0, n1); }
        { const int t = t2 + 1; ATT_BODY(t, kreg2, vreg2, rreg2, kreg, vreg, rreg, n0, n1, s0, s1); }
    }
    { auto rr = __builtin_amdgcn_permlane32_swap(__float_as_uint(lsum), __float_as_uint(lsum), false, false); lsum = __uint_as_float(rr[0]) + __uint_as_float(rr[1]); }
    const float inv = 1.f / lsum;
    {
        LAS unsigned char* stg = lds + 49152 + w * 4608;
        LAS unsigned char* mine = stg + r32 * 144 + 8 * h5;
#pragma unroll
        for (int g = 0; g < 4; ++g) {
            u32x2 a, b;
            a.x = pk2(o0[4 * g] * inv, o0[4 * g + 1] * inv); a.y = pk2(o0[4 * g + 2] * inv, o0[4 * g + 3] * inv);
            b.x = pk2(o1[4 * g] * inv, o1[4 * g + 1] * inv); b.y = pk2(o1[4 * g + 2] * inv, o1[4 * g + 3] * inv);
            *(LAS u32x2*)(mine + 16 * g) = a; *(LAS u32x2*)(mine + 64 + 16 * g) = b;
        }
        asm volatile("s_waitcnt lgkmcnt(0)" ::: "memory");
        bf16_t* ob = Op + (size_t)(qrow0 + 32 * w) * ldo;
#pragma unroll
        for (int it = 0; it < 4; ++it) { const int row = it * 8 + (lane >> 3), ch = lane & 7;
            const u32x4 v = *(const LAS u32x4*)(stg + row * 144 + ch * 16);
            *(u32x4*)(ob + (size_t)row * ldo + ch * 8) = v; }
    }
#undef ATT_LOADK
#undef ATT_LOADV
#undef ATT_STOREK
#undef ATT_STOREV
#undef ATT_KFRAG
#undef ATT_BODY
#undef ATT_LOADK2
#undef ATT_LOADV2
#undef ATT_STOREK2
#undef ATT_STOREV2
#undef ATT_QKM
#undef ATT_VFRAG
#undef ATT_KEYROW
#undef ATT_LOAD
#undef ATT_STORE
}

DI void wave_sum2(float& a, float& b, int lane) {
#pragma unroll
    for (int o = 1; o < 64; o <<= 1) { const float ta = shx(a, o, lane), tb = shx(b, o, lane); a += ta; b += tb; }
}
DI void ln_row_v(const Frame& F, f32x4 (&v)[4], float* xout, const float* g, const float* b, const float* sh, const float* sc, bf16_t* hout, const float* slab, const float* gres, float* stat = nullptr) {
    if (slab) {
#pragma unroll
        for (int j = 0; j < 4; ++j) { f32x4 a = ((const f32x4*)slab)[F.lane + 64 * j];
#pragma unroll
            for (int z = 1; z < 8; ++z) a += ((const f32x4*)(slab + (size_t)z * MC * 1024))[F.lane + 64 * j];
            v[j] = v[j] * ALPHA + ((const f32x4*)gres)[F.lane + 64 * j] * a; }
    }
    if (g) {
        float s = 0.f, s2 = 0.f;
#pragma unroll
        for (int j = 0; j < 4; ++j) { s += (v[j][0] + v[j][1]) + (v[j][2] + v[j][3]); s2 += (v[j][0] * v[j][0] + v[j][1] * v[j][1]) + (v[j][2] * v[j][2] + v[j][3] * v[j][3]); }
        wave_sum2(s, s2, F.lane);
        const float mean = s * (1.f / D); const float rstd = 1.f / sqrtf(fmaxf(s2 * (1.f / D) - mean * mean, 0.f) + EPS);
        if (stat && F.lane == 0) { f32x2 sv = {mean, rstd}; *(f32x2*)stat = sv; }
#pragma unroll
        for (int j = 0; j < 4; ++j) { const f32x4 gg = ((const f32x4*)g)[F.lane + 64 * j], bb = ((const f32x4*)b)[F.lane + 64 * j];
            v[j] = (v[j] - mean) * rstd * gg + bb; if (xout) ((f32x4*)xout)[F.lane + 64 * j] = v[j]; }
    }
    if (hout) {
        float s = 0.f, s2 = 0.f;
#pragma unroll
        for (int j = 0; j < 4; ++j) { s += (v[j][0] + v[j][1]) + (v[j][2] + v[j][3]); s2 += (v[j][0] * v[j][0] + v[j][1] * v[j][1]) + (v[j][2] * v[j][2] + v[j][3] * v[j][3]); }
        wave_sum2(s, s2, F.lane);
        const float mean = s * (1.f / D); const float rstd = 1.f / sqrtf(fmaxf(s2 * (1.f / D) - mean * mean, 0.f) + EPS);
#pragma unroll
        for (int j = 0; j < 4; ++j) { const f32x4 hh = ((const f32x4*)sh)[F.lane + 64 * j], cc = ((const f32x4*)sc)[F.lane + 64 * j];
            const f32x4 o = (v[j] - mean) * rstd * (cc + 1.f) + hh; u32x2 wv; wv.x = pk2(o[0], o[1]); wv.y = pk2(o[2], o[3]);
            ((u32x2*)hout)[F.lane + 64 * j] = wv; }
    }
}
DI void ln_load(const Frame& F, const float* xin, f32x4 (&v)[4]) {
    const f32x4* xr = (const f32x4*)xin + F.lane;
#pragma unroll
    for (int j = 0; j < 4; ++j) v[j] = xr[64 * j];
}
DI void ln_row(const Frame& F, const float* xin, float* xout, const float* g, const float* b, const float* sh, const float* sc, bf16_t* hout, const float* slab = nullptr, const float* gres = nullptr) {
    f32x4 v[4]; ln_load(F, xin, v);
    ln_row_v(F, v, xout, g, b, sh, sc, hout, slab, gres);
}

DI int srcmap(int kind, int n) {
    switch (kind) {
    case 0: {
        if (n < 256) return n;
        if (n < 512) return 1056 + (n - 256);
        if (n < 768) { const int c = n - 512, slot = (c & 127) >> 5, d = 32 * (c >> 7) + (c & 31); return slot < 2 ? 288 + slot * 64 + d : 416 + (slot - 2) * 64 + d; }
        if (n < 1280) { const int t = (n - 768) >> 8, c = (n - 768) & 255, slot = (c & 127) >> 5, d = 32 * (c >> 7) + (c & 31); return 1312 + (4 * t + slot) * 64 + d; }
        return 1824 + (n - 1280); }
    case 1: { const int half = (n & 7) >> 2, i = 4 * (n >> 3) + (n & 3); return 256 + half * 16 + i; }
    case 2: {
        if (n < 512) return (n >> 6) * 96 + (n & 63);
        const int c = n - 512, hd = c >> 5, j = c & 31, half = (j & 7) >> 2, i = 4 * (j >> 3) + (j & 3); return hd * 96 + 64 + half * 16 + i; }
    default: return n;
    }
}
DI void conv_item(const float* W, int K, int ld, int kind, const float* gain, bf16_t* WT, int item, int nblk, LAS float* scr, int lane) {
    const int kb = item / nblk, nb = item % nblk, k0 = 64 * kb, n0 = 32 * nb;
    const int sc_ = srcmap(kind, n0 + (lane & 31));
    float wv[32];
#pragma unroll
    for (int i = 0; i < 32; ++i) wv[i] = W[(size_t)(k0 + 2 * i + (lane >> 5)) * ld + sc_];
    if (gain) {
#pragma unroll
        for (int i = 0; i < 32; ++i) wv[i] *= gain[k0 + 2 * i + (lane >> 5)];
    }
#pragma unroll
    for (int i = 0; i < 32; ++i) scr[(2 * i + (lane >> 5)) * 33 + (lane & 31)] = wv[i];
    asm volatile("s_waitcnt lgkmcnt(0)" ::: "memory");
    const int c = lane & 7;
#pragma unroll
    for (int j = 0; j < 4; ++j) { const int n = (lane >> 3) + 8 * j; const LAS float* s = scr + (8 * c) * 33 + n;
        u32x4 o; o.x = pk2(s[0 * 33], s[1 * 33]); o.y = pk2(s[2 * 33], s[3 * 33]); o.z = pk2(s[4 * 33], s[5 * 33]); o.w = pk2(s[6 * 33], s[7 * 33]);
        *(u32x4*)(WT + (size_t)(n0 + n) * K + k0 + 8 * c) = o; }
    asm volatile("s_waitcnt lgkmcnt(0)" ::: "memory");
}
template <int Q0, int Q1>
DI void convert_weights(const Frame& F, int l, int crank, int ncu) {
    LAS float* scr = (LAS float*)(F.lds + F.wave * 16384);
    unsigned char* W = F.ws + WS_W;
    const int gw = crank * 8 + F.wave, NGW = ncu * 8;
    const float* w_in = pin(F, I_WIN) + (size_t)l * D * INC;
    struct It { const float* src; int K, ld, kind, N; const float* gain; size_t dst; };
    const It its[11] = {
        {w_in, 1024, INC, 0, NIN, nullptr, W_IN},
        {w_in, 1024, INC, 1, 32, nullptr, W_KR},
        {pin(F, I_WUK) + (size_t)l * 256 * 512, 256, 512, 9, 512, pin(F, I_MKVG) + l * 256, W_UKV},
        {pin(F, I_WUV) + (size_t)l * 256 * 512, 256, 512, 9, 512, pin(F, I_MKVG) + l * 256, W_UKV + 512 * 256 * 2},
        {pin(F, I_WUQ) + (size_t)l * 256 * 768, 256, 768, 2, 768, pin(F, I_MQG) + l * 256, W_UQ},
        {pin(F, I_WFO) + (size_t)l * 512 * 1024, 512, 1024, 9, 1024, nullptr, W_FO},
        {pin(F, I_WMO) + (size_t)l * 512 * 1024, 512, 1024, 9, 1024, nullptr, W_MO},
        {pin(F, I_WGO) + (size_t)l * 512 * 1024, 512, 1024, 9, 1024, nullptr, W_GO},
        {pin(F, I_WO) + (size_t)l * 1024 * 1024, 1024, 1024, 9, 1024, nullptr, W_O},
        {pin(F, I_W1) + (size_t)l * 1024 * 4096, 1024, 4096, 9, 4096, nullptr, W_1},
        {pin(F, I_W2) + (size_t)l * 4096 * 1024, 4096, 1024, 9, 1024, nullptr, W_2}};
    int base = 0;
#pragma unroll
    for (int q = Q0; q < Q1; ++q) {
        const int nblk = its[q].N / 32, nit = (its[q].K / 64) * nblk;
        int first = (gw - base) % NGW; if (first < 0) first += NGW;
        for (int it = first; it < nit; it += NGW) conv_item(its[q].src, its[q].K, its[q].ld, its[q].kind, its[q].gain, (bf16_t*)(W + its[q].dst), it, nblk, scr, F.lane);
        base = (base + nit) % NGW;
    }
}
DI void fold_fourier(const Frame& F, int l, int crank, int ncu) {
    __syncthreads();
    LAS float* u = (LAS float*)F.lds;
    LAS float* T = (LAS float*)(F.lds + 32768);
    if (F.tid < 128) T[F.tid] = cospif((float)F.tid * (1.f / 64.f));
    const float* w_in = pin(F, I_WIN) + (size_t)l * D * INC;
    bf16_t* WT = (bf16_t*)(F.ws + WS_W + W_T);
    for (int item = crank; item < 256; item += ncu) {
        const int g = item >> 6, k0 = (item & 63) * 16;
        __syncthreads();
        for (int e = F.tid; e < 16 * 128; e += 512) { const int kk = e >> 7, c = e & 127; u[kk * 129 + c] = w_in[(size_t)(k0 + kk) * INC + 544 + g * 128 + c]; }
        __syncthreads();
        const int kk = F.tid & 15, grp = F.tid >> 4;
        float a[8];
#pragma unroll
        for (int o = 0; o < 8; ++o) a[o] = 0.f;
        for (int c = 0; c < 128; ++c) { const float uv = u[kk * 129 + c];
#pragma unroll
            for (int o = 0; o < 8; ++o) { const int mcs = grp * 8 + o, mm = mcs >> 1, cs = mcs & 1; a[o] += uv * T[(mm * c - 32 * cs) & 127]; } }
#pragma unroll
        for (int o = 0; o < 8; ++o) { const int mcs = grp * 8 + o; unsigned short hv = (unsigned short)(pk2(a[o], 0.f) & 0xffffu); WT[(size_t)(g * 256 + mcs) * 1024 + k0 + kk] = hv; }
    }
    __syncthreads();
}
DI void krope_phase(const Frame& F, int crank, int ncu) {
    const bf16_t* H = (const bf16_t*)(F.ws + WS_HB); const bf16_t* Wk = (const bf16_t*)(F.ws + WS_W + W_KR); bf16_t* KR = (bf16_t*)(F.ws + WS_KR);
    const float* rm = (const float*)(F.ws + WS_ROPEM);
    const int r32 = F.lane & 31, h5 = F.lane >> 5, w = F.wave;
    LAS float* part = (LAS float*)F.lds;
    for (int it = crank; it < MT / 32; it += ncu) {
        const int row0 = it * 32;
        f32x16 acc;
#pragma unroll
        for (int i = 0; i < 16; ++i) acc[i] = 0.f;
        const bf16_t* hp = H + (size_t)(row0 + r32) * 1024 + 8 * h5 + 128 * w; const bf16_t* wp = Wk + (size_t)r32 * 1024 + 8 * h5 + 128 * w;
        bf16x8 a[8], b[8];
#pragma unroll
        for (int q = 0; q < 8; ++q) { a[q] = *(const bf16x8*)(wp + 16 * q); b[q] = *(const bf16x8*)(hp + 16 * q); }
#pragma unroll
        for (int q = 0; q < 8; ++q) acc = MFMA32(a[q], b[q], acc);
        __syncthreads();
#pragma unroll
        for (int i = 0; i < 16; ++i) part[(w * 16 + i) * 64 + F.lane] = acc[i];
        __syncthreads();
        if (w == 0) {
#pragma unroll
            for (int i = 0; i < 16; ++i) { float sacc = 0.f;
#pragma unroll
                for (int q = 0; q < 8; ++q) sacc += part[(q * 16 + i) * 64 + F.lane];
                acc[i] = sacc; }
            const int row = row0 + r32;
            f32x16 oth;
#pragma unroll
            for (int i = 0; i < 16; ++i) oth[i] = shx(acc[i], 32, F.lane);
            u32x2 wv[4];
#pragma unroll
            for (int g = 0; g < 4; ++g) { float o[4];
#pragma unroll
                for (int e = 0; e < 4; ++e) { const int i = 4 * g + e; float x1 = h5 ? oth[i] : acc[i], x2 = h5 ? acc[i] : oth[i]; float cs = 1.f, sn = 0.f;
                    if (row < ML) { cs = rm[(size_t)(row & 2047) * 32 + i]; sn = rm[(size_t)(row & 2047) * 32 + 16 + i]; }
                    o[e] = h5 ? (x1 * sn + x2 * cs) : (x1 * cs - x2 * sn); }
                wv[g].x = pk2(o[0], o[1]); wv[g].y = pk2(o[2], o[3]); }
#pragma unroll
            for (int g = 0; g < 4; ++g) *(u32x2*)(KR + (size_t)row * 32 + 8 * g + 4 * h5) = wv[g];
        }
    }
    __syncthreads();
}

DI void prologue_a(const Frame& F) {
    unsigned char* ws = F.ws;
    convert_weights<0, 5>(F, 0, F.vcu, F.G);
    fold_fourier(F, 0, F.bid, F.G);
    { const int gt = F.bid * 512 + F.tid, NT = F.G * 512;
      float* rm = (float*)(ws + WS_ROPEM); float* rg = (float*)(ws + WS_ROPEG);
      for (int e = gt; e < 2048 * 16; e += NT) { const int pos = e >> 4, i = e & 15; const float fr_ = powf(10000.f, -(float)(i & 7) / 8.f); const float p_ = (i < 8) ? (float)(pos >> 6) : (float)(pos & 63);
          float sn, cs; sincosf(p_ * fr_, &sn, &cs); rm[pos * 32 + i] = cs; rm[pos * 32 + 16 + i] = sn; }
      for (int e = gt; e < 2048 * 32; e += NT) { const int pos = e >> 5, i = e & 31; const float fr_ = powf(10000.f, -(float)(i & 15) / 16.f); const float p_ = (i < 16) ? (float)(pos >> 6) : (float)(pos & 63);
          float sn, cs; sincosf(p_ * fr_, &sn, &cs); rg[pos * 64 + i] = cs; rg[pos * 64 + 32 + i] = sn; }
      bf16_t* dm = (bf16_t*)(ws + WS_DFTM);
      for (int e = gt; e < 2048 * 1024; e += NT) { const int k = e >> 10, j2 = (e & 1023) * 2; unsigned wv[2];
#pragma unroll
          for (int q = 0; q < 2; ++q) { const int j = j2 + q * 2048; float v0, v1; { const int jj = j & 2047; const float a0 = (float)((k * jj) & 2047) * (1.f / 1024.f), a1 = (float)((k * (jj + 1)) & 2047) * (1.f / 1024.f);
              if (j < 2048) { v0 = cospif(a0); v1 = cospif(a1); } else { v0 = -sinpif(a0); v1 = -sinpif(a1); } }
              wv[q] = pk2(v0 * (1.f / 512.f), v1 * (1.f / 512.f)); }
          *(unsigned*)(dm + (size_t)k * 4096 + j2) = wv[0]; *(unsigned*)(dm + (size_t)k * 4096 + 2048 + j2) = wv[1]; }
      bf16_t* dc = (bf16_t*)(ws + WS_DFTMC); const float sc = 0.005524271728019903f;
      for (int e = gt; e < 256 * 512; e += NT) { const int k = e >> 9, j = e & 511, jj = j & 255; const float a0 = (float)((k * jj) & 255) * (1.f / 128.f);
          const float v = (j < 256) ? cospif(a0) : -sinpif(a0); dc[e] = (unsigned short)(pk2(v * sc, 0.f) & 0xffffu); }
    }
    { __syncthreads();
      LAS float* sl = (LAS float*)F.lds;
      LAS float* red = (LAS float*)(F.lds + 36864);
      for (int e = F.tid; e < 9 * 1024; e += 512) { const int r = e >> 10, k = e & 1023; const float c = r < 8 ? pin(F, I_C)[r * 1024 + k] : pin(F, I_CCTX)[k]; sl[e] = c / (1.f + __expf(-c)); }
      __syncthreads();
      const int col = F.tid & 63, kg = F.tid >> 6;
      for (int item = F.bid; item < 4 * 96; item += F.G) {
          const int l = item / 96, cb = (item % 96) * 64;
          const float* wa = pin(F, I_WADA) + (size_t)l * 1024 * 6144 + cb + col;
          float a[9];
#pragma unroll
          for (int r = 0; r < 9; ++r) a[r] = 0.f;
          for (int k0 = kg * 128; k0 < kg * 128 + 128; k0 += 16) { float wv[16];
#pragma unroll
              for (int q = 0; q < 16; ++q) wv[q] = wa[(size_t)(k0 + q) * 6144];
#pragma unroll
              for (int q = 0; q < 16; ++q)
#pragma unroll
                  for (int r = 0; r < 9; ++r) a[r] += sl[r * 1024 + k0 + q] * wv[q]; }
#pragma unroll
          for (int r = 0; r < 9; ++r) red[(kg * 9 + r) * 64 + col] = a[r];
          __syncthreads();
          for (int e = F.tid; e < 9 * 64; e += 512) { const int r = e >> 6, c2 = e & 63; float s = pin(F, I_BADA)[l * 6144 + cb + c2];
#pragma unroll
              for (int q = 0; q < 8; ++q) s += red[(q * 9 + r) * 64 + c2];
              ((float*)(ws + WS_MOD))[(size_t)(l * 9 + r) * 6144 + cb + c2] = s; }
          __syncthreads();
      }
    }
}
DI void prologue_b(const Frame& F) {
    const int gw = F.vcu * 8 + F.wave, NGW = F.G * 8;
    bf16_t* H = (bf16_t*)(F.ws + WS_HB);
    for (int row = gw; row < MT; row += NGW) {
        const int mr = row < ML ? (row >> 11) : 8;
        const float* xi = row < ML ? pin(F, I_X) + (size_t)row * D : pin(F, I_CTX) + (size_t)(row - ML) * D;
        ln_row(F, xi, nullptr, nullptr, nullptr, modp(F, 0, mr, 0), modp(F, 0, mr, 1), H + (size_t)row * D);
    }
}
DI void ln_phase(const Frame& F, int which) {
    const int gw = F.vcu * 8 + F.wave, NGW = F.G * 8; const int l = F.l;
    const int nrows = (l == NL - 1) ? ML : MT;
    bf16_t* H = (bf16_t*)(F.ws + WS_HB);
    const float* g = pin(F, which == 0 ? I_LN1G : I_LN2G) + l * 1024; const float* b = pin(F, which == 0 ? I_LN1B : I_LN2B) + l * 1024;
    const bool wh = !(which == 1 && l == NL - 1);
    f32x4 vc[4], vn[4];
    if (gw < nrows) ln_load(F, xrow_ptr(F, gw), vc);
    for (int row = gw; row < nrows; row += NGW) {
        if (row + NGW < nrows) ln_load(F, xrow_ptr(F, row + NGW), vn);
        const int mr = row < ML ? (row >> 11) : 8;
        const float* sh = which == 0 ? modp(F, l, mr, 3) : modp(F, l + 1 < NL ? l + 1 : l, mr, 0);
        const float* sc = which == 0 ? modp(F, l, mr, 4) : modp(F, l + 1 < NL ? l + 1 : l, mr, 1);
        const bool sl = (which == 1 && row >= ML);
        const bool st_only = row < ML && !(which == 1 && l == NL - 1);
        float* stp = st_only ? (float*)(F.ws + (which == 0 ? WS_ST1 : WS_ST2)) + 2 * (size_t)row : nullptr;
        ln_row_v(F, vc, st_only ? nullptr : xrow_ptr(F, row), g, b, sh, sc, wh ? H + (size_t)row * D : nullptr, sl ? (const float*)(F.ws + WS_KN) + (size_t)(row - ML) * 1024 : nullptr, modp(F, l, mr, 5), stp);
#pragma unroll
        for (int j = 0; j < 4; ++j) vc[j] = vn[j];
    }
}

DI void phase_g1(const Frame& F) {
    const unsigned char* W = F.ws + WS_W; const char* H = (const char*)(F.ws + WS_HB);
    pg8::Sched2 S; S.tileBytes = 256L * 1024 * 2; S.G = F.G; S.c = F.bid;
    S.j0 = pg8::JobD{H, (const char*)(W + W_IN), MT / 256, NIN / 256, 1, 0, 0};
    S.j1 = pg8::JobD{(const char*)(W + W_T), H, 4, MT / 256, 1, 0, 0};
    S.n0 = (MT / 256) * (NIN / 256); S.total = S.n0 + 4 * (MT / 256);
    krope_phase(F, F.bid, F.G);
    EpiG1 E{F};
    pg8::gemm_phase(F.lds, 1024, S, E, F.tid);
}
DI void phase_g2(const Frame& F) {
    const unsigned char* W = F.ws + WS_W;
    pg8::Sched2 S; S.tileBytes = 256L * 256 * 2; S.G = F.G; S.c = F.bid;
    S.j0 = pg8::JobD{(const char*)(F.ws + WS_CKV), (const char*)(W + W_UKV), MT / 256, 4, 1, 0, 0};
    S.j1 = pg8::JobD{(const char*)(F.ws + WS_CQ), (const char*)(W + W_UQ), MT / 256, 3, 1, 0, 0};
    S.n0 = (MT / 256) * 4; S.total = S.n0 + (MT / 256) * 3;
    EpiG2 E{F};
    pg8::gemm_phase(F.lds, 256, S, E, F.tid);
}
DI void phase_att(const Frame& F) {
    const bool lastl = (F.l == NL - 1);
    const int nun = (!lastl && F.vcu < 128) ? 5 : 4;
#pragma unroll 1
    for (int i = 0; i < nun; ++i) {
        int kind, b, h, q0, nt;
        if (i < 4) { const int idx = (i >> 1) * 256 + F.vcu; kind = i & 1; b = idx >> 6; h = (idx >> 3) & 7; q0 = b * SEQ + (idx & 7) * 256; nt = 36; }
        else { const int idx = F.vcu >> 1; kind = F.vcu & 1; b = idx >> 3; h = idx & 7; q0 = ML + b * CTXL; nt = 4; }
        if (kind == 0) attn_unit<0>(F, q0, h, ML + b * CTXL, b * SEQ, nt);
        else attn_unit<1>(F, q0, h, ML + b * CTXL, b * SEQ, nt);
    }
    __syncthreads();
#ifndef NO_DFT
    {
        pg8::Sched2 S; S.tileBytes = 256L * 4096 * 2; S.G = F.G; S.c = (F.bid + 128) & 255;
        S.j0 = pg8::JobD{(const char*)(F.ws + WS_DFTM), (const char*)(F.ws + WS_TF), 8, 2, 8, 0, 1024L * 2048 * 2}; S.j1 = S.j0;
        S.n0 = 128; S.total = 128;
        EpiDft E{(bf16_t*)(F.ws + WS_F), 2048, 512};
        pg8::gemm_phase(F.lds, 4096, S, E, F.tid);
#ifdef PROBE_DFT
        pg8::gemm_phase(F.lds, 4096, S, E, F.tid);
#endif
    }
    if (!lastl) {
        pg8::Sched2 S; S.tileBytes = 256L * 512 * 2; S.G = F.G; S.c = F.bid;
        S.j0 = pg8::JobD{(const char*)(F.ws + WS_DFTMC), (const char*)(F.ws + WS_TFC), 1, 2, 8, 0, 1024L * 256 * 2}; S.j1 = S.j0;
        S.n0 = 16; S.total = 16;
        EpiDft E{(bf16_t*)(F.ws + WS_F) + (size_t)ML * 512, 256, 512};
        pg8::gemm_phase(F.lds, 512, S, E, F.tid);
    }
#endif
    if (F.bid < 128) {
        __syncthreads();
        const int cr = (F.bid & 7) * 16 + (F.bid >> 3);
        convert_weights<5, 11>(F, F.l, cr, 128);
    }
}
DI void phase_g3(const Frame& F) {
    const unsigned char* W = F.ws + WS_W; const int nM = (F.l == NL - 1 ? ML : MT) / 256;
    pg8::Sched3 S; S.tileBytes = 256L * 512 * 2; S.G = F.G; S.c = F.bid; S.ntiles = nM * 4;
    S.j = pg8::JobD{(const char*)(F.ws + WS_F), (const char*)(W + W_FO), nM, 4, 1, 0, 0};
    S.A1 = (const char*)(F.ws + WS_AM); S.B1 = (const char*)(W + W_MO); S.A2 = (const char*)(F.ws + WS_QG); S.B2 = (const char*)(W + W_GO);
    EpiG3 E{F};
    pg8::gemm_phase(F.lds, 512, S, E, F.tid);
    if (F.l + 1 < NL && F.bid >= 32) {
        __syncthreads();
        convert_weights<0, 5>(F, F.l + 1, F.bid - 32, F.G - 32); fold_fourier(F, F.l + 1, F.bid - 32, F.G - 32);
    }
}
DI void phase_g4(const Frame& F) {
    const unsigned char* W = F.ws + WS_W; const int nM = (F.l == NL - 1 ? ML : MT) / 256;
    pg8::Sched2 S; S.tileBytes = 256L * 1024 * 2; S.G = F.G; S.c = F.bid;
    S.j0 = pg8::JobD{(const char*)(F.ws + WS_HB), (const char*)(W + W_O), nM, 4, 1, 0, 0}; S.j1 = S.j0; S.n0 = nM * 4; S.total = S.n0;
    EpiRes E{F, 2, true, F.l > 0 ? 2 : 0};
    pg8::gemm_phase(F.lds, 1024, S, E, F.tid);
}
DI void phase_g5(const Frame& F) {
    const unsigned char* W = F.ws + WS_W; const int nM = (F.l == NL - 1 ? ML : MT) / 256;
    pg8::Sched2 S; S.tileBytes = 256L * 1024 * 2; S.G = F.G; S.c = F.bid;
    S.j0 = pg8::JobD{(const char*)(F.ws + WS_HB), (const char*)(W + W_1), nM, 16, 1, 0, 0}; S.j1 = S.j0; S.n0 = nM * 16; S.total = S.n0;
    EpiW1 E{F};
    pg8::gemm_phase(F.lds, 1024, S, E, F.tid);
#ifdef PROBE_G5
    pg8::gemm_phase(F.lds, 1024, S, E, F.tid);
#endif
}
DI void phase_g6(const Frame& F) {
    const unsigned char* W = F.ws + WS_W;
    {
        pg8::Sched2 S; S.tileBytes = 256L * 4096 * 2; S.G = F.G; S.c = F.bid;
        S.j0 = pg8::JobD{(const char*)(F.ws + WS_U), (const char*)(W + W_2), ML / 256, 4, 1, 0, 0}; S.j1 = S.j0; S.n0 = (ML / 256) * 4; S.total = S.n0;
        EpiRes E{F, 5, false, 1};
        pg8::gemm_phase(F.lds, 4096, S, E, F.tid);
    }
    if (F.l < NL - 1) {
        pg8::Sched2 S; S.tileBytes = 256L * 4096 * 2; S.G = F.G; S.c = F.bid;
        S.j0 = pg8::JobD{(const char*)(F.ws + WS_U) + (size_t)ML * 4096 * 2, (const char*)(W + W_2), MC / 256, 4, 8, 512 * 2, 512 * 2}; S.j1 = S.j0; S.n0 = (MC / 256) * 4 * 8; S.total = S.n0;
        EpiSlab E{(float*)(F.ws + WS_KN)};
        pg8::gemm_phase<4096>(F.lds, 512, S, E, F.tid);
    }
}

constexpr int N_PHASES = 2 + 9 * NL;
template <int ONLY>
__global__ void __launch_bounds__(512, 2) fwd_kernel(Params prm) {
    extern __shared__ __attribute__((aligned(16))) unsigned char lds_raw[];
    Frame F;
    F.P = &prm; F.ws = prm.ws; F.lds = (LAS unsigned char*)lds_raw;
    F.tid = threadIdx.x; F.lane = F.tid & 63; F.wave = __builtin_amdgcn_readfirstlane(F.tid >> 6);
    F.G = gridDim.x; F.bid = blockIdx.x; F.vcu = (F.G % 8 == 0) ? (F.bid % 8) * (F.G / 8) + F.bid / 8 : F.bid; F.l = 0;
    volatile LAS unsigned* MISC = (volatile LAS unsigned*)(F.lds + MISC_OFF);
    for (int u = F.tid; u < (LDS_BYTES - RING_BYTES) / 4; u += 512) ((LAS unsigned*)(F.lds + RING_BYTES))[u] = 0u;
    __syncthreads();
#if MK_ONE_LAUNCH
    const int lo = 0, hi = N_PHASES;
#else
    const int lo = prm.ph_lo, hi = prm.ph_hi;
#endif
    XcdBarrier bar; bar.bar = (unsigned*)(F.ws + WS_CTL) + 4096; bar.x = 0; bar.st = nullptr;
    if (hi - lo > 1) {
        bar = xcd_barrier_post((unsigned*)(F.ws + WS_CTL) + 4096, MISC + 8);
        cg::this_grid().sync();
        if (threadIdx.x == 0) { unsigned nloc, nx; xcd_barrier_complete(bar.bar, bar.x, nloc, nx); bar.st[0] = nloc; bar.st[1] = nx; }
        __syncthreads();
    }
    const int wave_s = __builtin_amdgcn_readfirstlane(threadIdx.x >> 6);
    for (int ph = lo; ph < hi; ++ph) {
        { int lane_; asm volatile("v_mbcnt_lo_u32_b32 %0, -1, 0\n\tv_mbcnt_hi_u32_b32 %0, -1, %0" : "=v"(lane_));
          int z_ = 0, b_ = blockIdx.x, g_ = gridDim.x, t_ = wave_s * 64 + lane_;
#if (OPQ_MASK & 1)
          asm volatile("" : "+s"(z_));
#endif
#if (OPQ_MASK & 2)
          asm volatile("" : "+s"(b_), "+s"(g_));
#endif
#if (OPQ_MASK & 4)
          asm volatile("" : "+v"(t_));
#endif
          F.ws = prm.ws + z_; F.zo = z_;
          b_ &= 1023; g_ &= 1023; F.bid = b_; F.G = g_; F.vcu = (g_ % 8 == 0) ? (b_ % 8) * (g_ / 8) + b_ / 8 : b_; F.tid = t_ & 511; F.lane = t_ & 63; F.wave = __builtin_amdgcn_readfirstlane((t_ & 511) >> 6); }
        if constexpr (ONLY >= 0) {
            F.l = ph < 2 ? 0 : (ph - 2) / 9;
            if constexpr (ONLY == 100) prologue_a(F);
            else if constexpr (ONLY == 101) prologue_b(F);
            else if constexpr (ONLY == 0) phase_g1(F);
            else if constexpr (ONLY == 1) phase_g2(F);
            else if constexpr (ONLY == 2) phase_att(F);
            else if constexpr (ONLY == 3) phase_g3(F);
            else if constexpr (ONLY == 4) phase_g4(F);
            else if constexpr (ONLY == 5) ln_phase(F, 0);
            else if constexpr (ONLY == 6) phase_g5(F);
            else if constexpr (ONLY == 7) phase_g6(F);
            else ln_phase(F, 1);
            continue;
        }
        if (ph == 0) prologue_a(F);
        else if (ph == 1) prologue_b(F);
        else {
            const int q = ph - 2; F.l = q / 9; const int sub = q - F.l * 9;
            switch (sub) {
            case 0: phase_g1(F); break;
            case 1: phase_g2(F); break;
            case 2: phase_att(F); break;
            case 3: phase_g3(F); break;
            case 4: phase_g4(F); break;
            case 5: ln_phase(F, 0); break;
            case 6: phase_g5(F); break;
            case 7: phase_g6(F); break;
            default: ln_phase(F, 1); break;
            }
        }
        if (ph + 1 < hi) { XcdBarrier b2; b2.bar = (unsigned*)(F.ws + WS_CTL) + 4096; b2.x = xb_xcc_id(); b2.st = (volatile LAS unsigned*)(F.lds + MISC_OFF) + 8; xcd_barrier(b2, F.tid); }
    }
}

extern "C" void kernel_launch(void* const* d_in, const int* in_sizes, int n_in, void* d_out, int out_size, void* d_ws, size_t ws_size, hipStream_t stream) {
    static int grid = 0;
    if (grid == 0) {
        if (n_in != 25 || out_size != ML * D || ws_size < WS_END) { fprintf(stderr, "kernel_launch: unexpected shapes (n_in %d out %d ws %zu)\n", n_in, out_size, ws_size); grid = -1; return; }
        int dev = 0, cus = 0, per_cu = 0;
        (void)hipGetDevice(&dev); (void)hipDeviceGetAttribute(&cus, hipDeviceAttributeMultiprocessorCount, dev);
#if MK_ONE_LAUNCH
        (void)hipFuncSetAttribute((const void*)fwd_kernel<-1>, hipFuncAttributeMaxDynamicSharedMemorySize, LDS_BYTES);
        (void)hipOccupancyMaxActiveBlocksPerMultiprocessor(&per_cu, (const void*)fwd_kernel<-1>, 512, LDS_BYTES);
#else
        (void)hipFuncSetAttribute((const void*)fwd_kernel<100>, hipFuncAttributeMaxDynamicSharedMemorySize, LDS_BYTES);
        (void)hipFuncSetAttribute((const void*)fwd_kernel<101>, hipFuncAttributeMaxDynamicSharedMemorySize, LDS_BYTES);
        (void)hipFuncSetAttribute((const void*)fwd_kernel<0>, hipFuncAttributeMaxDynamicSharedMemorySize, LDS_BYTES);
        (void)hipFuncSetAttribute((const void*)fwd_kernel<1>, hipFuncAttributeMaxDynamicSharedMemorySize, LDS_BYTES);
        (void)hipFuncSetAttribute((const void*)fwd_kernel<2>, hipFuncAttributeMaxDynamicSharedMemorySize, LDS_BYTES);
        (void)hipFuncSetAttribute((const void*)fwd_kernel<3>, hipFuncAttributeMaxDynamicSharedMemorySize, LDS_BYTES);
        (void)hipFuncSetAttribute((const void*)fwd_kernel<4>, hipFuncAttributeMaxDynamicSharedMemorySize, LDS_BYTES);
        (void)hipFuncSetAttribute((const void*)fwd_kernel<5>, hipFuncAttributeMaxDynamicSharedMemorySize, LDS_BYTES);
        (void)hipFuncSetAttribute((const void*)fwd_kernel<6>, hipFuncAttributeMaxDynamicSharedMemorySize, LDS_BYTES);
        (void)hipFuncSetAttribute((const void*)fwd_kernel<7>, hipFuncAttributeMaxDynamicSharedMemorySize, LDS_BYTES);
        (void)hipFuncSetAttribute((const void*)fwd_kernel<8>, hipFuncAttributeMaxDynamicSharedMemorySize, LDS_BYTES);
#endif
        (void)hipGetLastError();
        if (per_cu < 1) per_cu = 1;
        grid = cus;
        if (grid != 256) fprintf(stderr, "kernel_launch: grid %d (expected 256)\n", grid);
    }
    if (grid < 0) return;
    (void)hipMemsetAsync((char*)d_ws + WS_CTL, 0, CTL_BYTES, stream);
    Params p{};
    for (int i = 0; i < 25; ++i) p.in[i] = (const float*)d_in[i];
    p.out = (float*)d_out; p.ws = (unsigned char*)d_ws;
#if MK_ONE_LAUNCH
    p.ph_lo = 0; p.ph_hi = N_PHASES;
    void* args[] = {&p};
    hipError_t e = hipLaunchCooperativeKernel((const void*)fwd_kernel<-1>, dim3(grid), dim3(512), args, LDS_BYTES, stream);
    if (e != hipSuccess) fprintf(stderr, "cooperative launch failed: %s\n", hipGetErrorString(e));
#else
    for (int ph = 0; ph < N_PHASES; ++ph) {
        p.ph_lo = ph; p.ph_hi = ph + 1;
        const int sub = ph < 2 ? 100 + ph : (ph - 2) % 9;
        switch (sub) {
        case 100: hipLaunchKernelGGL(fwd_kernel<100>, dim3(grid), dim3(512), LDS_BYTES, stream, p); break;
        case 101: hipLaunchKernelGGL(fwd_kernel<101>, dim3(grid), dim3(512), LDS_BYTES, stream, p); break;
        case 0: hipLaunchKernelGGL(fwd_kernel<0>, dim3(grid), dim3(512), LDS_BYTES, stream, p); break;
        case 1: hipLaunchKernelGGL(fwd_kernel<1>, dim3(grid), dim3(512), LDS_BYTES, stream, p); break;
        case 2: hipLaunchKernelGGL(fwd_kernel<2>, dim3(grid), dim3(512), LDS_BYTES, stream, p); break;
        case 3: hipLaunchKernelGGL(fwd_kernel<3>, dim3(grid), dim3(512), LDS_BYTES, stream, p); break;
        case 4: hipLaunchKernelGGL(fwd_kernel<4>, dim3(grid), dim3(512), LDS_BYTES, stream, p); break;
        case 5: hipLaunchKernelGGL(fwd_kernel<5>, dim3(grid), dim3(512), LDS_BYTES, stream, p); break;
        case 6: hipLaunchKernelGGL(fwd_kernel<6>, dim3(grid), dim3(512), LDS_BYTES, stream, p); break;
        case 7: hipLaunchKernelGGL(fwd_kernel<7>, dim3(grid), dim3(512), LDS_BYTES, stream, p); break;
        default: hipLaunchKernelGGL(fwd_kernel<8>, dim3(grid), dim3(512), LDS_BYTES, stream, p); break;
        }
    }
#endif
}
```

```cpp
#include <hip/hip_runtime.h>
#include <hip/hip_cooperative_groups.h>
#include <cstdio>
#include <cstdint>
namespace cg = cooperative_groups;

#define LAS __attribute__((address_space(3)))
#define DI __device__ __forceinline__
typedef unsigned short bf16_t;
typedef short bf16x8 __attribute__((ext_vector_type(8)));
typedef short s16x4 __attribute__((ext_vector_type(4)));
typedef float f32x2 __attribute__((ext_vector_type(2)));
typedef float f32x4 __attribute__((ext_vector_type(4)));
typedef float f32x16 __attribute__((ext_vector_type(16)));
typedef unsigned u32x4 __attribute__((ext_vector_type(4)));
typedef unsigned u32x2 __attribute__((ext_vector_type(2)));
typedef __bf16 bf16x2_t __attribute__((ext_vector_type(2)));

#ifndef MK_ONE_LAUNCH
#define MK_ONE_LAUNCH 1
#endif
#ifndef OPQ_MASK
#if MK_ONE_LAUNCH
#define OPQ_MASK 7
#else
#define OPQ_MASK 0
#endif
#endif

constexpr int D = 1024, NB = 8, SEQ = 2048, CTXL = 256, NL = 4;
constexpr int ML = NB * SEQ, MC = NB * CTXL, MT = ML + MC;
constexpr int DFF = 4096, INC = 4896;
constexpr float EPS = 1e-6f;
constexpr float ALPHA = 1.6817928305074290f;
constexpr float QS_MLA = (float)(0.10206207261596575 * 1.4426950408889634);
constexpr float QS_GQA = (float)(0.125 * 1.4426950408889634);
constexpr int NIN = 4352;

constexpr size_t MiB = 1u << 20;
constexpr size_t WS_CTL = 0, CTL_BYTES = 65536;
constexpr size_t WS_MOD = 1 * MiB;
constexpr size_t WS_ROPEM = 2 * MiB;
constexpr size_t WS_ROPEG = 2 * MiB + 262144;
constexpr size_t WS_SSKV = 3 * MiB, WS_SSQ = 3 * MiB + 524288;
constexpr size_t WS_DFTMC = 4 * MiB;
constexpr size_t WS_ST1 = 4 * MiB + 524288, WS_ST2 = 4 * MiB + 786432;
constexpr size_t WS_DFTM = 5 * MiB;
constexpr size_t WS_W = 21 * MiB;
constexpr size_t W_IN = 0, W_KR = 8 * MiB + 524288, W_T = 9 * MiB, W_UKV = 11 * MiB, W_UQ = 11 * MiB + 524288, W_FO = 12 * MiB, W_MO = 13 * MiB,
                 W_GO = 14 * MiB, W_O = 15 * MiB, W_1 = 17 * MiB, W_2 = 25 * MiB;
constexpr size_t WS_XC = 54 * MiB;
constexpr size_t WS_HB = 62 * MiB;
constexpr size_t WS_CKV = 98 * MiB, WS_CQ = 107 * MiB, WS_KG = 116 * MiB, WS_VG = 120 * MiB + 524288, WS_QG = 125 * MiB, WS_KR = 143 * MiB;
constexpr size_t WS_KN = 145 * MiB, WS_VM = 163 * MiB, WS_QM = 181 * MiB;
constexpr size_t WS_F = 208 * MiB, WS_AM = 226 * MiB;
constexpr size_t WS_GATE = 244 * MiB, WS_TF = 352 * MiB, WS_TFC = 384 * MiB, WS_U = 244 * MiB;
constexpr size_t WS_END = 388 * MiB;

constexpr int LDS_BYTES = 147456, RING_BYTES = 131072, MISC_OFF = RING_BYTES + 320;

struct Params {
    const float* in[25];
    float* out;
    unsigned char* ws;
    int ph_lo, ph_hi;
};
enum { I_X = 0, I_C, I_CTX, I_CCTX, I_WADA, I_BADA, I_WIN, I_BGATE, I_MQG, I_MKVG, I_WUQ, I_WUK, I_WUV, I_GQG, I_GKG, I_WFO, I_WMO, I_WGO, I_WO,
       I_LN1G, I_LN1B, I_W1, I_W2, I_LN2G, I_LN2B };

DI unsigned pk2(float lo, float hi) { f32x2 v = {lo, hi}; bf16x2_t b = __builtin_convertvector(v, bf16x2_t); return __builtin_bit_cast(unsigned, b); }
DI u32x4 pk8(const f32x4& a, const f32x4& b) { u32x4 w; w.x = pk2(a[0], a[1]); w.y = pk2(a[2], a[3]); w.z = pk2(b[0], b[1]); w.w = pk2(b[2], b[3]); return w; }
DI float bf2f(unsigned short h) { return __uint_as_float((unsigned)h << 16); }
DI void unpk8(const u32x4& w, float* f) {
    f[0] = __uint_as_float(w.x << 16); f[1] = __uint_as_float(w.x & 0xffff0000u); f[2] = __uint_as_float(w.y << 16); f[3] = __uint_as_float(w.y & 0xffff0000u);
    f[4] = __uint_as_float(w.z << 16); f[5] = __uint_as_float(w.z & 0xffff0000u); f[6] = __uint_as_float(w.w << 16); f[7] = __uint_as_float(w.w & 0xffff0000u);
}
DI float shx(float v, int m, int lane) { return __int_as_float(__builtin_amdgcn_ds_bpermute((lane ^ m) << 2, __float_as_int(v))); }
DI float wave_sum(float v, int lane) {
#pragma unroll
    for (int o = 1; o < 64; o <<= 1) v += shx(v, o, lane);
    return v;
}

#define XB_TMO      128
#define XB_XCNT(j)  (256  + 64 * (j))
#define XB_XSUB(j)  (1280 + 64 * (j))
#define XB_XGEN(j)  (2304 + 64 * (j))
#define XB_TOP      3328
#define XB_TOPGEN   3392
#define XB_SPIN_CAP (1u << 22)
DI unsigned xb_ld(unsigned* p)              { return __hip_atomic_load(p, __ATOMIC_RELAXED, __HIP_MEMORY_SCOPE_AGENT); }
DI unsigned xb_add(unsigned* p, unsigned v) { return __hip_atomic_fetch_add(p, v, __ATOMIC_RELAXED, __HIP_MEMORY_SCOPE_AGENT); }
DI unsigned xb_xcc_id() { return (unsigned)__builtin_amdgcn_s_getreg((3 << 11) | 20) & 0xFu; }
#define XB_SPIN(cond, bar) do { unsigned _sp = 0; while (cond) { __builtin_amdgcn_s_sleep(1); \
    if ((++_sp & 255u) == 0u) { if (xb_ld(&(bar)[XB_TMO])) break; if (_sp > XB_SPIN_CAP) { atomicAdd(&(bar)[XB_TMO], 1u); break; } } } } while (0)
struct XcdBarrier { unsigned* bar; unsigned x; volatile LAS unsigned* st; };
DI XcdBarrier xcd_barrier_post(unsigned* bar, volatile LAS unsigned* st) {
    XcdBarrier b; b.bar = bar; b.x = xb_xcc_id(); b.st = st;
    if (threadIdx.x == 0) (void)xb_add(&bar[XB_XCNT(b.x)], 1u);
    return b;
}
DI void xcd_barrier_complete(unsigned* bar, unsigned x, unsigned& nloc, unsigned& nx) {
    const unsigned G = gridDim.x * gridDim.y * gridDim.z;
    unsigned sum, cnt, mine, sp = 0u;
    for (;;) {
        sum = 0u; cnt = 0u; mine = 0u;
#pragma unroll
        for (unsigned j = 0; j < 16; ++j) { const unsigned c = xb_ld(&bar[XB_XCNT(j)]); sum += c; cnt += (c > 0u) ? 1u : 0u; mine = (j == x) ? c : mine; }
        if (sum == G) break;
        __builtin_amdgcn_s_sleep(1);
        if ((++sp & 255u) == 0u) { if (xb_ld(&bar[XB_TMO])) break; if (sp > XB_SPIN_CAP) { atomicAdd(&bar[XB_TMO], 1u); break; } }
    }
    nloc = mine > 0u ? mine : 1u; nx = cnt > 0u ? cnt : 1u;
}
DI void xcd_barrier(const XcdBarrier& b, const int tid) {
    asm volatile("s_waitcnt vmcnt(0)" ::: "memory");
    __syncthreads();
    if (tid == 0) {
        unsigned* bar = b.bar;
        __builtin_amdgcn_s_waitcnt(0);
        unsigned nloc = b.st[0], nx = b.st[1];
        const unsigned old = xb_add(&bar[XB_XSUB(b.x)], 1u);
        const unsigned gen = old / nloc;
        if (old + 1u == (gen + 1u) * nloc) {
            __builtin_amdgcn_fence(__ATOMIC_RELEASE, "agent");
            asm volatile("s_waitcnt vmcnt(0)" ::: "memory");
            const unsigned og = xb_add(&bar[XB_TOP], 1u);
            const unsigned tg = og / nx;
            if (og + 1u == (tg + 1u) * nx) xb_add(&bar[XB_TOPGEN], 1u);
            else XB_SPIN(xb_ld(&bar[XB_TOPGEN]) == tg, bar);
            __builtin_amdgcn_fence(__ATOMIC_ACQUIRE, "agent");
            xb_add(&bar[XB_XGEN(b.x)], 1u);
            asm volatile("s_waitcnt vmcnt(0)" ::: "memory");
        } else {
            XB_SPIN(xb_ld(&bar[XB_XGEN(b.x)]) == gen, bar);
            __builtin_amdgcn_fence(__ATOMIC_ACQUIRE, "agent");
            asm volatile("s_waitcnt vmcnt(0)" ::: "memory");
        }
    }
    __syncthreads();
}

namespace pg8 {
constexpr int BM = 256, BK = 64, HALF = 128, HTB = HALF * BK * 2;
DI int lds_byte(int r, int c) { const int st = (r >> 4) * 2 + (c >> 5), rr = r & 15, cc = c & 31, ob = rr * 64 + cc * 2; return st * 1024 + (ob ^ (((ob >> 9) & 1) << 5)); }
DI void stage_rc(int b, int& R, int& C) { const int st = b / 1024, sb = b % 1024, swz = sb ^ (((sb >> 9) & 1) << 5); R = (st >> 1) * 16 + swz / 64; C = (st & 1) * 32 + (swz % 64) / 2; }
DI int perm32(int rho) { const int n = rho >> 4, i = rho & 15; return 8 * (i >> 2) + 4 * n + (i & 3); }

struct Unit { const char* A; const char* B; int job, pm, pn, z, seg; bool last; };
struct JobD { const char* A; const char* B; int nM, nN, nZ; long Az, Bz; };
DI void decode(const JobD& j, int t, long tileBytes, int jobid, Unit& u) {
    const int nMt = j.nM * j.nZ, nwg = nMt * j.nN;
    int wg; { const int q = nwg >> 3, r = nwg & 7, xcd = t & 7, off = t >> 3; wg = (xcd < r ? xcd * (q + 1) : r * (q + 1) + (xcd - r) * q) + off; }
    const int nig = 8 * j.nN, gid = wg / nig, fm = gid * 8, gsz = (nMt - fm) < 8 ? (nMt - fm) : 8;
    const int rem = wg - gid * nig, pn = rem / gsz, pmt = fm + (rem - pn * gsz);
    const int z = pmt / j.nM, pm = pmt - z * j.nM;
    u.A = j.A + (long)z * j.Az + (long)pm * tileBytes; u.B = j.B + (long)z * j.Bz + (long)pn * tileBytes;
    u.job = jobid; u.pm = pm; u.pn = pn; u.z = z; u.seg = 0; u.last = true;
}
struct Sched2 {
    JobD j0, j1; int n0, total, G, c; long tileBytes;
    DI bool next(int i, Unit& u) const {
        const long L = (long)i * G + c; if (L >= total) return false;
        if ((int)L < n0) decode(j0, (int)L, tileBytes, 0, u); else decode(j1, (int)L - n0, tileBytes, 1, u);
        return true;
    }
};
struct Sched3 {
    JobD j; const char* A1; const char* A2; const char* B1; const char* B2; int ntiles, G, c; long tileBytes;
    DI bool next(int i, Unit& u) const {
        const int ti = i / 3, seg = i - ti * 3; const long L = (long)ti * G + c; if (L >= ntiles) return false;
        decode(j, (int)L, tileBytes, 0, u);
        if (seg == 1) { u.A = A1 + (u.A - j.A); u.B = B1 + (u.B - j.B); }
        if (seg == 2) { u.A = A2 + (u.A - j.A); u.B = B2 + (u.B - j.B); }
        u.seg = seg; u.last = (seg == 2);
        return true;
    }
};

typedef f32x4 Acc[2][2][4][2];
template <int PITCH = 0, class Epi, class Sched>
DI void gemm_phase(LAS unsigned char* lds, const int K_, const Sched& S, const Epi& E, const int tid_in) {
    int Kq = K_; asm volatile("" : "+s"(Kq)); const int K = Kq & 0x1fc0;
    int tid_ = tid_in;
#ifndef NO_OPQ_TID
    asm volatile("" : "+v"(tid_));
#endif
    const int tid = tid_ & 511, wid = __builtin_amdgcn_readfirstlane(tid >> 6), lane = tid & 63, wr = wid >> 2, wc = wid & 3, fr = lane & 15, fq = lane >> 4;
    const int nt = K / BK;
    unsigned voffA[2], voffB[2];
#pragma unroll
    for (int i = 0; i < 2; ++i) { int R, C; stage_rc(tid * 16 + i * 8192, R, C); const int Rb = (R & ~31) + perm32(R & 31);
        voffA[i] = (unsigned)(R * (PITCH ? PITCH : K) + C) * 2u; voffB[i] = (unsigned)(Rb * (PITCH ? PITCH : K) + C) * 2u; }
    const size_t kstep = (size_t)(BK * 2);
    const size_t hstep = (size_t)HALF * (PITCH ? PITCH : K) * 2;
    const unsigned ldsw = (unsigned)wid * 1024u;
    const int aoff = lds_byte(wr * 64 + fr, fq * 8), boff = lds_byte(wc * 32 + fr, fq * 8);
#define PG8_SA(b, h) (((b) * 2 + (h)) * HTB)
#define PG8_SB(b, h) ((4 + (b) * 2 + (h)) * HTB)
#define PG8_STAGE(bufoff, gbase, voff) do { _Pragma("unroll") for (int _i = 0; _i < 2; ++_i) \
        __builtin_amdgcn_global_load_lds((const unsigned*)((const char*)(gbase) + (voff)[_i]), (LAS unsigned*)(lds + (bufoff) + ldsw + _i * 8192), 16, 0, 0); } while (0)
#define PG8_LDA(dst, b, h) do { _Pragma("unroll") for (int m = 0; m < 4; ++m) _Pragma("unroll") for (int k = 0; k < 2; ++k) dst[m][k] = *(const LAS bf16x8*)(lds + PG8_SA(b, h) + aoff + m * 2048 + k * 1024); } while (0)
#define PG8_LDB(dst, b, h) do { _Pragma("unroll") for (int n = 0; n < 2; ++n) _Pragma("unroll") for (int k = 0; k < 2; ++k) dst[n][k] = *(const LAS bf16x8*)(lds + PG8_SB(b, h) + boff + n * 2048 + k * 1024); } while (0)
#define PG8_MMA(ai, bj, At, Bt) do { __builtin_amdgcn_s_setprio(1); _Pragma("unroll") for (int m = 0; m < 4; ++m) _Pragma("unroll") for (int n = 0; n < 2; ++n) _Pragma("unroll") for (int k = 0; k < 2; ++k) \
        acc[ai][bj][m][n] = __builtin_amdgcn_mfma_f32_16x16x32_bf16(Bt[n][k], At[m][k], acc[ai][bj][m][n], 0, 0, 0); __builtin_amdgcn_s_setprio(0); } while (0)
#define PG8_WAIT_V(n) asm volatile("s_waitcnt vmcnt(" #n ")" ::: "memory")
#define PG8_WAIT_L(n) asm volatile("s_waitcnt lgkmcnt(" #n ")" ::: "memory")
#define PG8_BAR __builtin_amdgcn_s_barrier()
#define PG8_SCHED __builtin_amdgcn_sched_barrier(0)
    Unit cur, nxt; int ui = 0;
    if (!S.next(0, cur)) return;
    Acc acc;
#pragma unroll
    for (int a = 0; a < 2; ++a)
#pragma unroll
        for (int b = 0; b < 2; ++b)
#pragma unroll
            for (int m = 0; m < 4; ++m)
#pragma unroll
                for (int n = 0; n < 2; ++n) acc[a][b][m][n] = (f32x4){0.f, 0.f, 0.f, 0.f};
    bf16x8 At[4][2], B0[2][2], B1[2][2];
    const char* cA = cur.A; const char* cB = cur.B;
    PG8_STAGE(PG8_SB(0, 0), cB, voffB); PG8_STAGE(PG8_SB(0, 1), cB + hstep, voffB); PG8_STAGE(PG8_SA(0, 0), cA, voffA); PG8_STAGE(PG8_SA(0, 1), cA + hstep, voffA);
    if (wr == 1) PG8_BAR;
    PG8_WAIT_V(2); PG8_BAR;
    PG8_STAGE(PG8_SB(1, 0), cB + kstep, voffB); PG8_STAGE(PG8_SA(1, 0), cA + kstep, voffA); PG8_STAGE(PG8_SB(1, 1), cB + hstep + kstep, voffB);
    PG8_WAIT_V(6); PG8_BAR;
    for (;;) {
        const bool has_next = S.next(ui + 1, nxt);
        const char* nA = has_next ? nxt.A : cA; const char* nB = has_next ? nxt.B : cB;
        for (int t = 0; t < nt; t += 2) {
            const bool last = (t == nt - 2);
            const char* a1 = cA + (size_t)(t + 1) * kstep;
            const char* a2 = last ? nA : cA + (size_t)(t + 2) * kstep; const char* b2 = last ? nB : cB + (size_t)(t + 2) * kstep;
            const char* a3 = a2 + kstep; const char* b3 = b2 + kstep;
            PG8_LDB(B0, 0, 0); PG8_LDB(B1, 0, 1); PG8_SCHED; PG8_LDA(At, 0, 0); PG8_STAGE(PG8_SA(1, 1), a1 + hstep, voffA);
            PG8_WAIT_V(8); PG8_WAIT_L(0); PG8_BAR; PG8_MMA(0, 0, At, B0); PG8_MMA(0, 1, At, B1); PG8_BAR; PG8_SCHED;
            PG8_LDA(At, 0, 1); PG8_STAGE(PG8_SB(0, 0), b2, voffB); PG8_STAGE(PG8_SB(0, 1), b2 + hstep, voffB); PG8_STAGE(PG8_SA(0, 0), a2, voffA);
            PG8_WAIT_V(8); PG8_WAIT_L(0); PG8_BAR; PG8_MMA(1, 0, At, B0); PG8_MMA(1, 1, At, B1); PG8_BAR; PG8_SCHED;
            PG8_LDB(B0, 1, 0); PG8_LDB(B1, 1, 1); PG8_SCHED; PG8_LDA(At, 1, 0); PG8_STAGE(PG8_SA(0, 1), a2 + hstep, voffA);
            PG8_WAIT_V(8); PG8_WAIT_L(0); PG8_BAR; PG8_MMA(0, 0, At, B0); PG8_MMA(0, 1, At, B1); PG8_BAR; PG8_SCHED;
            PG8_LDA(At, 1, 1); PG8_STAGE(PG8_SB(1, 0), b3, voffB); PG8_STAGE(PG8_SB(1, 1), b3 + hstep, voffB); PG8_STAGE(PG8_SA(1, 0), a3, voffA);
            PG8_WAIT_V(8); PG8_WAIT_L(0); PG8_BAR; PG8_MMA(1, 0, At, B0); PG8_MMA(1, 1, At, B1); PG8_BAR; PG8_SCHED;
        }
        if (wr == 0) PG8_BAR;
        E(acc, cur, wr, wc, fr, fq);
        if (!has_next) break;
        if (cur.last) {
#pragma unroll
            for (int a = 0; a < 2; ++a)
#pragma unroll
                for (int b = 0; b < 2; ++b)
#pragma unroll
                    for (int m = 0; m < 4; ++m)
#pragma unroll
                        for (int n = 0; n < 2; ++n) acc[a][b][m][n] = (f32x4){0.f, 0.f, 0.f, 0.f};
        }
        cur = nxt; cA = nA; cB = nB; ++ui;
        if (wr == 1) PG8_BAR;
    }
    PG8_WAIT_V(0);
    PG8_BAR;
#undef PG8_SA
#undef PG8_SB
#undef PG8_STAGE
#undef PG8_LDA
#undef PG8_LDB
#undef PG8_MMA
#undef PG8_WAIT_V
#undef PG8_WAIT_L
#undef PG8_BAR
#undef PG8_SCHED
}
}
using pg8::Acc; using pg8::Unit;

struct Frame {
    const Params* P;
    unsigned char* ws;
    LAS unsigned char* lds;
    int tid, lane, wave, G, bid, vcu;
    int l;
    int zo;
};
DI const float* pin(const Frame& F, int idx) { return F.P->in[idx + F.zo]; }
DI const float* inl(const Frame& F, int idx, size_t per_layer) { return pin(F, idx) + (size_t)F.l * per_layer; }
DI const float* modp(const Frame& F, int l, int mr, int which) { return (const float*)(F.ws + WS_MOD) + ((size_t)(l * 9 + mr) * 6 + which) * 1024; }
DI int modrow_of_tile(int row0) { return row0 < ML ? (row0 >> 11) : 8; }
DI float* xrow_ptr(const Frame& F, int row) { return row < ML ? F.P->out + (size_t)row * D : (float*)(F.ws + WS_XC) + (size_t)(row - ML) * D; }
DI const float* xin_ptr(const Frame& F, int row) {
    if (F.l == 0) return row < ML ? pin(F, I_X) + (size_t)row * D : pin(F, I_CTX) + (size_t)(row - ML) * D;
    return xrow_ptr(F, row);
}

#define EPI_ROWS(ai, m) (128 * (ai) + 64 * wr + 16 * (m) + fr)
#define EPI_COL8(bj) (128 * (bj) + 32 * wc + 8 * fq)
#define FOR_AI_M _Pragma("unroll") for (int ai = 0; ai < 2; ++ai) _Pragma("unroll") for (int m = 0; m < 4; ++m)
#define ROW_FENCE asm volatile("" ::: "memory")

struct EpiG1 {
    const Frame& F;
    DI void operator()(Acc& acc, const Unit& u, int wr, int wc, int fr, int fq) const {
        unsigned char* ws = F.ws;
        if (u.job == 1) {
            bf16_t* base; int ld;
            if (u.pn < 64) { base = (bf16_t*)(ws + WS_TF) + (size_t)(u.pn >> 3) * 1024 * 2048 + (u.pn & 7) * 256; ld = 2048; }
            else { base = (bf16_t*)(ws + WS_TFC) + (size_t)(u.pn - 64) * 1024 * 256; ld = 256; }
            FOR_AI_M { const int r = u.pm * 256 + EPI_ROWS(ai, m);
#pragma unroll
                for (int bj = 0; bj < 2; ++bj) *(u32x4*)(base + (size_t)r * ld + EPI_COL8(bj)) = pk8(acc[ai][bj][m][0], acc[ai][bj][m][1]); }
            return;
        }
        const int row0 = u.pm * 256;
        if (u.pn <= 1) {
            bf16_t* dst = (bf16_t*)(ws + (u.pn == 0 ? WS_CKV : WS_CQ)); float* ss = (float*)(ws + (u.pn == 0 ? WS_SSKV : WS_SSQ));
            FOR_AI_M { const int r = row0 + EPI_ROWS(ai, m); float s = 0.f;
#pragma unroll
                for (int bj = 0; bj < 2; ++bj) { const f32x4 a = acc[ai][bj][m][0], b = acc[ai][bj][m][1];
                    s += (a[0] * a[0] + a[1] * a[1]) + (a[2] * a[2] + a[3] * a[3]) + (b[0] * b[0] + b[1] * b[1]) + (b[2] * b[2] + b[3] * b[3]);
                    *(u32x4*)(dst + (size_t)r * 256 + EPI_COL8(bj)) = pk8(a, b); }
                s += shx(s, 16, fr + 16 * fq); s += shx(s, 32, fr + 16 * fq);
                if (fq == 0) ss[(size_t)r * 4 + wc] = s; }
            return;
        }
        if (u.pn >= 5) {
            const int cb = (u.pn - 5) * 256; const float* bg = inl(F, I_BGATE, 3072) + cb; bf16_t* dst = (bf16_t*)(ws + WS_GATE) + cb;
            f32x4 bv[2][2];
#pragma unroll
            for (int bj = 0; bj < 2; ++bj) { bv[bj][0] = *(const f32x4*)(bg + EPI_COL8(bj)); bv[bj][1] = *(const f32x4*)(bg + EPI_COL8(bj) + 4); }
            FOR_AI_M { const int r = row0 + EPI_ROWS(ai, m);
#pragma unroll
                for (int bj = 0; bj < 2; ++bj) { f32x4 a = acc[ai][bj][m][0] + bv[bj][0], b = acc[ai][bj][m][1] + bv[bj][1];
#pragma unroll
                    for (int e = 0; e < 4; ++e) { a[e] = __builtin_amdgcn_rcpf(1.f + __builtin_amdgcn_exp2f(-1.4426950408889634f * a[e])); b[e] = __builtin_amdgcn_rcpf(1.f + __builtin_amdgcn_exp2f(-1.4426950408889634f * b[e])); }
                    *(u32x4*)(dst + (size_t)r * 3072 + EPI_COL8(bj)) = pk8(a, b); } }
            return;
        }
        const bool is_q = (u.pn >= 3);
        const bool is_v = (!is_q) && (wc >= 2);
        const float* gain = is_q ? inl(F, I_GQG, 64) : inl(F, I_GKG, 64);
        f32x4 gv[2][2];
#pragma unroll
        for (int bj = 0; bj < 2; ++bj) { gv[bj][0] = *(const f32x4*)(gain + 32 * bj + 8 * fq); gv[bj][1] = *(const f32x4*)(gain + 32 * bj + 8 * fq + 4); }
        bf16_t* dst; int ld, colb;
        if (is_q) { dst = (bf16_t*)(ws + WS_QG); ld = 512; colb = ((u.pn - 3) * 4 + wc) * 64; }
        else if (!is_v) { dst = (bf16_t*)(ws + WS_KG); ld = 128; colb = wc * 64; }
        else { dst = (bf16_t*)(ws + WS_VG); ld = 128; colb = (wc - 2) * 64; }
        const bool rope = (row0 < ML);
        const float* rg = (const float*)(ws + WS_ROPEG);
        const float qs = is_q ? QS_GQA : 1.f;
        FOR_AI_M { const int r = row0 + EPI_ROWS(ai, m);
            f32x4 x[2][2];
#pragma unroll
            for (int bj = 0; bj < 2; ++bj) { x[bj][0] = acc[ai][bj][m][0]; x[bj][1] = acc[ai][bj][m][1]; }
            if (!is_v) {
                float s = 0.f;
#pragma unroll
                for (int bj = 0; bj < 2; ++bj)
#pragma unroll
                    for (int n = 0; n < 2; ++n) s += (x[bj][n][0] * x[bj][n][0] + x[bj][n][1] * x[bj][n][1]) + (x[bj][n][2] * x[bj][n][2] + x[bj][n][3] * x[bj][n][3]);
                s += shx(s, 16, fr + 16 * fq); s += shx(s, 32, fr + 16 * fq);
                const float rstd = 1.f / sqrtf(s * (1.f / 64.f) + EPS);
#pragma unroll
                for (int bj = 0; bj < 2; ++bj)
#pragma unroll
                    for (int n = 0; n < 2; ++n) x[bj][n] = x[bj][n] * rstd * gv[bj][n];
                if (rope) {
                    const float* rr = rg + (size_t)(r & 2047) * 64 + 8 * fq;
#pragma unroll
                    for (int n = 0; n < 2; ++n) { const f32x4 cs = *(const f32x4*)(rr + 4 * n), sn = *(const f32x4*)(rr + 32 + 4 * n);
                        const f32x4 x1 = x[0][n], x2 = x[1][n]; x[0][n] = x1 * cs - x2 * sn; x[1][n] = x1 * sn + x2 * cs; }
                }
#pragma unroll
                for (int bj = 0; bj < 2; ++bj)
#pragma unroll
                    for (int n = 0; n < 2; ++n) x[bj][n] = x[bj][n] * qs;
            }
#pragma unroll
            for (int bj = 0; bj < 2; ++bj) *(u32x4*)(dst + (size_t)r * ld + colb + 32 * bj + 8 * fq) = pk8(x[bj][0], x[bj][1]);
            if (m & 1) ROW_FENCE;
        }
    }
};

struct EpiG2 {
    const Frame& F;
    DI void operator()(Acc& acc, const Unit& u, int wr, int wc, int fr, int fq) const {
        unsigned char* ws = F.ws; const int row0 = u.pm * 256;
        const float* ss = (const float*)(ws + (u.job == 0 ? WS_SSKV : WS_SSQ));
        bf16_t* dst; int ld; float sc = 1.f;
        if (u.job == 0) { dst = (bf16_t*)(ws + (u.pn < 2 ? WS_KN : WS_VM)) + (u.pn & 1) * 256; ld = 512; }
        else { dst = (bf16_t*)(ws + WS_QM); ld = 768; sc = QS_MLA; }
        const bool ropet = (u.job == 1 && u.pn == 2);
        const bool rope = ropet && row0 < ML;
        const float* rm = (const float*)(ws + WS_ROPEM) + 4 * fq;
        int colv[2];
#pragma unroll
        for (int bj = 0; bj < 2; ++bj) {
            if (u.job == 0) colv[bj] = EPI_COL8(bj);
            else if (!ropet) { const int c = u.pn * 256 + EPI_COL8(bj); colv[bj] = (c >> 6) * 96 + (c & 63); }
            else { const int c = EPI_COL8(bj); colv[bj] = (c >> 5) * 96 + 64 + (c & 31); }
        }
        FOR_AI_M { const int r = row0 + EPI_ROWS(ai, m);
            const f32x4 s4 = *(const f32x4*)(ss + (size_t)r * 4);
            const float rstd = sc * __builtin_amdgcn_rsqf(((s4[0] + s4[1]) + (s4[2] + s4[3])) * (1.f / 256.f) + EPS);
            f32x4 cs = {1.f, 1.f, 1.f, 1.f}, sn = {0.f, 0.f, 0.f, 0.f};
            if (rope) { const float* rr = rm + (size_t)(r & 2047) * 32; cs = *(const f32x4*)rr; sn = *(const f32x4*)(rr + 16); }
#pragma unroll
            for (int bj = 0; bj < 2; ++bj) {
                const f32x4 x1 = acc[ai][bj][m][0] * rstd, x2 = acc[ai][bj][m][1] * rstd;
                f32x4 a = x1, b = x2;
                if (ropet) { a = x1 * cs - x2 * sn; b = x1 * sn + x2 * cs; }
                *(u32x4*)(dst + (size_t)r * ld + colv[bj]) = pk8(a, b);
            }
            ROW_FENCE;
        }
    }
};

struct EpiDft {
    bf16_t* dst; int zrows, ld;
    DI void operator()(Acc& acc, const Unit& u, int wr, int wc, int fr, int fq) const {
        FOR_AI_M { const int r = u.z * zrows + u.pm * 256 + EPI_ROWS(ai, m);
#pragma unroll
            for (int bj = 0; bj < 2; ++bj) *(u32x4*)(dst + (size_t)r * ld + u.pn * 256 + EPI_COL8(bj)) = pk8(acc[ai][bj][m][0], acc[ai][bj][m][1]); }
    }
};

struct EpiG3 {
    const Frame& F;
    DI void operator()(Acc& acc, const Unit& u, int wr, int wc, int fr, int fq) const {
        const bf16_t* gate = (const bf16_t*)(F.ws + WS_GATE); bf16_t* Y = (bf16_t*)(F.ws + WS_HB);
        const int row0 = u.pm * 256, col0 = u.pn * 256;
        const int s1 = u.seg < 2 ? u.seg + 1 : u.seg;
#pragma unroll
        for (int aim = 0; aim < 4; ++aim) { const int ai = aim >> 1, mb = (aim & 1) * 2;
            u32x4 ga[4][2], gb[4][2];
#pragma unroll
            for (int m = mb; m < mb + 2; ++m)
#pragma unroll
                for (int bj = 0; bj < 2; ++bj) { const size_t o = (size_t)(row0 + EPI_ROWS(ai, m)) * 3072 + col0 + EPI_COL8(bj);
                    ga[m][bj] = *(const u32x4*)(gate + o + u.seg * 1024); if (u.seg < 2) gb[m][bj] = *(const u32x4*)(gate + o + s1 * 1024); }
#pragma unroll
            for (int m = mb; m < mb + 2; ++m) { const int r = row0 + EPI_ROWS(ai, m);
#pragma unroll
                for (int bj = 0; bj < 2; ++bj) {
                    float g0[8]; unpk8(ga[m][bj], g0);
                    if (u.seg < 2) { float g1[8]; unpk8(gb[m][bj], g1);
#pragma unroll
                        for (int e = 0; e < 8; ++e) g0[e] = g0[e] * __builtin_amdgcn_rcpf(fmaxf(g1[e], 1e-20f)); }
#pragma unroll
                    for (int e = 0; e < 4; ++e) { acc[ai][bj][m][0][e] *= g0[e]; acc[ai][bj][m][1][e] *= g0[4 + e]; }
                    if (u.seg == 2) *(u32x4*)(Y + (size_t)r * 1024 + col0 + EPI_COL8(bj)) = pk8(acc[ai][bj][m][0], acc[ai][bj][m][1]);
                }
            }
            ROW_FENCE;
        }
    }
};

struct EpiRes {
    const Frame& F; int which; bool from_input;
    int lnmode;
    DI void operator()(Acc& acc, const Unit& u, int wr, int wc, int fr, int fq) const {
        const int row0 = u.pm * 256, col0 = u.pn * 256;
        const float* g = modp(F, F.l, modrow_of_tile(row0), which) + col0;
        const bool ln = (lnmode != 0) && row0 < ML;
        const float* st = (const float*)(F.ws + (lnmode == 1 ? WS_ST1 : WS_ST2));
        const float* lg = lnmode == 1 ? pin(F, I_LN1G) + F.l * 1024 : pin(F, I_LN2G) + (F.l > 0 ? F.l - 1 : 0) * 1024;
        const float* lb = lnmode == 1 ? pin(F, I_LN1B) + F.l * 1024 : pin(F, I_LN2B) + (F.l > 0 ? F.l - 1 : 0) * 1024;
        {
#pragma unroll
            for (int bj = 0; bj < 2; ++bj) {
                f32x4 gv0 = *(const f32x4*)(g + EPI_COL8(bj)), gv1 = *(const f32x4*)(g + EPI_COL8(bj) + 4);
                f32x4 c0 = {0.f, 0.f, 0.f, 0.f}, c1 = {0.f, 0.f, 0.f, 0.f};
                if (ln) { c0 = *(const f32x4*)(lb + col0 + EPI_COL8(bj)) * ALPHA; c1 = *(const f32x4*)(lb + col0 + EPI_COL8(bj) + 4) * ALPHA; }
#pragma unroll
                for (int ai = 0; ai < 2; ++ai)
#pragma unroll
                    for (int m = 0; m < 4; ++m) { acc[ai][bj][m][0] = acc[ai][bj][m][0] * gv0 + c0; acc[ai][bj][m][1] = acc[ai][bj][m][1] * gv1 + c1; }
            }
        }
        f32x4 la[2][2];
#pragma unroll
        for (int bj = 0; bj < 2; ++bj) {
#pragma unroll
            for (int n = 0; n < 2; ++n) la[bj][n] = (f32x4){ALPHA, ALPHA, ALPHA, ALPHA};
            if (ln) {
#pragma unroll
                for (int n = 0; n < 2; ++n) la[bj][n] = *(const f32x4*)(lg + col0 + EPI_COL8(bj) + 4 * n) * ALPHA; } }
        const float* xib = (from_input ? xin_ptr(F, row0) : xrow_ptr(F, row0)) + col0; float* xob = xrow_ptr(F, row0) + col0;
        int oz_ = 0; asm volatile("" : "+v"(oz_));
#pragma unroll
        for (int aim = 0; aim < 8; ++aim) { const int ai = aim >> 2, m = aim & 3;
            f32x4 xa[2][2]; f32x2 sv = {0.f, 1.f};
            if (ln) sv = *(const f32x2*)(st + 2 * (size_t)(row0 + EPI_ROWS(ai, m) + oz_));
#pragma unroll
            for (int bj = 0; bj < 2; ++bj) { const float* p = xib + (size_t)(EPI_ROWS(ai, m) + oz_) * D + EPI_COL8(bj); xa[bj][0] = *(const f32x4*)p; xa[bj][1] = *(const f32x4*)(p + 4); }
#pragma unroll
            for (int bj = 0; bj < 2; ++bj) { float* p = xob + (size_t)(EPI_ROWS(ai, m) + oz_) * D + EPI_COL8(bj);
                *(f32x4*)p = ((xa[bj][0] - sv[0]) * sv[1]) * la[bj][0] + acc[ai][bj][m][0];
                *(f32x4*)(p + 4) = ((xa[bj][1] - sv[0]) * sv[1]) * la[bj][1] + acc[ai][bj][m][1]; }
            if (m & 1) ROW_FENCE;
        }
    }
};

struct EpiSlab {
    float* slab;
    DI void operator()(Acc& acc, const Unit& u, int wr, int wc, int fr, int fq) const {
        FOR_AI_M { const int r = u.z * MC + u.pm * 256 + EPI_ROWS(ai, m);
#pragma unroll
            for (int bj = 0; bj < 2; ++bj) { float* o = slab + (size_t)r * 1024 + u.pn * 256 + EPI_COL8(bj);
                *(f32x4*)o = acc[ai][bj][m][0]; *(f32x4*)(o + 4) = acc[ai][bj][m][1]; } }
    }
};

struct EpiW1 {
    const Frame& F;
    DI void operator()(Acc& acc, const Unit& u, int wr, int wc, int fr, int fq) const {
        bf16_t* U = (bf16_t*)(F.ws + WS_U);
        FOR_AI_M { const int r = u.pm * 256 + EPI_ROWS(ai, m);
#pragma unroll
            for (int bj = 0; bj < 2; ++bj) { f32x4 a = acc[ai][bj][m][0], b = acc[ai][bj][m][1];
#pragma unroll
                for (int e = 0; e < 4; ++e) { const float x = fmaxf(a[e], 0.f), y = fmaxf(b[e], 0.f); a[e] = x * x; b[e] = y * y; }
                *(u32x4*)(U + (size_t)r * DFF + u.pn * 256 + EPI_COL8(bj)) = pk8(a, b); } }
    }
};

#define MFMA32(a, b, c) __builtin_amdgcn_mfma_f32_32x32x16_bf16((a), (b), (c), 0, 0, 0)
constexpr int ATT_KBUF = 14336;
constexpr int ATT_KR = 9216, ATT_VB = 28672, ATT_VBUF = 8192, ATT_OST = 57344;
template <int KIND>
DI void attn_unit(const Frame& F, int qrow0, int head, int ctx_row0, int lat_row0, int ntiles) {
    constexpr int ND = KIND == 0 ? 6 : 4;
    unsigned char* ws = F.ws; LAS unsigned char* lds = F.lds;
    int tid_ = F.tid; asm volatile("" : "+v"(tid_));
    const int tid = tid_ & 511, lane = tid & 63, w = __builtin_amdgcn_readfirstlane(tid >> 6), r32 = lane & 31, h5 = lane >> 5;
    const bf16_t *Kp, *Vp, *Qp; bf16_t* Op; int ldk, ldq, ldo;
    if (KIND == 0) { Kp = (const bf16_t*)(ws + WS_KN) + head * 64; Vp = (const bf16_t*)(ws + WS_VM) + head * 64; ldk = 512; Qp = (const bf16_t*)(ws + WS_QM) + head * 96; ldq = 768;
                     Op = (bf16_t*)(ws + WS_AM) + head * 64; ldo = 512; }
    else { Kp = (const bf16_t*)(ws + WS_KG) + (head >> 2) * 64; Vp = (const bf16_t*)(ws + WS_VG) + (head >> 2) * 64; ldk = 128; Qp = (const bf16_t*)(ws + WS_QG) + head * 64; ldq = 512;
           Op = (bf16_t*)(ws + WS_QG) + head * 64; ldo = 512; }
    const bf16_t* Krp = (const bf16_t*)(ws + WS_KR);
    bf16x8 qf[ND];
    { const bf16_t* qr = Qp + (size_t)(qrow0 + 32 * w + r32) * ldq + 8 * h5;
#pragma unroll
      for (int ds = 0; ds < ND; ++ds) qf[ds] = *(const bf16x8*)(qr + 16 * ds); }
    const int skey = tid >> 3, sch = tid & 7;
    const int skey_r = (tid & 255) >> 2, sch_r = tid & 3;
    const unsigned kdst = skey * 144 + sch * 16;
    const unsigned vdst = (sch >> 2) * 4096 + skey * 64 + (sch & 3) * 16;
    const unsigned rdst = ATT_KR + skey_r * 80 + sch_r * 16;
    u32x4 kreg, vreg, rreg;
#define ATT_KEYROW(t) ((t) < 4 ? ctx_row0 + 64 * (t) : lat_row0 + 64 * ((t) - 4))
    const unsigned kbase = r32 * 144 + h5 * 16, rbase = ATT_KR + r32 * 80 + h5 * 16;
    const unsigned voff = (4 * h5 + ((lane & 15) >> 2)) * 64 + ((lane >> 4) & 1) * 32 + (lane & 3) * 8;
    float mref = 0.f, lsum = 0.f;
    f32x16 o0, o1;
#pragma unroll
    for (int i = 0; i < 16; ++i) { o0[i] = 0.f; o1[i] = 0.f; }
#define ATT_QK1(S, buf, kb, C) do { LAS unsigned char* kq_ = lds + (buf) * ATT_KBUF + (kb) * 32 * 144; LAS unsigned char* kr_ = lds + (buf) * ATT_KBUF + (kb) * 32 * 80; \
        bf16x8 kf_[ND]; \
        _Pragma("unroll") for (int ds = 0; ds < ND; ++ds) kf_[ds] = ds < 4 ? *(const LAS bf16x8*)(kq_ + kbase + ds * 32) : *(const LAS bf16x8*)(kr_ + rbase + (ds - 4) * 32); \
        _Pragma("unroll") for (int ds = 0; ds < ND; ++ds) { if (ds == 0) S = MFMA32(kf_[0], qf[0], C); else S = MFMA32(kf_[ds], qf[ds], S); } } while (0)
#define ATT_QKM(S0, S1, buf, C) do { ATT_QK1(S0, buf, 0, C); ATT_QK1(S1, buf, 1, C); } while (0)
#define ATT_VFRAG(dst, vb, kb) do { \
        _Pragma("unroll") for (int s = 0; s < 2; ++s) _Pragma("unroll") for (int db = 0; db < 2; ++db) { \
            const unsigned a_ = voff + db * 4096 + (32 * (kb) + 16 * s) * 64; \
            const s16x4 lo = __builtin_bit_cast(s16x4, __builtin_amdgcn_ds_read_tr16_b64_v4i16((LAS s16x4*)((vb) + a_))); \
            const s16x4 hi = __builtin_bit_cast(s16x4, __builtin_amdgcn_ds_read_tr16_b64_v4i16((LAS s16x4*)((vb) + a_ + 512))); \
            dst[s][db] = __builtin_shufflevector(lo, hi, 0, 1, 2, 3, 4, 5, 6, 7); } } while (0)
#define ATT_PV(PF, vb) do { \
        { bf16x8 va[2][2]; ATT_VFRAG(va, vb, 0); \
          _Pragma("unroll") for (int s = 0; s < 2; ++s) { o0 = MFMA32(va[s][0], PF[0][s], o0); o1 = MFMA32(va[s][1], PF[0][s], o1); } } \
        { bf16x8 vb2[2][2]; ATT_VFRAG(vb2, vb, 1); \
          _Pragma("unroll") for (int s = 0; s < 2; ++s) { o0 = MFMA32(vb2[s][0], PF[1][s], o0); o1 = MFMA32(vb2[s][1], PF[1][s], o1); } } } while (0)
    bf16x8 pfa[2][2], pfb[2][2];
    f32x16 s0, s1, n0, n1;
#define ATT_LOADK2(t, KR_, RR_) do { const int kr_ = ATT_KEYROW(t); KR_ = *(const u32x4*)(Kp + (size_t)(kr_ + skey) * ldk + sch * 8); \
        if (KIND == 0 && tid < 256) RR_ = *(const u32x4*)(Krp + (size_t)(kr_ + skey_r) * 32 + sch_r * 8); } while (0)
#define ATT_LOADV2(t, VR_) do { const int kr_ = ATT_KEYROW(t); VR_ = *(const u32x4*)(Vp + (size_t)(kr_ + skey) * ldk + sch * 8); } while (0)
#define ATT_STOREK2(buf, KR_, RR_) do { LAS unsigned char* b_ = lds + (buf) * ATT_KBUF; *(LAS u32x4*)(b_ + kdst) = KR_; if (KIND == 0 && tid < 256) *(LAS u32x4*)(b_ + rdst) = RR_; } while (0)
#define ATT_STOREV2(vsl, VR_) do { *(LAS u32x4*)(lds + ATT_VB + (vsl) + vdst) = VR_; } while (0)
#define ATT_BODY(t, KS, VS, RS, KL, VL, RL, C0, C1, N0, N1, PFN, PFP) do { \
        const bool more = (t + 1 < ntiles), more2 = (t + 2 < ntiles); \
        if (more2) ATT_LOADK2(t + 2, KS, RS); \
        if (more) ATT_LOADV2(t + 1, VS); \
        __builtin_amdgcn_iglp_opt(2); \
        if (more) { f32x16 ng_; _Pragma("unroll") for (int i = 0; i < 16; ++i) ng_[i] = -mref; ATT_QKM(N0, N1, (t + 1) & 1, ng_); } \
        if (t > 0) ATT_PV(PFP, lds + ATT_VB + (vs_c == 0 ? 2 * ATT_VBUF : vs_c - ATT_VBUF)); \
        float psa = 0.f, psb = 0.f; \
        _Pragma("unroll") for (int i = 0; i < 16; ++i) { C0[i] = __builtin_amdgcn_exp2f(C0[i]); C1[i] = __builtin_amdgcn_exp2f(C1[i]); psa += C0[i]; psb += C1[i]; } \
        psa += psb; \
        if (__builtin_expect(__any(psa > BIGP), 0)) { \
            float mx = fmaxf(C0[0], C1[0]); \
            _Pragma("unroll") for (int i = 1; i < 16; ++i) mx = fmaxf(mx, fmaxf(C0[i], C1[i])); \
            { auto rr = __builtin_amdgcn_permlane32_swap(__float_as_uint(mx), __float_as_uint(mx), false, false); mx = fmaxf(__uint_as_float(rr[0]), __uint_as_float(rr[1])); } \
            const float dl = mx > 1.f ? ceilf(__log2f(mx)) : 0.f; const float f = __builtin_amdgcn_exp2f(-dl); \
            mref += dl; lsum *= f; psa *= f; \
            _Pragma("unroll") for (int i = 0; i < 16; ++i) { C0[i] *= f; C1[i] *= f; o0[i] *= f; o1[i] *= f; N0[i] -= dl; N1[i] -= dl; } \
        } \
        lsum += psa; \
        _Pragma("unroll") for (int s = 0; s < 2; ++s) { \
            u32x4 a, b; \
            a.x = pk2(C0[8 * s + 0], C0[8 * s + 1]); a.y = pk2(C0[8 * s + 2], C0[8 * s + 3]); a.z = pk2(C0[8 * s + 4], C0[8 * s + 5]); a.w = pk2(C0[8 * s + 6], C0[8 * s + 7]); \
            b.x = pk2(C1[8 * s + 0], C1[8 * s + 1]); b.y = pk2(C1[8 * s + 2], C1[8 * s + 3]); b.z = pk2(C1[8 * s + 4], C1[8 * s + 5]); b.w = pk2(C1[8 * s + 6], C1[8 * s + 7]); \
            PFN[0][s] = __builtin_bit_cast(bf16x8, a); PFN[1][s] = __builtin_bit_cast(bf16x8, b); \
        } \
        __builtin_amdgcn_sched_barrier(0); \
        if (more2) ATT_STOREK2(t & 1, KS, RS); \
        if (more) ATT_STOREV2((vs_c == 2 * ATT_VBUF ? 0 : vs_c + ATT_VBUF), VS); \
        asm volatile("s_waitcnt lgkmcnt(0)\n\ts_barrier" ::: "memory"); \
        vs_c = (vs_c == 2 * ATT_VBUF ? 0 : vs_c + ATT_VBUF); \
    } while (0)
    constexpr float BIGP = 65536.f;
    int vs_c = 0;
    ATT_LOADK2(0, kreg, rreg); ATT_LOADV2(0, vreg);
    ATT_STOREK2(0, kreg, rreg); ATT_STOREV2(0, vreg);
    ATT_LOADK2(1, kreg, rreg); ATT_STOREK2(1, kreg, rreg);
    __syncthreads();
    { f32x16 z_; _Pragma("unroll") for (int i = 0; i < 16; ++i) z_[i] = 0.f; ATT_QKM(s0, s1, 0, z_); }
    {
        float mx = fmaxf(s0[0], s1[0]);
#pragma unroll
        for (int i = 1; i < 16; ++i) mx = fmaxf(mx, fmaxf(s0[i], s1[i]));
        { auto rr = __builtin_amdgcn_permlane32_swap(__float_as_uint(mx), __float_as_uint(mx), false, false); mx = fmaxf(__uint_as_float(rr[0]), __uint_as_float(rr[1])); }
        mref = mx;
#pragma unroll
        for (int i = 0; i < 16; ++i) { s0[i] -= mx; s1[i] -= mx; }
    }
    for (int t2 = 0; t2 < ntiles; t2 += 2) {
        { const int t = t2; ATT_BODY(t, kreg, vreg, rreg, kreg, vreg, rreg, s0, s1, n0, n1, pfa, pfb); }
        { const int t = t2 + 1; ATT_BODY(t, kreg, vreg, rreg, kreg, vreg, rreg, n0, n1, s0, s1, pfb, pfa); }
    }
    ATT_PV(pfb, lds + ATT_VB + (vs_c == 0 ? 2 * ATT_VBUF : vs_c - ATT_VBUF));
    { auto rr = __builtin_amdgcn_permlane32_swap(__float_as_uint(lsum), __float_as_uint(lsum), false, false); lsum = __uint_as_float(rr[0]) + __uint_as_float(rr[1]); }
    const float inv = 1.f / lsum;
    {
        LAS unsigned char* stg = lds + ATT_OST + w * 4608;
        LAS unsigned char* mine = stg + r32 * 144 + 8 * h5;
#pragma unroll
        for (int g = 0; g < 4; ++g) {
            u32x2 a, b;
            a.x = pk2(o0[4 * g] * inv, o0[4 * g + 1] * inv); a.y = pk2(o0[4 * g + 2] * inv, o0[4 * g + 3] * inv);
            b.x = pk2(o1[4 * g] * inv, o1[4 * g + 1] * inv); b.y = pk2(o1[4 * g + 2] * inv, o1[4 * g + 3] * inv);
            *(LAS u32x2*)(mine + 16 * g) = a; *(LAS u32x2*)(mine + 64 + 16 * g) = b;
        }
        asm volatile("s_waitcnt lgkmcnt(0)" ::: "memory");
        bf16_t* ob = Op + (size_t)(qrow0 + 32 * w) * ldo;
#pragma unroll
        for (int it = 0; it < 4; ++it) { const int row = it * 8 + (lane >> 3), ch = lane & 7;
            const u32x4 v = *(const LAS u32x4*)(stg + row * 144 + ch * 16);
            *(u32x4*)(ob + (size_t)row * ldo + ch * 8) = v; }
    }
    asm volatile("s_waitcnt lgkmcnt(0)\n\ts_barrier" ::: "memory");
#undef ATT_PV
#undef ATT_LOADK
#undef ATT_LOADV
#undef ATT_STOREK
#undef ATT_STOREV
#undef ATT_QK1
#undef ATT_BODY
#undef ATT_LOADK2
#undef ATT_LOADV2
#undef ATT_STOREK2
#undef ATT_STOREV2
#undef ATT_QKM
#undef ATT_VFRAG
#undef ATT_KEYROW
#undef ATT_LOAD
#undef ATT_STORE
}

DI void wave_sum2(float& a, float& b, int lane) {
#pragma unroll
    for (int o = 1; o < 64; o <<= 1) { const float ta = shx(a, o, lane), tb = shx(b, o, lane); a += ta; b += tb; }
}
DI void ln_row_v(const Frame& F, f32x4 (&v)[4], float* xout, const float* g, const float* b, const float* sh, const float* sc, bf16_t* hout, const float* slab, const float* gres, float* stat = nullptr) {
    if (slab) {
#pragma unroll
        for (int j = 0; j < 4; ++j) { f32x4 a = ((const f32x4*)slab)[F.lane + 64 * j];
#pragma unroll
            for (int z = 1; z < 8; ++z) a += ((const f32x4*)(slab + (size_t)z * MC * 1024))[F.lane + 64 * j];
            v[j] = v[j] * ALPHA + ((const f32x4*)gres)[F.lane + 64 * j] * a; }
    }
    if (g) {
        float s = 0.f, s2 = 0.f;
#pragma unroll
        for (int j = 0; j < 4; ++j) { s += (v[j][0] + v[j][1]) + (v[j][2] + v[j][3]); s2 += (v[j][0] * v[j][0] + v[j][1] * v[j][1]) + (v[j][2] * v[j][2] + v[j][3] * v[j][3]); }
        wave_sum2(s, s2, F.lane);
        const float mean = s * (1.f / D); const float rstd = 1.f / sqrtf(fmaxf(s2 * (1.f / D) - mean * mean, 0.f) + EPS);
        if (stat && F.lane == 0) { f32x2 sv = {mean, rstd}; *(f32x2*)stat = sv; }
#pragma unroll
        for (int j = 0; j < 4; ++j) { const f32x4 gg = ((const f32x4*)g)[F.lane + 64 * j], bb = ((const f32x4*)b)[F.lane + 64 * j];
            v[j] = (v[j] - mean) * rstd * gg + bb; if (xout) ((f32x4*)xout)[F.lane + 64 * j] = v[j]; }
    }
    if (hout) {
        float s = 0.f, s2 = 0.f;
#pragma unroll
        for (int j = 0; j < 4; ++j) { s += (v[j][0] + v[j][1]) + (v[j][2] + v[j][3]); s2 += (v[j][0] * v[j][0] + v[j][1] * v[j][1]) + (v[j][2] * v[j][2] + v[j][3] * v[j][3]); }
        wave_sum2(s, s2, F.lane);
        const float mean = s * (1.f / D); const float rstd = 1.f / sqrtf(fmaxf(s2 * (1.f / D) - mean * mean, 0.f) + EPS);
#pragma unroll
        for (int j = 0; j < 4; ++j) { const f32x4 hh = ((const f32x4*)sh)[F.lane + 64 * j], cc = ((const f32x4*)sc)[F.lane + 64 * j];
            const f32x4 o = (v[j] - mean) * rstd * (cc + 1.f) + hh; u32x2 wv; wv.x = pk2(o[0], o[1]); wv.y = pk2(o[2], o[3]);
            ((u32x2*)hout)[F.lane + 64 * j] = wv; }
    }
}
DI void ln_load(const Frame& F, const float* xin, f32x4 (&v)[4]) {
    const f32x4* xr = (const f32x4*)xin + F.lane;
#pragma unroll
    for (int j = 0; j < 4; ++j) v[j] = xr[64 * j];
}
DI void ln_row(const Frame& F, const float* xin, float* xout, const float* g, const float* b, const float* sh, const float* sc, bf16_t* hout, const float* slab = nullptr, const float* gres = nullptr) {
    f32x4 v[4]; ln_load(F, xin, v);
    ln_row_v(F, v, xout, g, b, sh, sc, hout, slab, gres);
}

DI int srcmap(int kind, int n) {
    switch (kind) {
    case 0: {
        if (n < 256) return n;
        if (n < 512) return 1056 + (n - 256);
        if (n < 768) { const int c = n - 512, slot = (c & 127) >> 5, d = 32 * (c >> 7) + (c & 31); return slot < 2 ? 288 + slot * 64 + d : 416 + (slot - 2) * 64 + d; }
        if (n < 1280) { const int t = (n - 768) >> 8, c = (n - 768) & 255, slot = (c & 127) >> 5, d = 32 * (c >> 7) + (c & 31); return 1312 + (4 * t + slot) * 64 + d; }
        return 1824 + (n - 1280); }
    case 1: { const int half = (n & 7) >> 2, i = 4 * (n >> 3) + (n & 3); return 256 + half * 16 + i; }
    case 2: {
        if (n < 512) return (n >> 6) * 96 + (n & 63);
        const int c = n - 512, hd = c >> 5, j = c & 31, half = (j & 7) >> 2, i = 4 * (j >> 3) + (j & 3); return hd * 96 + 64 + half * 16 + i; }
    default: return n;
    }
}
DI void conv_item(const float* W, int K, int ld, int kind, const float* gain, bf16_t* WT, int item, int nblk, LAS float* scr, int lane) {
    const int kb = item / nblk, nb = item % nblk, k0 = 64 * kb, n0 = 32 * nb;
    const int sc_ = srcmap(kind, n0 + (lane & 31));
    float wv[32];
#pragma unroll
    for (int i = 0; i < 32; ++i) wv[i] = W[(size_t)(k0 + 2 * i + (lane >> 5)) * ld + sc_];
    if (gain) {
#pragma unroll
        for (int i = 0; i < 32; ++i) wv[i] *= gain[k0 + 2 * i + (lane >> 5)];
    }
#pragma unroll
    for (int i = 0; i < 32; ++i) scr[(2 * i + (lane >> 5)) * 33 + (lane & 31)] = wv[i];
    asm volatile("s_waitcnt lgkmcnt(0)" ::: "memory");
    const int c = lane & 7;
#pragma unroll
    for (int j = 0; j < 4; ++j) { const int n = (lane >> 3) + 8 * j; const LAS float* s = scr + (8 * c) * 33 + n;
        u32x4 o; o.x = pk2(s[0 * 33], s[1 * 33]); o.y = pk2(s[2 * 33], s[3 * 33]); o.z = pk2(s[4 * 33], s[5 * 33]); o.w = pk2(s[6 * 33], s[7 * 33]);
        *(u32x4*)(WT + (size_t)(n0 + n) * K + k0 + 8 * c) = o; }
    asm volatile("s_waitcnt lgkmcnt(0)" ::: "memory");
}
template <int Q0, int Q1>
DI void convert_weights(const Frame& F, int l, int crank, int ncu) {
    LAS float* scr = (LAS float*)(F.lds + F.wave * 16384);
    unsigned char* W = F.ws + WS_W;
    const int gw = crank * 8 + F.wave, NGW = ncu * 8;
    const float* w_in = pin(F, I_WIN) + (size_t)l * D * INC;
    struct It { const float* src; int K, ld, kind, N; const float* gain; size_t dst; };
    const It its[11] = {
        {w_in, 1024, INC, 0, NIN, nullptr, W_IN},
        {w_in, 1024, INC, 1, 32, nullptr, W_KR},
        {pin(F, I_WUK) + (size_t)l * 256 * 512, 256, 512, 9, 512, pin(F, I_MKVG) + l * 256, W_UKV},
        {pin(F, I_WUV) + (size_t)l * 256 * 512, 256, 512, 9, 512, pin(F, I_MKVG) + l * 256, W_UKV + 512 * 256 * 2},
        {pin(F, I_WUQ) + (size_t)l * 256 * 768, 256, 768, 2, 768, pin(F, I_MQG) + l * 256, W_UQ},
        {pin(F, I_WFO) + (size_t)l * 512 * 1024, 512, 1024, 9, 1024, nullptr, W_FO},
        {pin(F, I_WMO) + (size_t)l * 512 * 1024, 512, 1024, 9, 1024, nullptr, W_MO},
        {pin(F, I_WGO) + (size_t)l * 512 * 1024, 512, 1024, 9, 1024, nullptr, W_GO},
        {pin(F, I_WO) + (size_t)l * 1024 * 1024, 1024, 1024, 9, 1024, nullptr, W_O},
        {pin(F, I_W1) + (size_t)l * 1024 * 4096, 1024, 4096, 9, 4096, nullptr, W_1},
        {pin(F, I_W2) + (size_t)l * 4096 * 1024, 4096, 1024, 9, 1024, nullptr, W_2}};
    int base = 0;
#pragma unroll
    for (int q = Q0; q < Q1; ++q) {
        const int nblk = its[q].N / 32, nit = (its[q].K / 64) * nblk;
        int first = (gw - base) % NGW; if (first < 0) first += NGW;
        for (int it = first; it < nit; it += NGW) conv_item(its[q].src, its[q].K, its[q].ld, its[q].kind, its[q].gain, (bf16_t*)(W + its[q].dst), it, nblk, scr, F.lane);
        base = (base + nit) % NGW;
    }
}
DI void fold_fourier(const Frame& F, int l, int crank, int ncu) {
    __syncthreads();
    LAS float* u = (LAS float*)F.lds;
    LAS float* T = (LAS float*)(F.lds + 32768);
    if (F.tid < 128) T[F.tid] = cospif((float)F.tid * (1.f / 64.f));
    const float* w_in = pin(F, I_WIN) + (size_t)l * D * INC;
    bf16_t* WT = (bf16_t*)(F.ws + WS_W + W_T);
    for (int item = crank; item < 256; item += ncu) {
        const int g = item >> 6, k0 = (item & 63) * 16;
        __syncthreads();
        for (int e = F.tid; e < 16 * 128; e += 512) { const int kk = e >> 7, c = e & 127; u[kk * 129 + c] = w_in[(size_t)(k0 + kk) * INC + 544 + g * 128 + c]; }
        __syncthreads();
        const int kk = F.tid & 15, grp = F.tid >> 4;
        float a[8];
#pragma unroll
        for (int o = 0; o < 8; ++o) a[o] = 0.f;
        for (int c = 0; c < 128; ++c) { const float uv = u[kk * 129 + c];
#pragma unroll
            for (int o = 0; o < 8; ++o) { const int mcs = grp * 8 + o, mm = mcs >> 1, cs = mcs & 1; a[o] += uv * T[(mm * c - 32 * cs) & 127]; } }
#pragma unroll
        for (int o = 0; o < 8; ++o) { const int mcs = grp * 8 + o; unsigned short hv = (unsigned short)(pk2(a[o], 0.f) & 0xffffu); WT[(size_t)(g * 256 + mcs) * 1024 + k0 + kk] = hv; }
    }
    __syncthreads();
}
DI void krope_phase(const Frame& F, int crank, int ncu) {
    const bf16_t* H = (const bf16_t*)(F.ws + WS_HB); const bf16_t* Wk = (const bf16_t*)(F.ws + WS_W + W_KR); bf16_t* KR = (bf16_t*)(F.ws + WS_KR);
    const float* rm = (const float*)(F.ws + WS_ROPEM);
    const int r32 = F.lane & 31, h5 = F.lane >> 5, w = F.wave;
    LAS float* part = (LAS float*)F.lds;
    for (int it = crank; it < MT / 32; it += ncu) {
        const int row0 = it * 32;
        f32x16 acc;
#pragma unroll
        for (int i = 0; i < 16; ++i) acc[i] = 0.f;
        const bf16_t* hp = H + (size_t)(row0 + r32) * 1024 + 8 * h5 + 128 * w; const bf16_t* wp = Wk + (size_t)r32 * 1024 + 8 * h5 + 128 * w;
        bf16x8 a[8], b[8];
#pragma unroll
        for (int q = 0; q < 8; ++q) { a[q] = *(const bf16x8*)(wp + 16 * q); b[q] = *(const bf16x8*)(hp + 16 * q); }
#pragma unroll
        for (int q = 0; q < 8; ++q) acc = MFMA32(a[q], b[q], acc);
        __syncthreads();
#pragma unroll
        for (int i = 0; i < 16; ++i) part[(w * 16 + i) * 64 + F.lane] = acc[i];
        __syncthreads();
        if (w == 0) {
#pragma unroll
            for (int i = 0; i < 16; ++i) { float sacc = 0.f;
#pragma unroll
                for (int q = 0; q < 8; ++q) sacc += part[(q * 16 + i) * 64 + F.lane];
                acc[i] = sacc; }
            const int row = row0 + r32;
            f32x16 oth;
#pragma unroll
            for (int i = 0; i < 16; ++i) oth[i] = shx(acc[i], 32, F.lane);
            u32x2 wv[4];
#pragma unroll
            for (int g = 0; g < 4; ++g) { float o[4];
#pragma unroll
                for (int e = 0; e < 4; ++e) { const int i = 4 * g + e; float x1 = h5 ? oth[i] : acc[i], x2 = h5 ? acc[i] : oth[i]; float cs = 1.f, sn = 0.f;
                    if (row < ML) { cs = rm[(size_t)(row & 2047) * 32 + i]; sn = rm[(size_t)(row & 2047) * 32 + 16 + i]; }
                    o[e] = h5 ? (x1 * sn + x2 * cs) : (x1 * cs - x2 * sn); }
                wv[g].x = pk2(o[0], o[1]); wv[g].y = pk2(o[2], o[3]); }
#pragma unroll
            for (int g = 0; g < 4; ++g) *(u32x2*)(KR + (size_t)row * 32 + 8 * g + 4 * h5) = wv[g];
        }
    }
    __syncthreads();
}

DI void prologue_a(const Frame& F) {
    unsigned char* ws = F.ws;
    convert_weights<0, 5>(F, 0, F.vcu, F.G);
    fold_fourier(F, 0, F.bid, F.G);
    { const int gt = F.bid * 512 + F.tid, NT = F.G * 512;
      float* rm = (float*)(ws + WS_ROPEM); float* rg = (float*)(ws + WS_ROPEG);
      for (int e = gt; e < 2048 * 16; e += NT) { const int pos = e >> 4, i = e & 15; const float fr_ = powf(10000.f, -(float)(i & 7) / 8.f); const float p_ = (i < 8) ? (float)(pos >> 6) : (float)(pos & 63);
          float sn, cs; sincosf(p_ * fr_, &sn, &cs); rm[pos * 32 + i] = cs; rm[pos * 32 + 16 + i] = sn; }
      for (int e = gt; e < 2048 * 32; e += NT) { const int pos = e >> 5, i = e & 31; const float fr_ = powf(10000.f, -(float)(i & 15) / 16.f); const float p_ = (i < 16) ? (float)(pos >> 6) : (float)(pos & 63);
          float sn, cs; sincosf(p_ * fr_, &sn, &cs); rg[pos * 64 + i] = cs; rg[pos * 64 + 32 + i] = sn; }
      bf16_t* dm = (bf16_t*)(ws + WS_DFTM);
      for (int e = gt; e < 2048 * 1024; e += NT) { const int k = e >> 10, j2 = (e & 1023) * 2; unsigned wv[2];
#pragma unroll
          for (int q = 0; q < 2; ++q) { const int j = j2 + q * 2048; float v0, v1; { const int jj = j & 2047; const float a0 = (float)((k * jj) & 2047) * (1.f / 1024.f), a1 = (float)((k * (jj + 1)) & 2047) * (1.f / 1024.f);
              if (j < 2048) { v0 = cospif(a0); v1 = cospif(a1); } else { v0 = -sinpif(a0); v1 = -sinpif(a1); } }
              wv[q] = pk2(v0 * (1.f / 512.f), v1 * (1.f / 512.f)); }
          *(unsigned*)(dm + (size_t)k * 4096 + j2) = wv[0]; *(unsigned*)(dm + (size_t)k * 4096 + 2048 + j2) = wv[1]; }
      bf16_t* dc = (bf16_t*)(ws + WS_DFTMC); const float sc = 0.005524271728019903f;
      for (int e = gt; e < 256 * 512; e += NT) { const int k = e >> 9, j = e & 511, jj = j & 255; const float a0 = (float)((k * jj) & 255) * (1.f / 128.f);
          const float v = (j < 256) ? cospif(a0) : -sinpif(a0); dc[e] = (unsigned short)(pk2(v * sc, 0.f) & 0xffffu); }
    }
    { __syncthreads();
      LAS float* sl = (LAS float*)F.lds;
      LAS float* red = (LAS float*)(F.lds + 36864);
      for (int e = F.tid; e < 9 * 1024; e += 512) { const int r = e >> 10, k = e & 1023; const float c = r < 8 ? pin(F, I_C)[r * 1024 + k] : pin(F, I_CCTX)[k]; sl[e] = c / (1.f + __expf(-c)); }
      __syncthreads();
      const int col = F.tid & 63, kg = F.tid >> 6;
      for (int item = F.bid; item < 4 * 96; item += F.G) {
          const int l = item / 96, cb = (item % 96) * 64;
          const float* wa = pin(F, I_WADA) + (size_t)l * 1024 * 6144 + cb + col;
          float a[9];
#pragma unroll
          for (int r = 0; r < 9; ++r) a[r] = 0.f;
          for (int k0 = kg * 128; k0 < kg * 128 + 128; k0 += 16) { float wv[16];
#pragma unroll
              for (int q = 0; q < 16; ++q) wv[q] = wa[(size_t)(k0 + q) * 6144];
#pragma unroll
              for (int q = 0; q < 16; ++q)
#pragma unroll
                  for (int r = 0; r < 9; ++r) a[r] += sl[r * 1024 + k0 + q] * wv[q]; }
#pragma unroll
          for (int r = 0; r < 9; ++r) red[(kg * 9 + r) * 64 + col] = a[r];
          __syncthreads();
          for (int e = F.tid; e < 9 * 64; e += 512) { const int r = e >> 6, c2 = e & 63; float s = pin(F, I_BADA)[l * 6144 + cb + c2];
#pragma unroll
              for (int q = 0; q < 8; ++q) s += red[(q * 9 + r) * 64 + c2];
              ((float*)(ws + WS_MOD))[(size_t)(l * 9 + r) * 6144 + cb + c2] = s; }
          __syncthreads();
      }
    }
}
DI void prologue_b(const Frame& F) {
    const int gw = F.vcu * 8 + F.wave, NGW = F.G * 8;
    bf16_t* H = (bf16_t*)(F.ws + WS_HB);
    for (int row = gw; row < MT; row += NGW) {
        const int mr = row < ML ? (row >> 11) : 8;
        const float* xi = row < ML ? pin(F, I_X) + (size_t)row * D : pin(F, I_CTX) + (size_t)(row - ML) * D;
        ln_row(F, xi, nullptr, nullptr, nullptr, modp(F, 0, mr, 0), modp(F, 0, mr, 1), H + (size_t)row * D);
    }
}
DI void ln_phase(const Frame& F, int which) {
    const int gw = F.vcu * 8 + F.wave, NGW = F.G * 8; const int l = F.l;
    const int nrows = (l == NL - 1) ? ML : MT;
    bf16_t* H = (bf16_t*)(F.ws + WS_HB);
    const float* g = pin(F, which == 0 ? I_LN1G : I_LN2G) + l * 1024; const float* b = pin(F, which == 0 ? I_LN1B : I_LN2B) + l * 1024;
    const bool wh = !(which == 1 && l == NL - 1);
    f32x4 vc[4], vn[4];
    if (gw < nrows) ln_load(F, xrow_ptr(F, gw), vc);
    for (int row = gw; row < nrows; row += NGW) {
        if (row + NGW < nrows) ln_load(F, xrow_ptr(F, row + NGW), vn);
        const int mr = row < ML ? (row >> 11) : 8;
        const float* sh = which == 0 ? modp(F, l, mr, 3) : modp(F, l + 1 < NL ? l + 1 : l, mr, 0);
        const float* sc = which == 0 ? modp(F, l, mr, 4) : modp(F, l + 1 < NL ? l + 1 : l, mr, 1);
        const bool sl = (which == 1 && row >= ML);
        const bool st_only = row < ML && !(which == 1 && l == NL - 1);
        float* stp = st_only ? (float*)(F.ws + (which == 0 ? WS_ST1 : WS_ST2)) + 2 * (size_t)row : nullptr;
        ln_row_v(F, vc, st_only ? nullptr : xrow_ptr(F, row), g, b, sh, sc, wh ? H + (size_t)row * D : nullptr, sl ? (const float*)(F.ws + WS_KN) + (size_t)(row - ML) * 1024 : nullptr, modp(F, l, mr, 5), stp);
#pragma unroll
        for (int j = 0; j < 4; ++j) vc[j] = vn[j];
    }
}

DI void phase_g1(const Frame& F) {
    const unsigned char* W = F.ws + WS_W; const char* H = (const char*)(F.ws + WS_HB);
    pg8::Sched2 S; S.tileBytes = 256L * 1024 * 2; S.G = F.G; S.c = F.bid;
    S.j0 = pg8::JobD{H, (const char*)(W + W_IN), MT / 256, NIN / 256, 1, 0, 0};
    S.j1 = pg8::JobD{(const char*)(W + W_T), H, 4, MT / 256, 1, 0, 0};
    S.n0 = (MT / 256) * (NIN / 256); S.total = S.n0 + 4 * (MT / 256);
    krope_phase(F, F.bid, F.G);
    EpiG1 E{F};
    pg8::gemm_phase(F.lds, 1024, S, E, F.tid);
}
DI void phase_g2(const Frame& F) {
    const unsigned char* W = F.ws + WS_W;
    pg8::Sched2 S; S.tileBytes = 256L * 256 * 2; S.G = F.G; S.c = F.bid;
    S.j0 = pg8::JobD{(const char*)(F.ws + WS_CKV), (const char*)(W + W_UKV), MT / 256, 4, 1, 0, 0};
    S.j1 = pg8::JobD{(const char*)(F.ws + WS_CQ), (const char*)(W + W_UQ), MT / 256, 3, 1, 0, 0};
    S.n0 = (MT / 256) * 4; S.total = S.n0 + (MT / 256) * 3;
    EpiG2 E{F};
    pg8::gemm_phase(F.lds, 256, S, E, F.tid);
}
DI void phase_att(const Frame& F) {
    const bool lastl = (F.l == NL - 1);
    const int nun = (!lastl && F.vcu < 128) ? 5 : 4;
#pragma unroll 1
    for (int i = 0; i < nun; ++i) {
        int kind, b, h, q0, nt;
        if (i < 4) { const int idx = (i >> 1) * 256 + F.vcu; kind = i & 1; b = idx >> 6; h = (idx >> 3) & 7; q0 = b * SEQ + (idx & 7) * 256; nt = 36; }
        else { const int idx = F.vcu >> 1; kind = F.vcu & 1; b = idx >> 3; h = idx & 7; q0 = ML + b * CTXL; nt = 4; }
        if (kind == 0) attn_unit<0>(F, q0, h, ML + b * CTXL, b * SEQ, nt);
        else attn_unit<1>(F, q0, h, ML + b * CTXL, b * SEQ, nt);
    }
    __syncthreads();
#ifndef NO_DFT
    {
        pg8::Sched2 S; S.tileBytes = 256L * 4096 * 2; S.G = F.G; S.c = (F.bid + 128) & 255;
        S.j0 = pg8::JobD{(const char*)(F.ws + WS_DFTM), (const char*)(F.ws + WS_TF), 8, 2, 8, 0, 1024L * 2048 * 2}; S.j1 = S.j0;
        S.n0 = 128; S.total = 128;
        EpiDft E{(bf16_t*)(F.ws + WS_F), 2048, 512};
        pg8::gemm_phase(F.lds, 4096, S, E, F.tid);
#ifdef PROBE_DFT
        pg8::gemm_phase(F.lds, 4096, S, E, F.tid);
#endif
    }
    if (!lastl) {
        pg8::Sched2 S; S.tileBytes = 256L * 512 * 2; S.G = F.G; S.c = F.bid;
        S.j0 = pg8::JobD{(const char*)(F.ws + WS_DFTMC), (const char*)(F.ws + WS_TFC), 1, 2, 8, 0, 1024L * 256 * 2}; S.j1 = S.j0;
        S.n0 = 16; S.total = 16;
        EpiDft E{(bf16_t*)(F.ws + WS_F) + (size_t)ML * 512, 256, 512};
        pg8::gemm_phase(F.lds, 512, S, E, F.tid);
    }
#endif
    if (F.bid < 128) {
        __syncthreads();
        const int cr = (F.bid & 7) * 16 + (F.bid >> 3);
        convert_weights<5, 11>(F, F.l, cr, 128);
    }
}
DI void phase_g3(const Frame& F) {
    const unsigned char* W = F.ws + WS_W; const int nM = (F.l == NL - 1 ? ML : MT) / 256;
    pg8::Sched3 S; S.tileBytes = 256L * 512 * 2; S.G = F.G; S.c = F.bid; S.ntiles = nM * 4;
    S.j = pg8::JobD{(const char*)(F.ws + WS_F), (const char*)(W + W_FO), nM, 4, 1, 0, 0};
    S.A1 = (const char*)(F.ws + WS_AM); S.B1 = (const char*)(W + W_MO); S.A2 = (const char*)(F.ws + WS_QG); S.B2 = (const char*)(W + W_GO);
    EpiG3 E{F};
    pg8::gemm_phase(F.lds, 512, S, E, F.tid);
    if (F.l + 1 < NL && F.bid >= 32) {
        __syncthreads();
        convert_weights<0, 5>(F, F.l + 1, F.bid - 32, F.G - 32); fold_fourier(F, F.l + 1, F.bid - 32, F.G - 32);
    }
}
DI void phase_g4(const Frame& F) {
    const unsigned char* W = F.ws + WS_W; const int nM = (F.l == NL - 1 ? ML : MT) / 256;
    pg8::Sched2 S; S.tileBytes = 256L * 1024 * 2; S.G = F.G; S.c = F.bid;
    S.j0 = pg8::JobD{(const char*)(F.ws + WS_HB), (const char*)(W + W_O), nM, 4, 1, 0, 0}; S.j1 = S.j0; S.n0 = nM * 4; S.total = S.n0;
    EpiRes E{F, 2, true, F.l > 0 ? 2 : 0};
    pg8::gemm_phase(F.lds, 1024, S, E, F.tid);
}
DI void phase_g5(const Frame& F) {
    const unsigned char* W = F.ws + WS_W; const int nM = (F.l == NL - 1 ? ML : MT) / 256;
    pg8::Sched2 S; S.tileBytes = 256L * 1024 * 2; S.G = F.G; S.c = F.bid;
    S.j0 = pg8::JobD{(const char*)(F.ws + WS_HB), (const char*)(W + W_1), nM, 16, 1, 0, 0}; S.j1 = S.j0; S.n0 = nM * 16; S.total = S.n0;
    EpiW1 E{F};
    pg8::gemm_phase(F.lds, 1024, S, E, F.tid);
#ifdef PROBE_G5
    pg8::gemm_phase(F.lds, 1024, S, E, F.tid);
#endif
}
DI void phase_g6(const Frame& F) {
    const unsigned char* W = F.ws + WS_W;
    {
        pg8::Sched2 S; S.tileBytes = 256L * 4096 * 2; S.G = F.G; S.c = F.bid;
        S.j0 = pg8::JobD{(const char*)(F.ws + WS_U), (const char*)(W + W_2), ML / 256, 4, 1, 0, 0}; S.j1 = S.j0; S.n0 = (ML / 256) * 4; S.total = S.n0;
        EpiRes E{F, 5, false, 1};
        pg8::gemm_phase(F.lds, 4096, S, E, F.tid);
    }
    if (F.l < NL - 1) {
        pg8::Sched2 S; S.tileBytes = 256L * 4096 * 2; S.G = F.G; S.c = F.bid;
        S.j0 = pg8::JobD{(const char*)(F.ws + WS_U) + (size_t)ML * 4096 * 2, (const char*)(W + W_2), MC / 256, 4, 8, 512 * 2, 512 * 2}; S.j1 = S.j0; S.n0 = (MC / 256) * 4 * 8; S.total = S.n0;
        EpiSlab E{(float*)(F.ws + WS_KN)};
        pg8::gemm_phase<4096>(F.lds, 512, S, E, F.tid);
    }
}

constexpr int N_PHASES = 2 + 9 * NL;
template <int ONLY>
__global__ void __launch_bounds__(512, 2) fwd_kernel(Params prm) {
    extern __shared__ __attribute__((aligned(16))) unsigned char lds_raw[];
    Frame F;
    F.P = &prm; F.ws = prm.ws; F.lds = (LAS unsigned char*)lds_raw;
    F.tid = threadIdx.x; F.lane = F.tid & 63; F.wave = __builtin_amdgcn_readfirstlane(F.tid >> 6);
    F.G = gridDim.x; F.bid = blockIdx.x; F.vcu = (F.G % 8 == 0) ? (F.bid % 8) * (F.G / 8) + F.bid / 8 : F.bid; F.l = 0;
    volatile LAS unsigned* MISC = (volatile LAS unsigned*)(F.lds + MISC_OFF);
    for (int u = F.tid; u < (LDS_BYTES - RING_BYTES) / 4; u += 512) ((LAS unsigned*)(F.lds + RING_BYTES))[u] = 0u;
    __syncthreads();
#if MK_ONE_LAUNCH
    const int lo = 0, hi = N_PHASES;
#else
    const int lo = prm.ph_lo, hi = prm.ph_hi;
#endif
    XcdBarrier bar; bar.bar = (unsigned*)(F.ws + WS_CTL) + 4096; bar.x = 0; bar.st = nullptr;
    if (hi - lo > 1) {
        bar = xcd_barrier_post((unsigned*)(F.ws + WS_CTL) + 4096, MISC + 8);
        cg::this_grid().sync();
        if (threadIdx.x == 0) { unsigned nloc, nx; xcd_barrier_complete(bar.bar, bar.x, nloc, nx); bar.st[0] = nloc; bar.st[1] = nx; }
        __syncthreads();
    }
    const int wave_s = __builtin_amdgcn_readfirstlane(threadIdx.x >> 6);
    for (int ph = lo; ph < hi; ++ph) {
        { int lane_; asm volatile("v_mbcnt_lo_u32_b32 %0, -1, 0\n\tv_mbcnt_hi_u32_b32 %0, -1, %0" : "=v"(lane_));
          int z_ = 0, b_ = blockIdx.x, g_ = gridDim.x, t_ = wave_s * 64 + lane_;
#if (OPQ_MASK & 1)
          asm volatile("" : "+s"(z_));
#endif
#if (OPQ_MASK & 2)
          asm volatile("" : "+s"(b_), "+s"(g_));
#endif
#if (OPQ_MASK & 4)
          asm volatile("" : "+v"(t_));
#endif
          F.ws = prm.ws + z_; F.zo = z_;
          b_ &= 1023; g_ &= 1023; F.bid = b_; F.G = g_; F.vcu = (g_ % 8 == 0) ? (b_ % 8) * (g_ / 8) + b_ / 8 : b_; F.tid = t_ & 511; F.lane = t_ & 63; F.wave = __builtin_amdgcn_readfirstlane((t_ & 511) >> 6); }
        if constexpr (ONLY >= 0) {
            F.l = ph < 2 ? 0 : (ph - 2) / 9;
            if constexpr (ONLY == 100) prologue_a(F);
            else if constexpr (ONLY == 101) prologue_b(F);
            else if constexpr (ONLY == 0) phase_g1(F);
            else if constexpr (ONLY == 1) phase_g2(F);
            else if constexpr (ONLY == 2) phase_att(F);
            else if constexpr (ONLY == 3) phase_g3(F);
            else if constexpr (ONLY == 4) phase_g4(F);
            else if constexpr (ONLY == 5) ln_phase(F, 0);
            else if constexpr (ONLY == 6) phase_g5(F);
            else if constexpr (ONLY == 7) phase_g6(F);
            else ln_phase(F, 1);
            continue;
        }
        if (ph == 0) prologue_a(F);
        else if (ph == 1) prologue_b(F);
        else {
            const int q = ph - 2; F.l = q / 9; const int sub = q - F.l * 9;
            switch (sub) {
            case 0: phase_g1(F); break;
            case 1: phase_g2(F); break;
            case 2: phase_att(F); break;
            case 3: phase_g3(F); break;
            case 4: phase_g4(F); break;
            case 5: ln_phase(F, 0); break;
            case 6: phase_g5(F); break;
            case 7: phase_g6(F); break;
            default: ln_phase(F, 1); break;
            }
        }
        if (ph + 1 < hi) { XcdBarrier b2; b2.bar = (unsigned*)(F.ws + WS_CTL) + 4096; b2.x = xb_xcc_id(); b2.st = (volatile LAS unsigned*)(F.lds + MISC_OFF) + 8; xcd_barrier(b2, F.tid); }
    }
}

extern "C" void kernel_launch(void* const* d_in, const int* in_sizes, int n_in, void* d_out, int out_size, void* d_ws, size_t ws_size, hipStream_t stream) {
    static int grid = 0;
    if (grid == 0) {
        if (n_in != 25 || out_size != ML * D || ws_size < WS_END) { fprintf(stderr, "kernel_launch: unexpected shapes (n_in %d out %d ws %zu)\n", n_in, out_size, ws_size); grid = -1; return; }
        int dev = 0, cus = 0, per_cu = 0;
        (void)hipGetDevice(&dev); (void)hipDeviceGetAttribute(&cus, hipDeviceAttributeMultiprocessorCount, dev);
#if MK_ONE_LAUNCH
        (void)hipFuncSetAttribute((const void*)fwd_kernel<-1>, hipFuncAttributeMaxDynamicSharedMemorySize, LDS_BYTES);
        (void)hipOccupancyMaxActiveBlocksPerMultiprocessor(&per_cu, (const void*)fwd_kernel<-1>, 512, LDS_BYTES);
#else
        (void)hipFuncSetAttribute((const void*)fwd_kernel<100>, hipFuncAttributeMaxDynamicSharedMemorySize, LDS_BYTES);
        (void)hipFuncSetAttribute((const void*)fwd_kernel<101>, hipFuncAttributeMaxDynamicSharedMemorySize, LDS_BYTES);
        (void)hipFuncSetAttribute((const void*)fwd_kernel<0>, hipFuncAttributeMaxDynamicSharedMemorySize, LDS_BYTES);
        (void)hipFuncSetAttribute((const void*)fwd_kernel<1>, hipFuncAttributeMaxDynamicSharedMemorySize, LDS_BYTES);
        (void)hipFuncSetAttribute((const void*)fwd_kernel<2>, hipFuncAttributeMaxDynamicSharedMemorySize, LDS_BYTES);
        (void)hipFuncSetAttribute((const void*)fwd_kernel<3>, hipFuncAttributeMaxDynamicSharedMemorySize, LDS_BYTES);
        (void)hipFuncSetAttribute((const void*)fwd_kernel<4>, hipFuncAttributeMaxDynamicSharedMemorySize, LDS_BYTES);
        (void)hipFuncSetAttribute((const void*)fwd_kernel<5>, hipFuncAttributeMaxDynamicSharedMemorySize, LDS_BYTES);
        (void)hipFuncSetAttribute((const void*)fwd_kernel<6>, hipFuncAttributeMaxDynamicSharedMemorySize, LDS_BYTES);
        (void)hipFuncSetAttribute((const void*)fwd_kernel<7>, hipFuncAttributeMaxDynamicSharedMemorySize, LDS_BYTES);
        (void)hipFuncSetAttribute((const void*)fwd_kernel<8>, hipFuncAttributeMaxDynamicSharedMemorySize, LDS_BYTES);
#endif
        (void)hipGetLastError();
        if (per_cu < 1) per_cu = 1;
        grid = cus;
        if (grid != 256) fprintf(stderr, "kernel_launch: grid %d (expected 256)\n", grid);
    }
    if (grid < 0) return;
    (void)hipMemsetAsync((char*)d_ws + WS_CTL, 0, CTL_BYTES, stream);
    Params p{};
    for (int i = 0; i < 25; ++i) p.in[i] = (const float*)d_in[i];
    p.out = (float*)d_out; p.ws = (unsigned char*)d_ws;
#if MK_ONE_LAUNCH
    p.ph_lo = 0; p.ph_hi = N_PHASES;
    void* args[] = {&p};
    hipError_t e = hipLaunchCooperativeKernel((const void*)fwd_kernel<-1>, dim3(grid), dim3(512), args, LDS_BYTES, stream);
    if (e != hipSuccess) fprintf(stderr, "cooperative launch failed: %s\n", hipGetErrorString(e));
#else
    for (int ph = 0; ph < N_PHASES; ++ph) {
        p.ph_lo = ph; p.ph_hi = ph + 1;
        const int sub = ph < 2 ? 100 + ph : (ph - 2) % 9;
        switch (sub) {
        case 100: hipLaunchKernelGGL(fwd_kernel<100>, dim3(grid), dim3(512), LDS_BYTES, stream, p); break;
        case 101: hipLaunchKernelGGL(fwd_kernel<101>, dim3(grid), dim3(512), LDS_BYTES, stream, p); break;
        case 0: hipLaunchKernelGGL(fwd_kernel<0>, dim3(grid), dim3(512), LDS_BYTES, stream, p); break;
        case 1: hipLaunchKernelGGL(fwd_kernel<1>, dim3(grid), dim3(512), LDS_BYTES, stream, p); break;
        case 2: hipLaunchKernelGGL(fwd_kernel<2>, dim3(grid), dim3(512), LDS_BYTES, stream, p); break;
        case 3: hipLaunchKernelGGL(fwd_kernel<3>, dim3(grid), dim3(512), LDS_BYTES, stream, p); break;
        case 4: hipLaunchKernelGGL(fwd_kernel<4>, dim3(grid), dim3(512), LDS_BYTES, stream, p); break;
        case 5: hipLaunchKernelGGL(fwd_kernel<5>, dim3(grid), dim3(512), LDS_BYTES, stream, p); break;
        case 6: hipLaunchKernelGGL(fwd_kernel<6>, dim3(grid), dim3(512), LDS_BYTES, stream, p); break;
        case 7: hipLaunchKernelGGL(fwd_kernel<7>, dim3(grid), dim3(512), LDS_BYTES, stream, p); break;
        default: hipLaunchKernelGGL(fwd_kernel<8>, dim3(grid), dim3(512), LDS_BYTES, stream, p); break;
        }
    }
#endif
}
```

```cpp
#include <hip/hip_runtime.h>
#include <hip/hip_cooperative_groups.h>
#include <cstdio>
#include <cstdint>
namespace cg = cooperative_groups;

#define LAS __attribute__((address_space(3)))
#define DI __device__ __forceinline__
typedef unsigned short bf16_t;
typedef short bf16x8 __attribute__((ext_vector_type(8)));
typedef short s16x4 __attribute__((ext_vector_type(4)));
typedef float f32x2 __attribute__((ext_vector_type(2)));
typedef float f32x4 __attribute__((ext_vector_type(4)));
typedef float f32x16 __attribute__((ext_vector_type(16)));
typedef unsigned u32x4 __attribute__((ext_vector_type(4)));
typedef unsigned u32x2 __attribute__((ext_vector_type(2)));
typedef __bf16 bf16x2_t __attribute__((ext_vector_type(2)));

#ifndef MK_ONE_LAUNCH
#define MK_ONE_LAUNCH 1
#endif
#ifndef OPQ_MASK
#if MK_ONE_LAUNCH
#define OPQ_MASK 7
#else
#define OPQ_MASK 0
#endif
#endif

constexpr int D = 1024, NB = 8, SEQ = 2048, CTXL = 256, NL = 4;
constexpr int ML = NB * SEQ, MC = NB * CTXL, MT = ML + MC;
constexpr int DFF = 4096, INC = 4896;
constexpr float EPS = 1e-6f;
constexpr float ALPHA = 1.6817928305074290f;
constexpr float QS_MLA = (float)(0.10206207261596575 * 1.4426950408889634);
constexpr float QS_GQA = (float)(0.125 * 1.4426950408889634);
constexpr int NIN = 4352;

constexpr size_t MiB = 1u << 20;
constexpr size_t WS_CTL = 0, CTL_BYTES = 65536;
constexpr size_t WS_MOD = 1 * MiB;
constexpr size_t WS_ROPEM = 2 * MiB;
constexpr size_t WS_ROPEG = 2 * MiB + 262144;
constexpr size_t WS_SSKV = 3 * MiB, WS_SSQ = 3 * MiB + 524288;
constexpr size_t WS_DFTMC = 4 * MiB;
constexpr size_t WS_ST1 = 4 * MiB + 524288, WS_ST2 = 4 * MiB + 786432;
constexpr size_t WS_DFTM = 5 * MiB;
constexpr size_t WS_W = 21 * MiB;
constexpr size_t W_IN = 0, W_KR = 8 * MiB + 524288, W_T = 9 * MiB, W_UKV = 11 * MiB, W_UQ = 11 * MiB + 524288, W_FO = 12 * MiB, W_MO = 13 * MiB,
                 W_GO = 14 * MiB, W_O = 15 * MiB, W_1 = 17 * MiB, W_2 = 25 * MiB;
constexpr size_t WS_XC = 54 * MiB;
constexpr size_t WS_HB = 62 * MiB;
constexpr size_t WS_CKV = 98 * MiB, WS_CQ = 107 * MiB, WS_KG = 116 * MiB, WS_VG = 120 * MiB + 524288, WS_QG = 125 * MiB, WS_KR = 143 * MiB;
constexpr size_t WS_KN = 145 * MiB, WS_VM = 163 * MiB, WS_QM = 181 * MiB;
constexpr size_t WS_F = 208 * MiB, WS_AM = 226 * MiB;
constexpr size_t WS_GATE = 244 * MiB, WS_TF = 352 * MiB, WS_TFC = 384 * MiB, WS_U = 244 * MiB;
constexpr size_t WS_END = 388 * MiB;

constexpr int LDS_BYTES = 147456, RING_BYTES = 131072, MISC_OFF = RING_BYTES + 320;

struct Params {
    const float* in[25];
    float* out;
    unsigned char* ws;
    int ph_lo, ph_hi;
};
enum { I_X = 0, I_C, I_CTX, I_CCTX, I_WADA, I_BADA, I_WIN, I_BGATE, I_MQG, I_MKVG, I_WUQ, I_WUK, I_WUV, I_GQG, I_GKG, I_WFO, I_WMO, I_WGO, I_WO,
       I_LN1G, I_LN1B, I_W1, I_W2, I_LN2G, I_LN2B };

DI unsigned pk2(float lo, float hi) { f32x2 v = {lo, hi}; bf16x2_t b = __builtin_convertvector(v, bf16x2_t); return __builtin_bit_cast(unsigned, b); }
DI u32x4 pk8(const f32x4& a, const f32x4& b) { u32x4 w; w.x = pk2(a[0], a[1]); w.y = pk2(a[2], a[3]); w.z = pk2(b[0], b[1]); w.w = pk2(b[2], b[3]); return w; }
DI float bf2f(unsigned short h) { return __uint_as_float((unsigned)h << 16); }
DI void unpk8(const u32x4& w, float* f) {
    f[0] = __uint_as_float(w.x << 16); f[1] = __uint_as_float(w.x & 0xffff0000u); f[2] = __uint_as_float(w.y << 16); f[3] = __uint_as_float(w.y & 0xffff0000u);
    f[4] = __uint_as_float(w.z << 16); f[5] = __uint_as_float(w.z & 0xffff0000u); f[6] = __uint_as_float(w.w << 16); f[7] = __uint_as_float(w.w & 0xffff0000u);
}
DI float shx(float v, int m, int lane) { return __int_as_float(__builtin_amdgcn_ds_bpermute((lane ^ m) << 2, __float_as_int(v))); }
DI float wave_sum(float v, int lane) {
#pragma unroll
    for (int o = 1; o < 64; o <<= 1) v += shx(v, o, lane);
    return v;
}

#define XB_TMO      128
#define XB_XCNT(j)  (256  + 64 * (j))
#define XB_XSUB(j)  (1280 + 64 * (j))
#define XB_XGEN(j)  (2304 + 64 * (j))
#define XB_TOP      3328
#define XB_TOPGEN   3392
#define XB_SPIN_CAP (1u << 22)
DI unsigned xb_ld(unsigned* p)              { return __hip_atomic_load(p, __ATOMIC_RELAXED, __HIP_MEMORY_SCOPE_AGENT); }
DI unsigned xb_add(unsigned* p, unsigned v) { return __hip_atomic_fetch_add(p, v, __ATOMIC_RELAXED, __HIP_MEMORY_SCOPE_AGENT); }
DI unsigned xb_xcc_id() { return (unsigned)__builtin_amdgcn_s_getreg((3 << 11) | 20) & 0xFu; }
#define XB_SPIN(cond, bar) do { unsigned _sp = 0; while (cond) { __builtin_amdgcn_s_sleep(1); \
    if ((++_sp & 255u) == 0u) { if (xb_ld(&(bar)[XB_TMO])) break; if (_sp > XB_SPIN_CAP) { atomicAdd(&(bar)[XB_TMO], 1u); break; } } } } while (0)
struct XcdBarrier { unsigned* bar; unsigned x; volatile LAS unsigned* st; };
DI XcdBarrier xcd_barrier_post(unsigned* bar, volatile LAS unsigned* st) {
    XcdBarrier b; b.bar = bar; b.x = xb_xcc_id(); b.st = st;
    if (threadIdx.x == 0) (void)xb_add(&bar[XB_XCNT(b.x)], 1u);
    return b;
}
DI void xcd_barrier_complete(unsigned* bar, unsigned x, unsigned& nloc, unsigned& nx) {
    const unsigned G = gridDim.x * gridDim.y * gridDim.z;
    unsigned sum, cnt, mine, sp = 0u;
    for (;;) {
        sum = 0u; cnt = 0u; mine = 0u;
#pragma unroll
        for (unsigned j = 0; j < 16; ++j) { const unsigned c = xb_ld(&bar[XB_XCNT(j)]); sum += c; cnt += (c > 0u) ? 1u : 0u; mine = (j == x) ? c : mine; }
        if (sum == G) break;
        __builtin_amdgcn_s_sleep(1);
        if ((++sp & 255u) == 0u) { if (xb_ld(&bar[XB_TMO])) break; if (sp > XB_SPIN_CAP) { atomicAdd(&bar[XB_TMO], 1u); break; } }
    }
    nloc = mine > 0u ? mine : 1u; nx = cnt > 0u ? cnt : 1u;
}
DI void xcd_barrier(const XcdBarrier& b, const int tid) {
    asm volatile("s_waitcnt vmcnt(0)" ::: "memory");
    __syncthreads();
    if (tid == 0) {
        unsigned* bar = b.bar;
        __builtin_amdgcn_s_waitcnt(0);
        unsigned nloc = b.st[0], nx = b.st[1];
        const unsigned old = xb_add(&bar[XB_XSUB(b.x)], 1u);
        const unsigned gen = old / nloc;
        if (old + 1u == (gen + 1u) * nloc) {
            __builtin_amdgcn_fence(__ATOMIC_RELEASE, "agent");
            asm volatile("s_waitcnt vmcnt(0)" ::: "memory");
            const unsigned og = xb_add(&bar[XB_TOP], 1u);
            const unsigned tg = og / nx;
            if (og + 1u == (tg + 1u) * nx) xb_add(&bar[XB_TOPGEN], 1u);
            else XB_SPIN(xb_ld(&bar[XB_TOPGEN]) == tg, bar);
            __builtin_amdgcn_fence(__ATOMIC_ACQUIRE, "agent");
            xb_add(&bar[XB_XGEN(b.x)], 1u);
            asm volatile("s_waitcnt vmcnt(0)" ::: "memory");
        } else {
            XB_SPIN(xb_ld(&bar[XB_XGEN(b.x)]) == gen, bar);
            __builtin_amdgcn_fence(__ATOMIC_ACQUIRE, "agent");
            asm volatile("s_waitcnt vmcnt(0)" ::: "memory");
        }
    }
    __syncthreads();
}

namespace pg8 {
constexpr int BM = 256, BK = 64, HALF = 128, HTB = HALF * BK * 2;
DI int lds_byte(int r, int c) { const int st = (r >> 4) * 2 + (c >> 5), rr = r & 15, cc = c & 31, ob = rr * 64 + cc * 2; return st * 1024 + (ob ^ (((ob >> 9) & 1) << 5)); }
DI void stage_rc(int b, int& R, int& C) { const int st = b / 1024, sb = b % 1024, swz = sb ^ (((sb >> 9) & 1) << 5); R = (st >> 1) * 16 + swz / 64; C = (st & 1) * 32 + (swz % 64) / 2; }
DI int perm32(int rho) { const int n = rho >> 4, i = rho & 15; return 8 * (i >> 2) + 4 * n + (i & 3); }

struct Unit { const char* A; const char* B; int job, pm, pn, z, seg; bool last; };
struct JobD { const char* A; const char* B; int nM, nN, nZ; long Az, Bz; };
DI void decode(const JobD& j, int t, long tileBytes, int jobid, Unit& u) {
    const int nMt = j.nM * j.nZ, nwg = nMt * j.nN;
    int wg; { const int q = nwg >> 3, r = nwg & 7, xcd = t & 7, off = t >> 3; wg = (xcd < r ? xcd * (q + 1) : r * (q + 1) + (xcd - r) * q) + off; }
    const int nig = 8 * j.nN, gid = wg / nig, fm = gid * 8, gsz = (nMt - fm) < 8 ? (nMt - fm) : 8;
    const int rem = wg - gid * nig, pn = rem / gsz, pmt = fm + (rem - pn * gsz);
    const int z = pmt / j.nM, pm = pmt - z * j.nM;
    u.A = j.A + (long)z * j.Az + (long)pm * tileBytes; u.B = j.B + (long)z * j.Bz + (long)pn * tileBytes;
    u.job = jobid; u.pm = pm; u.pn = pn; u.z = z; u.seg = 0; u.last = true;
}
struct Sched2 {
    JobD j0, j1; int n0, total, G, c; long tileBytes;
    DI bool next(int i, Unit& u) const {
        const long L = (long)i * G + c; if (L >= total) return false;
        if ((int)L < n0) decode(j0, (int)L, tileBytes, 0, u); else decode(j1, (int)L - n0, tileBytes, 1, u);
        return true;
    }
};
struct Sched3 {
    JobD j; const char* A1; const char* A2; const char* B1; const char* B2; int ntiles, G, c; long tileBytes;
    DI bool next(int i, Unit& u) const {
        const int ti = i / 3, seg = i - ti * 3; const long L = (long)ti * G + c; if (L >= ntiles) return false;
        decode(j, (int)L, tileBytes, 0, u);
        if (seg == 1) { u.A = A1 + (u.A - j.A); u.B = B1 + (u.B - j.B); }
        if (seg == 2) { u.A = A2 + (u.A - j.A); u.B = B2 + (u.B - j.B); }
        u.seg = seg; u.last = (seg == 2);
        return true;
    }
};

typedef f32x4 Acc[2][2][4][2];
template <int PITCH = 0, class Epi, class Sched>
DI void gemm_phase(LAS unsigned char* lds, const int K_, const Sched& S, const Epi& E, const int tid_in) {
    int Kq = K_; asm volatile("" : "+s"(Kq)); const int K = Kq & 0x1fc0;
    int tid_ = tid_in;
#ifndef NO_OPQ_TID
    asm volatile("" : "+v"(tid_));
#endif
    const int tid = tid_ & 511, wid = __builtin_amdgcn_readfirstlane(tid >> 6), lane = tid & 63, wr = wid >> 2, wc = wid & 3, fr = lane & 15, fq = lane >> 4;
    const int nt = K / BK;
    unsigned voffA[2], voffB[2];
#pragma unroll
    for (int i = 0; i < 2; ++i) { int R, C; stage_rc(tid * 16 + i * 8192, R, C); const int Rb = (R & ~31) + perm32(R & 31);
        voffA[i] = (unsigned)(R * (PITCH ? PITCH : K) + C) * 2u; voffB[i] = (unsigned)(Rb * (PITCH ? PITCH : K) + C) * 2u; }
    const size_t kstep = (size_t)(BK * 2);
    const size_t hstep = (size_t)HALF * (PITCH ? PITCH : K) * 2;
    const unsigned ldsw = (unsigned)wid * 1024u;
    const int aoff = lds_byte(wr * 64 + fr, fq * 8), boff = lds_byte(wc * 32 + fr, fq * 8);
#define PG8_SA(b, h) (((b) * 2 + (h)) * HTB)
#define PG8_SB(b, h) ((4 + (b) * 2 + (h)) * HTB)
#define PG8_STAGE(bufoff, gbase, voff) do { _Pragma("unroll") for (int _i = 0; _i < 2; ++_i) \
        __builtin_amdgcn_global_load_lds((const unsigned*)((const char*)(gbase) + (voff)[_i]), (LAS unsigned*)(lds + (bufoff) + ldsw + _i * 8192), 16, 0, 0); } while (0)
#define PG8_LDA(dst, b, h) do { _Pragma("unroll") for (int m = 0; m < 4; ++m) _Pragma("unroll") for (int k = 0; k < 2; ++k) dst[m][k] = *(const LAS bf16x8*)(lds + PG8_SA(b, h) + aoff + m * 2048 + k * 1024); } while (0)
#define PG8_LDB(dst, b, h) do { _Pragma("unroll") for (int n = 0; n < 2; ++n) _Pragma("unroll") for (int k = 0; k < 2; ++k) dst[n][k] = *(const LAS bf16x8*)(lds + PG8_SB(b, h) + boff + n * 2048 + k * 1024); } while (0)
#define PG8_MMA(ai, bj, At, Bt) do { __builtin_amdgcn_s_setprio(1); _Pragma("unroll") for (int m = 0; m < 4; ++m) _Pragma("unroll") for (int n = 0; n < 2; ++n) _Pragma("unroll") for (int k = 0; k < 2; ++k) \
        acc[ai][bj][m][n] = __builtin_amdgcn_mfma_f32_16x16x32_bf16(Bt[n][k], At[m][k], acc[ai][bj][m][n], 0, 0, 0); __builtin_amdgcn_s_setprio(0); } while (0)
#define PG8_WAIT_V(n) asm volatile("s_waitcnt vmcnt(" #n ")" ::: "memory")
#define PG8_WAIT_L(n) asm volatile("s_waitcnt lgkmcnt(" #n ")" ::: "memory")
#define PG8_BAR __builtin_amdgcn_s_barrier()
#define PG8_SCHED __builtin_amdgcn_sched_barrier(0)
    Unit cur, nxt; int ui = 0;
    if (!S.next(0, cur)) return;
    Acc acc;
#pragma unroll
    for (int a = 0; a < 2; ++a)
#pragma unroll
        for (int b = 0; b < 2; ++b)
#pragma unroll
            for (int m = 0; m < 4; ++m)
#pragma unroll
                for (int n = 0; n < 2; ++n) acc[a][b][m][n] = (f32x4){0.f, 0.f, 0.f, 0.f};
    bf16x8 At[4][2], B0[2][2], B1[2][2];
    const char* cA = cur.A; const char* cB = cur.B;
    PG8_STAGE(PG8_SB(0, 0), cB, voffB); PG8_STAGE(PG8_SB(0, 1), cB + hstep, voffB); PG8_STAGE(PG8_SA(0, 0), cA, voffA); PG8_STAGE(PG8_SA(0, 1), cA + hstep, voffA);
    if (wr == 1) PG8_BAR;
    PG8_WAIT_V(2); PG8_BAR;
    PG8_STAGE(PG8_SB(1, 0), cB + kstep, voffB); PG8_STAGE(PG8_SA(1, 0), cA + kstep, voffA); PG8_STAGE(PG8_SB(1, 1), cB + hstep + kstep, voffB);
    PG8_WAIT_V(6); PG8_BAR;
    for (;;) {
        const bool has_next = S.next(ui + 1, nxt);
        const char* nA = has_next ? nxt.A : cA; const char* nB = has_next ? nxt.B : cB;
        for (int t = 0; t < nt; t += 2) {
            const bool last = (t == nt - 2);
            const char* a1 = cA + (size_t)(t + 1) * kstep;
            const char* a2 = last ? nA : cA + (size_t)(t + 2) * kstep; const char* b2 = last ? nB : cB + (size_t)(t + 2) * kstep;
            const char* a3 = a2 + kstep; const char* b3 = b2 + kstep;
            PG8_LDB(B0, 0, 0); PG8_LDB(B1, 0, 1); PG8_SCHED; PG8_LDA(At, 0, 0); PG8_STAGE(PG8_SA(1, 1), a1 + hstep, voffA);
            PG8_WAIT_V(8); PG8_WAIT_L(0); PG8_BAR; PG8_MMA(0, 0, At, B0); PG8_MMA(0, 1, At, B1); PG8_BAR; PG8_SCHED;
            PG8_LDA(At, 0, 1); PG8_STAGE(PG8_SB(0, 0), b2, voffB); PG8_STAGE(PG8_SB(0, 1), b2 + hstep, voffB); PG8_STAGE(PG8_SA(0, 0), a2, voffA);
            PG8_WAIT_V(8); PG8_WAIT_L(0); PG8_BAR; PG8_MMA(1, 0, At, B0); PG8_MMA(1, 1, At, B1); PG8_BAR; PG8_SCHED;
            PG8_LDB(B0, 1, 0); PG8_LDB(B1, 1, 1); PG8_SCHED; PG8_LDA(At, 1, 0); PG8_STAGE(PG8_SA(0, 1), a2 + hstep, voffA);
            PG8_WAIT_V(8); PG8_WAIT_L(0); PG8_BAR; PG8_MMA(0, 0, At, B0); PG8_MMA(0, 1, At, B1); PG8_BAR; PG8_SCHED;
            PG8_LDA(At, 1, 1); PG8_STAGE(PG8_SB(1, 0), b3, voffB); PG8_STAGE(PG8_SB(1, 1), b3 + hstep, voffB); PG8_STAGE(PG8_SA(1, 0), a3, voffA);
            PG8_WAIT_V(8); PG8_WAIT_L(0); PG8_BAR; PG8_MMA(1, 0, At, B0); PG8_MMA(1, 1, At, B1); PG8_BAR; PG8_SCHED;
        }
        if (wr == 0) PG8_BAR;
        E(acc, cur, wr, wc, fr, fq);
        if (!has_next) break;
        if (cur.last) {
#pragma unroll
            for (int a = 0; a < 2; ++a)
#pragma unroll
                for (int b = 0; b < 2; ++b)
#pragma unroll
                    for (int m = 0; m < 4; ++m)
#pragma unroll
                        for (int n = 0; n < 2; ++n) acc[a][b][m][n] = (f32x4){0.f, 0.f, 0.f, 0.f};
        }
        cur = nxt; cA = nA; cB = nB; ++ui;
        if (wr == 1) PG8_BAR;
    }
    PG8_WAIT_V(0);
    PG8_BAR;
#undef PG8_SA
#undef PG8_SB
#undef PG8_STAGE
#undef PG8_LDA
#undef PG8_LDB
#undef PG8_MMA
#undef PG8_WAIT_V
#undef PG8_WAIT_L
#undef PG8_BAR
#undef PG8_SCHED
}
}
using pg8::Acc; using pg8::Unit;

struct Frame {
    const Params* P;
    unsigned char* ws;
    LAS unsigned char* lds;
    int tid, lane, wave, G, bid, vcu;
    int l;
    int zo;
};
DI const float* pin(const Frame& F, int idx) { return F.P->in[idx + F.zo]; }
DI const float* inl(const Frame& F, int idx, size_t per_layer) { return pin(F, idx) + (size_t)F.l * per_layer; }
DI const float* modp(const Frame& F, int l, int mr, int which) { return (const float*)(F.ws + WS_MOD) + ((size_t)(l * 9 + mr) * 6 + which) * 1024; }
DI int modrow_of_tile(int row0) { return row0 < ML ? (row0 >> 11) : 8; }
DI float* xrow_ptr(const Frame& F, int row) { return row < ML ? F.P->out + (size_t)row * D : (float*)(F.ws + WS_XC) + (size_t)(row - ML) * D; }
DI const float* xin_ptr(const Frame& F, int row) {
    if (F.l == 0) return row < ML ? pin(F, I_X) + (size_t)row * D : pin(F, I_CTX) + (size_t)(row - ML) * D;
    return xrow_ptr(F, row);
}

#define EPI_ROWS(ai, m) (128 * (ai) + 64 * wr + 16 * (m) + fr)
#define EPI_COL8(bj) (128 * (bj) + 32 * wc + 8 * fq)
#define FOR_AI_M _Pragma("unroll") for (int ai = 0; ai < 2; ++ai) _Pragma("unroll") for (int m = 0; m < 4; ++m)
#define ROW_FENCE asm volatile("" ::: "memory")

struct EpiG1 {
    const Frame& F;
    DI void operator()(Acc& acc, const Unit& u, int wr, int wc, int fr, int fq) const {
        unsigned char* ws = F.ws;
        if (u.job == 1) {
            bf16_t* base; int ld;
            if (u.pn < 64) { base = (bf16_t*)(ws + WS_TF) + (size_t)(u.pn >> 3) * 1024 * 2048 + (u.pn & 7) * 256; ld = 2048; }
            else { base = (bf16_t*)(ws + WS_TFC) + (size_t)(u.pn - 64) * 1024 * 256; ld = 256; }
            FOR_AI_M { const int r = u.pm * 256 + EPI_ROWS(ai, m);
#pragma unroll
                for (int bj = 0; bj < 2; ++bj) *(u32x4*)(base + (size_t)r * ld + EPI_COL8(bj)) = pk8(acc[ai][bj][m][0], acc[ai][bj][m][1]); }
            return;
        }
        const int row0 = u.pm * 256;
        if (u.pn <= 1) {
            bf16_t* dst = (bf16_t*)(ws + (u.pn == 0 ? WS_CKV : WS_CQ)); float* ss = (float*)(ws + (u.pn == 0 ? WS_SSKV : WS_SSQ));
            FOR_AI_M { const int r = row0 + EPI_ROWS(ai, m); float s = 0.f;
#pragma unroll
                for (int bj = 0; bj < 2; ++bj) { const f32x4 a = acc[ai][bj][m][0], b = acc[ai][bj][m][1];
                    s += (a[0] * a[0] + a[1] * a[1]) + (a[2] * a[2] + a[3] * a[3]) + (b[0] * b[0] + b[1] * b[1]) + (b[2] * b[2] + b[3] * b[3]);
                    *(u32x4*)(dst + (size_t)r * 256 + EPI_COL8(bj)) = pk8(a, b); }
                s += shx(s, 16, fr + 16 * fq); s += shx(s, 32, fr + 16 * fq);
                if (fq == 0) ss[(size_t)r * 4 + wc] = s; }
            return;
        }
        if (u.pn >= 5) {
            const int cb = (u.pn - 5) * 256; const float* bg = inl(F, I_BGATE, 3072) + cb; bf16_t* dst = (bf16_t*)(ws + WS_GATE) + cb;
            f32x4 bv[2][2];
#pragma unroll
            for (int bj = 0; bj < 2; ++bj) { bv[bj][0] = *(const f32x4*)(bg + EPI_COL8(bj)); bv[bj][1] = *(const f32x4*)(bg + EPI_COL8(bj) + 4); }
            FOR_AI_M { const int r = row0 + EPI_ROWS(ai, m);
#pragma unroll
                for (int bj = 0; bj < 2; ++bj) { f32x4 a = acc[ai][bj][m][0] + bv[bj][0], b = acc[ai][bj][m][1] + bv[bj][1];
#pragma unroll
                    for (int e = 0; e < 4; ++e) { a[e] = __builtin_amdgcn_rcpf(1.f + __builtin_amdgcn_exp2f(-1.4426950408889634f * a[e])); b[e] = __builtin_amdgcn_rcpf(1.f + __builtin_amdgcn_exp2f(-1.4426950408889634f * b[e])); }
                    *(u32x4*)(dst + (size_t)r * 3072 + EPI_COL8(bj)) = pk8(a, b); } }
            return;
        }
        const bool is_q = (u.pn >= 3);
        const bool is_v = (!is_q) && (wc >= 2);
        const float* gain = is_q ? inl(F, I_GQG, 64) : inl(F, I_GKG, 64);
        f32x4 gv[2][2];
#pragma unroll
        for (int bj = 0; bj < 2; ++bj) { gv[bj][0] = *(const f32x4*)(gain + 32 * bj + 8 * fq); gv[bj][1] = *(const f32x4*)(gain + 32 * bj + 8 * fq + 4); }
        bf16_t* dst; int ld, colb;
        if (is_q) { dst = (bf16_t*)(ws + WS_QG); ld = 512; colb = ((u.pn - 3) * 4 + wc) * 64; }
        else if (!is_v) { dst = (bf16_t*)(ws + WS_KG); ld = 128; colb = wc * 64; }
        else { dst = (bf16_t*)(ws + WS_VG); ld = 128; colb = (wc - 2) * 64; }
        const bool rope = (row0 < ML);
        const float* rg = (const float*)(ws + WS_ROPEG);
        const float qs = is_q ? QS_GQA : 1.f;
        FOR_AI_M { const int r = row0 + EPI_ROWS(ai, m);
            f32x4 x[2][2];
#pragma unroll
            for (int bj = 0; bj < 2; ++bj) { x[bj][0] = acc[ai][bj][m][0]; x[bj][1] = acc[ai][bj][m][1]; }
            if (!is_v) {
                float s = 0.f;
#pragma unroll
                for (int bj = 0; bj < 2; ++bj)
#pragma unroll
                    for (int n = 0; n < 2; ++n) s += (x[bj][n][0] * x[bj][n][0] + x[bj][n][1] * x[bj][n][1]) + (x[bj][n][2] * x[bj][n][2] + x[bj][n][3] * x[bj][n][3]);
                s += shx(s, 16, fr + 16 * fq); s += shx(s, 32, fr + 16 * fq);
                const float rstd = 1.f / sqrtf(s * (1.f / 64.f) + EPS);
#pragma unroll
                for (int bj = 0; bj < 2; ++bj)
#pragma unroll
                    for (int n = 0; n < 2; ++n) x[bj][n] = x[bj][n] * rstd * gv[bj][n];
                if (rope) {
                    const float* rr = rg + (size_t)(r & 2047) * 64 + 8 * fq;
#pragma unroll
                    for (int n = 0; n < 2; ++n) { const f32x4 cs = *(const f32x4*)(rr + 4 * n), sn = *(const f32x4*)(rr + 32 + 4 * n);
                        const f32x4 x1 = x[0][n], x2 = x[1][n]; x[0][n] = x1 * cs - x2 * sn; x[1][n] = x1 * sn + x2 * cs; }
                }
#pragma unroll
                for (int bj = 0; bj < 2; ++bj)
#pragma unroll
                    for (int n = 0; n < 2; ++n) x[bj][n] = x[bj][n] * qs;
            }
#pragma unroll
            for (int bj = 0; bj < 2; ++bj) *(u32x4*)(dst + (size_t)r * ld + colb + 32 * bj + 8 * fq) = pk8(x[bj][0], x[bj][1]);
            if (m & 1) ROW_FENCE;
        }
    }
};

struct EpiG2 {
    const Frame& F;
    DI void operator()(Acc& acc, const Unit& u, int wr, int wc, int fr, int fq) const {
        unsigned char* ws = F.ws; const int row0 = u.pm * 256;
        const float* ss = (const float*)(ws + (u.job == 0 ? WS_SSKV : WS_SSQ));
        bf16_t* dst; int ld; float sc = 1.f;
        if (u.job == 0) { dst = (bf16_t*)(ws + (u.pn < 2 ? WS_KN : WS_VM)) + (u.pn & 1) * 256; ld = 512; }
        else { dst = (bf16_t*)(ws + WS_QM); ld = 768; sc = QS_MLA; }
        const bool ropet = (u.job == 1 && u.pn == 2);
        const bool rope = ropet && row0 < ML;
        const float* rm = (const float*)(ws + WS_ROPEM) + 4 * fq;
        int colv[2];
#pragma unroll
        for (int bj = 0; bj < 2; ++bj) {
            if (u.job == 0) colv[bj] = EPI_COL8(bj);
            else if (!ropet) { const int c = u.pn * 256 + EPI_COL8(bj); colv[bj] = (c >> 6) * 96 + (c & 63); }
            else { const int c = EPI_COL8(bj); colv[bj] = (c >> 5) * 96 + 64 + (c & 31); }
        }
        FOR_AI_M { const int r = row0 + EPI_ROWS(ai, m);
            const f32x4 s4 = *(const f32x4*)(ss + (size_t)r * 4);
            const float rstd = sc * __builtin_amdgcn_rsqf(((s4[0] + s4[1]) + (s4[2] + s4[3])) * (1.f / 256.f) + EPS);
            f32x4 cs = {1.f, 1.f, 1.f, 1.f}, sn = {0.f, 0.f, 0.f, 0.f};
            if (rope) { const float* rr = rm + (size_t)(r & 2047) * 32; cs = *(const f32x4*)rr; sn = *(const f32x4*)(rr + 16); }
#pragma unroll
            for (int bj = 0; bj < 2; ++bj) {
                const f32x4 x1 = acc[ai][bj][m][0] * rstd, x2 = acc[ai][bj][m][1] * rstd;
                f32x4 a = x1, b = x2;
                if (ropet) { a = x1 * cs - x2 * sn; b = x1 * sn + x2 * cs; }
                *(u32x4*)(dst + (size_t)r * ld + colv[bj]) = pk8(a, b);
            }
            ROW_FENCE;
        }
    }
};

struct EpiDft {
    bf16_t* dst; int zrows, ld;
    DI void operator()(Acc& acc, const Unit& u, int wr, int wc, int fr, int fq) const {
        FOR_AI_M { const int r = u.z * zrows + u.pm * 256 + EPI_ROWS(ai, m);
#pragma unroll
            for (int bj = 0; bj < 2; ++bj) *(u32x4*)(dst + (size_t)r * ld + u.pn * 256 + EPI_COL8(bj)) = pk8(acc[ai][bj][m][0], acc[ai][bj][m][1]); }
    }
};

struct EpiG3 {
    const Frame& F;
    DI void operator()(Acc& acc, const Unit& u, int wr, int wc, int fr, int fq) const {
        const bf16_t* gate = (const bf16_t*)(F.ws + WS_GATE); bf16_t* Y = (bf16_t*)(F.ws + WS_HB);
        const int row0 = u.pm * 256, col0 = u.pn * 256;
        const int s1 = u.seg < 2 ? u.seg + 1 : u.seg;
#pragma unroll
        for (int aim = 0; aim < 4; ++aim) { const int ai = aim >> 1, mb = (aim & 1) * 2;
            u32x4 ga[4][2], gb[4][2];
#pragma unroll
            for (int m = mb; m < mb + 2; ++m)
#pragma unroll
                for (int bj = 0; bj < 2; ++bj) { const size_t o = (size_t)(row0 + EPI_ROWS(ai, m)) * 3072 + col0 + EPI_COL8(bj);
                    ga[m][bj] = *(const u32x4*)(gate + o + u.seg * 1024); if (u.seg < 2) gb[m][bj] = *(const u32x4*)(gate + o + s1 * 1024); }
#pragma unroll
            for (int m = mb; m < mb + 2; ++m) { const int r = row0 + EPI_ROWS(ai, m);
#pragma unroll
                for (int bj = 0; bj < 2; ++bj) {
                    float g0[8]; unpk8(ga[m][bj], g0);
                    if (u.seg < 2) { float g1[8]; unpk8(gb[m][bj], g1);
#pragma unroll
                        for (int e = 0; e < 8; ++e) g0[e] = g0[e] * __builtin_amdgcn_rcpf(fmaxf(g1[e], 1e-20f)); }
#pragma unroll
                    for (int e = 0; e < 4; ++e) { acc[ai][bj][m][0][e] *= g0[e]; acc[ai][bj][m][1][e] *= g0[4 + e]; }
                    if (u.seg == 2) *(u32x4*)(Y + (size_t)r * 1024 + col0 + EPI_COL8(bj)) = pk8(acc[ai][bj][m][0], acc[ai][bj][m][1]);
                }
            }
            ROW_FENCE;
        }
    }
};

struct EpiRes {
    const Frame& F; int which; bool from_input;
    int lnmode;
    DI void operator()(Acc& acc, const Unit& u, int wr, int wc, int fr, int fq) const {
        const int row0 = u.pm * 256, col0 = u.pn * 256;
        const float* g = modp(F, F.l, modrow_of_tile(row0), which) + col0;
        const bool ln = (lnmode != 0) && row0 < ML;
        const float* st = (const float*)(F.ws + (lnmode == 1 ? WS_ST1 : WS_ST2));
        const float* lg = lnmode == 1 ? pin(F, I_LN1G) + F.l * 1024 : pin(F, I_LN2G) + (F.l > 0 ? F.l - 1 : 0) * 1024;
        const float* lb = lnmode == 1 ? pin(F, I_LN1B) + F.l * 1024 : pin(F, I_LN2B) + (F.l > 0 ? F.l - 1 : 0) * 1024;
        {
#pragma unroll
            for (int bj = 0; bj < 2; ++bj) {
                f32x4 gv0 = *(const f32x4*)(g + EPI_COL8(bj)), gv1 = *(const f32x4*)(g + EPI_COL8(bj) + 4);
                f32x4 c0 = {0.f, 0.f, 0.f, 0.f}, c1 = {0.f, 0.f, 0.f, 0.f};
                if (ln) { c0 = *(const f32x4*)(lb + col0 + EPI_COL8(bj)) * ALPHA; c1 = *(const f32x4*)(lb + col0 + EPI_COL8(bj) + 4) * ALPHA; }
#pragma unroll
                for (int ai = 0; ai < 2; ++ai)
#pragma unroll
                    for (int m = 0; m < 4; ++m) { acc[ai][bj][m][0] = acc[ai][bj][m][0] * gv0 + c0; acc[ai][bj][m][1] = acc[ai][bj][m][1] * gv1 + c1; }
            }
        }
        f32x4 la[2][2];
#pragma unroll
        for (int bj = 0; bj < 2; ++bj) {
#pragma unroll
            for (int n = 0; n < 2; ++n) la[bj][n] = (f32x4){ALPHA, ALPHA, ALPHA, ALPHA};
            if (ln) {
#pragma unroll
                for (int n = 0; n < 2; ++n) la[bj][n] = *(const f32x4*)(lg + col0 + EPI_COL8(bj) + 4 * n) * ALPHA; } }
        const float* xib = (from_input ? xin_ptr(F, row0) : xrow_ptr(F, row0)) + col0; float* xob = xrow_ptr(F, row0) + col0;
        int oz_ = 0; asm volatile("" : "+v"(oz_));
#pragma unroll
        for (int aim = 0; aim < 8; ++aim) { const int ai = aim >> 2, m = aim & 3;
            f32x4 xa[2][2]; f32x2 sv = {0.f, 1.f};
            if (ln) sv = *(const f32x2*)(st + 2 * (size_t)(row0 + EPI_ROWS(ai, m) + oz_));
#pragma unroll
            for (int bj = 0; bj < 2; ++bj) { const float* p = xib + (size_t)(EPI_ROWS(ai, m) + oz_) * D + EPI_COL8(bj); xa[bj][0] = *(const f32x4*)p; xa[bj][1] = *(const f32x4*)(p + 4); }
#pragma unroll
            for (int bj = 0; bj < 2; ++bj) { float* p = xob + (size_t)(EPI_ROWS(ai, m) + oz_) * D + EPI_COL8(bj);
                *(f32x4*)p = ((xa[bj][0] - sv[0]) * sv[1]) * la[bj][0] + acc[ai][bj][m][0];
                *(f32x4*)(p + 4) = ((xa[bj][1] - sv[0]) * sv[1]) * la[bj][1] + acc[ai][bj][m][1]; }
            if (m & 1) ROW_FENCE;
        }
    }
};

struct EpiSlab {
    float* slab;
    DI void operator()(Acc& acc, const Unit& u, int wr, int wc, int fr, int fq) const {
        FOR_AI_M { const int r = u.z * MC + u.pm * 256 + EPI_ROWS(ai, m);
#pragma unroll
            for (int bj = 0; bj < 2; ++bj) { float* o = slab + (size_t)r * 1024 + u.pn * 256 + EPI_COL8(bj);
                *(f32x4*)o = acc[ai][bj][m][0]; *(f32x4*)(o + 4) = acc[ai][bj][m][1]; } }
    }
};

struct EpiW1 {
    const Frame& F;
    DI void operator()(Acc& acc, const Unit& u, int wr, int wc, int fr, int fq) const {
        bf16_t* U = (bf16_t*)(F.ws + WS_U);
        FOR_AI_M { const int r = u.pm * 256 + EPI_ROWS(ai, m);
#pragma unroll
            for (int bj = 0; bj < 2; ++bj) { f32x4 a = acc[ai][bj][m][0], b = acc[ai][bj][m][1];
#pragma unroll
                for (int e = 0; e < 4; ++e) { const float x = fmaxf(a[e], 0.f), y = fmaxf(b[e], 0.f); a[e] = x * x; b[e] = y * y; }
                *(u32x4*)(U + (size_t)r * DFF + u.pn * 256 + EPI_COL8(bj)) = pk8(a, b); } }
    }
};

#define MFMA32(a, b, c) __builtin_amdgcn_mfma_f32_32x32x16_bf16((a), (b), (c), 0, 0, 0)
constexpr int ATT_KBUF = 14336;
constexpr int ATT_KR = 9216, ATT_VB = 28672, ATT_VBUF = 8192, ATT_OST = 57344;
template <int KIND>
DI void attn_unit(const Frame& F, int qrow0, int head, int ctx_row0, int lat_row0, int ntiles) {
    constexpr int ND = KIND == 0 ? 6 : 4;
    unsigned char* ws = F.ws; LAS unsigned char* lds = F.lds;
    int tid_ = F.tid; asm volatile("" : "+v"(tid_));
    const int tid = tid_ & 511, lane = tid & 63, w = __builtin_amdgcn_readfirstlane(tid >> 6), r32 = lane & 31, h5 = lane >> 5;
    const bf16_t *Kp, *Vp, *Qp; bf16_t* Op; int ldk, ldq, ldo;
    if (KIND == 0) { Kp = (const bf16_t*)(ws + WS_KN) + head * 64; Vp = (const bf16_t*)(ws + WS_VM) + head * 64; ldk = 512; Qp = (const bf16_t*)(ws + WS_QM) + head * 96; ldq = 768;
                     Op = (bf16_t*)(ws + WS_AM) + head * 64; ldo = 512; }
    else { Kp = (const bf16_t*)(ws + WS_KG) + (head >> 2) * 64; Vp = (const bf16_t*)(ws + WS_VG) + (head >> 2) * 64; ldk = 128; Qp = (const bf16_t*)(ws + WS_QG) + head * 64; ldq = 512;
           Op = (bf16_t*)(ws + WS_QG) + head * 64; ldo = 512; }
    const bf16_t* Krp = (const bf16_t*)(ws + WS_KR);
    bf16x8 qf[ND];
    { const bf16_t* qr = Qp + (size_t)(qrow0 + 32 * w + r32) * ldq + 8 * h5;
#pragma unroll
      for (int ds = 0; ds < ND; ++ds) qf[ds] = *(const bf16x8*)(qr + 16 * ds); }
    const int skey = tid >> 3, sch = tid & 7;
    const int skey_r = (tid & 255) >> 2, sch_r = tid & 3;
    const unsigned kdst = skey * 144 + sch * 16;
    const unsigned vdst = (sch >> 2) * 4096 + skey * 64 + (sch & 3) * 16;
    const unsigned rdst = ATT_KR + skey_r * 80 + sch_r * 16;
    u32x4 kreg, vreg, rreg;
#define ATT_KEYROW(t) ((t) < 4 ? ctx_row0 + 64 * (t) : lat_row0 + 64 * ((t) - 4))
    const unsigned kbase = r32 * 144 + h5 * 16, rbase = ATT_KR + r32 * 80 + h5 * 16;
    const unsigned voff = (4 * h5 + ((lane & 15) >> 2)) * 64 + ((lane >> 4) & 1) * 32 + (lane & 3) * 8;
    float mref = 0.f, lsum = 0.f;
    f32x16 o0, o1;
#pragma unroll
    for (int i = 0; i < 16; ++i) { o0[i] = 0.f; o1[i] = 0.f; }
#define ATT_QK1(S, buf, kb, C) do { LAS unsigned char* kq_ = lds + (buf) * ATT_KBUF + (kb) * 32 * 144; LAS unsigned char* kr_ = lds + (buf) * ATT_KBUF + (kb) * 32 * 80; \
        bf16x8 kf_[ND]; \
        _Pragma("unroll") for (int ds = 0; ds < ND; ++ds) kf_[ds] = ds < 4 ? *(const LAS bf16x8*)(kq_ + kbase + ds * 32) : *(const LAS bf16x8*)(kr_ + rbase + (ds - 4) * 32); \
        _Pragma("unroll") for (int ds = 0; ds < ND; ++ds) { if (ds == 0) S = MFMA32(kf_[0], qf[0], C); else S = MFMA32(kf_[ds], qf[ds], S); } } while (0)
#define ATT_QKM(S0, S1, buf, C) do { ATT_QK1(S0, buf, 0, C); ATT_QK1(S1, buf, 1, C); } while (0)
#define ATT_VFRAG(dst, vb, kb) do { \
        _Pragma("unroll") for (int s = 0; s < 2; ++s) _Pragma("unroll") for (int db = 0; db < 2; ++db) { \
            const unsigned a_ = voff + db * 4096 + (32 * (kb) + 16 * s) * 64; \
            const s16x4 lo = __builtin_bit_cast(s16x4, __builtin_amdgcn_ds_read_tr16_b64_v4i16((LAS s16x4*)((vb) + a_))); \
            const s16x4 hi = __builtin_bit_cast(s16x4, __builtin_amdgcn_ds_read_tr16_b64_v4i16((LAS s16x4*)((vb) + a_ + 512))); \
            dst[s][db] = __builtin_shufflevector(lo, hi, 0, 1, 2, 3, 4, 5, 6, 7); } } while (0)
#define ATT_PV(PF, vb) do { \
        { bf16x8 va[2][2]; ATT_VFRAG(va, vb, 0); \
          _Pragma("unroll") for (int s = 0; s < 2; ++s) { o0 = MFMA32(va[s][0], PF[0][s], o0); o1 = MFMA32(va[s][1], PF[0][s], o1); } } \
        { bf16x8 vb2[2][2]; ATT_VFRAG(vb2, vb, 1); \
          _Pragma("unroll") for (int s = 0; s < 2; ++s) { o0 = MFMA32(vb2[s][0], PF[1][s], o0); o1 = MFMA32(vb2[s][1], PF[1][s], o1); } } } while (0)
    bf16x8 pfa[2][2], pfb[2][2];
    f32x16 s0, s1, n0, n1;
#define ATT_LOADK2(t, KR_, RR_) do { const int kr_ = ATT_KEYROW(t); KR_ = *(const u32x4*)(Kp + (size_t)(kr_ + skey) * ldk + sch * 8); \
        if (KIND == 0 && tid < 256) RR_ = *(const u32x4*)(Krp + (size_t)(kr_ + skey_r) * 32 + sch_r * 8); } while (0)
#define ATT_LOADV2(t, VR_) do { const int kr_ = ATT_KEYROW(t); VR_ = *(const u32x4*)(Vp + (size_t)(kr_ + skey) * ldk + sch * 8); } while (0)
#define ATT_STOREK2(buf, KR_, RR_) do { LAS unsigned char* b_ = lds + (buf) * ATT_KBUF; *(LAS u32x4*)(b_ + kdst) = KR_; if (KIND == 0 && tid < 256) *(LAS u32x4*)(b_ + rdst) = RR_; } while (0)
#define ATT_STOREV2(vsl, VR_) do { *(LAS u32x4*)(lds + ATT_VB + (vsl) + vdst) = VR_; } while (0)
#define ATT_PACK(PF_, A0, A1) do { _Pragma("unroll") for (int s = 0; s < 2; ++s) { \
            u32x4 a, b; \
            a.x = pk2(A0[8 * s + 0], A0[8 * s + 1]); a.y = pk2(A0[8 * s + 2], A0[8 * s + 3]); a.z = pk2(A0[8 * s + 4], A0[8 * s + 5]); a.w = pk2(A0[8 * s + 6], A0[8 * s + 7]); \
            b.x = pk2(A1[8 * s + 0], A1[8 * s + 1]); b.y = pk2(A1[8 * s + 2], A1[8 * s + 3]); b.z = pk2(A1[8 * s + 4], A1[8 * s + 5]); b.w = pk2(A1[8 * s + 6], A1[8 * s + 7]); \
            PF_[0][s] = __builtin_bit_cast(bf16x8, a); PF_[1][s] = __builtin_bit_cast(bf16x8, b); } } while (0)
#define ATT_BODY(t, KS, VS, RS, KL, VL, RL, C0, C1, N0, N1, PFN, PFP, HAS_PV, HAS_QK) do { \
        const bool more = (t + 1 < ntiles), more2 = (t + 2 < ntiles); \
        if (more2) ATT_LOADK2(t + 2, KS, RS); \
        if (more) ATT_LOADV2(t + 1, VS); \
        __builtin_amdgcn_iglp_opt(2); \
        if (HAS_QK) { f32x16 ng_; _Pragma("unroll") for (int i = 0; i < 16; ++i) ng_[i] = -mref; ATT_QKM(N0, N1, (t + 1) & 1, ng_); } \
        if (HAS_PV) ATT_PV(PFP, lds + ATT_VB + (vs_c == 0 ? 2 * ATT_VBUF : vs_c - ATT_VBUF)); \
        float psa = 0.f, psb = 0.f; \
        _Pragma("unroll") for (int i = 0; i < 16; ++i) { C0[i] = __builtin_amdgcn_exp2f(C0[i]); C1[i] = __builtin_amdgcn_exp2f(C1[i]); psa += C0[i]; psb += C1[i]; } \
        psa += psb; \
        ATT_PACK(PFN, C0, C1); \
        if (__builtin_expect(__any(psa > BIGP), 0)) { \
            float mx = fmaxf(C0[0], C1[0]); \
            _Pragma("unroll") for (int i = 1; i < 16; ++i) mx = fmaxf(mx, fmaxf(C0[i], C1[i])); \
            { auto rr = __builtin_amdgcn_permlane32_swap(__float_as_uint(mx), __float_as_uint(mx), false, false); mx = fmaxf(__uint_as_float(rr[0]), __uint_as_float(rr[1])); } \
            const float dl = mx > 1.f ? ceilf(__log2f(mx)) : 0.f; const float f = __builtin_amdgcn_exp2f(-dl); \
            mref += dl; lsum *= f; psa *= f; \
            _Pragma("unroll") for (int i = 0; i < 16; ++i) { C0[i] *= f; C1[i] *= f; o0[i] *= f; o1[i] *= f; N0[i] -= dl; N1[i] -= dl; } \
            ATT_PACK(PFN, C0, C1); \
        } \
        lsum += psa; \
        if (more2) ATT_STOREK2(t & 1, KS, RS); \
        if (more) ATT_STOREV2((vs_c == 2 * ATT_VBUF ? 0 : vs_c + ATT_VBUF), VS); \
        asm volatile("s_waitcnt lgkmcnt(0)\n\ts_barrier" ::: "memory"); \
        vs_c = (vs_c == 2 * ATT_VBUF ? 0 : vs_c + ATT_VBUF); \
    } while (0)
    constexpr float BIGP = 65536.f;
    int vs_c = 0;
    ATT_LOADK2(0, kreg, rreg); ATT_LOADV2(0, vreg);
    ATT_STOREK2(0, kreg, rreg); ATT_STOREV2(0, vreg);
    ATT_LOADK2(1, kreg, rreg); ATT_STOREK2(1, kreg, rreg);
    __syncthreads();
    { f32x16 z_; _Pragma("unroll") for (int i = 0; i < 16; ++i) z_[i] = 0.f; ATT_QKM(s0, s1, 0, z_); }
    {
        float mx = fmaxf(s0[0], s1[0]);
#pragma unroll
        for (int i = 1; i < 16; ++i) mx = fmaxf(mx, fmaxf(s0[i], s1[i]));
        { auto rr = __builtin_amdgcn_permlane32_swap(__float_as_uint(mx), __float_as_uint(mx), false, false); mx = fmaxf(__uint_as_float(rr[0]), __uint_as_float(rr[1])); }
        mref = mx;
#pragma unroll
        for (int i = 0; i < 16; ++i) { s0[i] -= mx; s1[i] -= mx; }
    }
    { const int t = 0; ATT_BODY(t, kreg, vreg, rreg, kreg, vreg, rreg, s0, s1, n0, n1, pfa, pfb, 0, 1); }
    for (int t2 = 1; t2 < ntiles - 1; t2 += 2) {
        { const int t = t2; ATT_BODY(t, kreg, vreg, rreg, kreg, vreg, rreg, n0, n1, s0, s1, pfb, pfa, 1, 1); }
        { const int t = t2 + 1; ATT_BODY(t, kreg, vreg, rreg, kreg, vreg, rreg, s0, s1, n0, n1, pfa, pfb, 1, 1); }
    }
    { const int t = ntiles - 1; ATT_BODY(t, kreg, vreg, rreg, kreg, vreg, rreg, n0, n1, s0, s1, pfb, pfa, 1, 0); }
    ATT_PV(pfb, lds + ATT_VB + (vs_c == 0 ? 2 * ATT_VBUF : vs_c - ATT_VBUF));
    { auto rr = __builtin_amdgcn_permlane32_swap(__float_as_uint(lsum), __float_as_uint(lsum), false, false); lsum = __uint_as_float(rr[0]) + __uint_as_float(rr[1]); }
    const float inv = 1.f / lsum;
    {
        LAS unsigned char* stg = lds + ATT_OST + w * 4608;
        LAS unsigned char* mine = stg + r32 * 144 + 8 * h5;
#pragma unroll
        for (int g = 0; g < 4; ++g) {
            u32x2 a, b;
            a.x = pk2(o0[4 * g] * inv, o0[4 * g + 1] * inv); a.y = pk2(o0[4 * g + 2] * inv, o0[4 * g + 3] * inv);
            b.x = pk2(o1[4 * g] * inv, o1[4 * g + 1] * inv); b.y = pk2(o1[4 * g + 2] * inv, o1[4 * g + 3] * inv);
            *(LAS u32x2*)(mine + 16 * g) = a; *(LAS u32x2*)(mine + 64 + 16 * g) = b;
        }
        asm volatile("s_waitcnt lgkmcnt(0)" ::: "memory");
        bf16_t* ob = Op + (size_t)(qrow0 + 32 * w) * ldo;
#pragma unroll
        for (int it = 0; it < 4; ++it) { const int row = it * 8 + (lane >> 3), ch = lane & 7;
            const u32x4 v = *(const LAS u32x4*)(stg + row * 144 + ch * 16);
            *(u32x4*)(ob + (size_t)row * ldo + ch * 8) = v; }
    }
    asm volatile("s_waitcnt lgkmcnt(0)\n\ts_barrier" ::: "memory");
#undef ATT_PV
#undef ATT_PACK
#undef ATT_LOADK
#undef ATT_LOADV
#undef ATT_STOREK
#undef ATT_STOREV
#undef ATT_QK1
#undef ATT_BODY
#undef ATT_LOADK2
#undef ATT_LOADV2
#undef ATT_STOREK2
#undef ATT_STOREV2
#undef ATT_QKM
#undef ATT_VFRAG
#undef ATT_KEYROW
#undef ATT_LOAD
#undef ATT_STORE
}

DI void wave_sum2(float& a, float& b, int lane) {
#pragma unroll
    for (int o = 1; o < 64; o <<= 1) { const float ta = shx(a, o, lane), tb = shx(b, o, lane); a += ta; b += tb; }
}
DI void ln_row_v(const Frame& F, f32x4 (&v)[4], float* xout, const float* g, const float* b, const float* sh, const float* sc, bf16_t* hout, const float* slab, const float* gres, float* stat = nullptr) {
    if (slab) {
#pragma unroll
        for (int j = 0; j < 4; ++j) { f32x4 a = ((const f32x4*)slab)[F.lane + 64 * j];
#pragma unroll
            for (int z = 1; z < 8; ++z) a += ((const f32x4*)(slab + (size_t)z * MC * 1024))[F.lane + 64 * j];
            v[j] = v[j] * ALPHA + ((const f32x4*)gres)[F.lane + 64 * j] * a; }
    }
    if (g) {
        float s = 0.f, s2 = 0.f;
#pragma unroll
        for (int j = 0; j < 4; ++j) { s += (v[j][0] + v[j][1]) + (v[j][2] + v[j][3]); s2 += (v[j][0] * v[j][0] + v[j][1] * v[j][1]) + (v[j][2] * v[j][2] + v[j][3] * v[j][3]); }
        wave_sum2(s, s2, F.lane);
        const float mean = s * (1.f / D); const float rstd = 1.f / sqrtf(fmaxf(s2 * (1.f / D) - mean * mean, 0.f) + EPS);
        if (stat && F.lane == 0) { f32x2 sv = {mean, rstd}; *(f32x2*)stat = sv; }
#pragma unroll
        for (int j = 0; j < 4; ++j) { const f32x4 gg = ((const f32x4*)g)[F.lane + 64 * j], bb = ((const f32x4*)b)[F.lane + 64 * j];
            v[j] = (v[j] - mean) * rstd * gg + bb; if (xout) ((f32x4*)xout)[F.lane + 64 * j] = v[j]; }
    }
    if (hout) {
        float s = 0.f, s2 = 0.f;
#pragma unroll
        for (int j = 0; j < 4; ++j) { s += (v[j][0] + v[j][1]) + (v[j][2] + v[j][3]); s2 += (v[j][0] * v[j][0] + v[j][1] * v[j][1]) + (v[j][2] * v[j][2] + v[j][3] * v[j][3]); }
        wave_sum2(s, s2, F.lane);
        const float mean = s * (1.f / D); const float rstd = 1.f / sqrtf(fmaxf(s2 * (1.f / D) - mean * mean, 0.f) + EPS);
#pragma unroll
        for (int j = 0; j < 4; ++j) { const f32x4 hh = ((const f32x4*)sh)[F.lane + 64 * j], cc = ((const f32x4*)sc)[F.lane + 64 * j];
            const f32x4 o = (v[j] - mean) * rstd * (cc + 1.f) + hh; u32x2 wv; wv.x = pk2(o[0], o[1]); wv.y = pk2(o[2], o[3]);
            ((u32x2*)hout)[F.lane + 64 * j] = wv; }
    }
}
DI void ln_load(const Frame& F, const float* xin, f32x4 (&v)[4]) {
    const f32x4* xr = (const f32x4*)xin + F.lane;
#pragma unroll
    for (int j = 0; j < 4; ++j) v[j] = xr[64 * j];
}
DI void ln_row(const Frame& F, const float* xin, float* xout, const float* g, const float* b, const float* sh, const float* sc, bf16_t* hout, const float* slab = nullptr, const float* gres = nullptr) {
    f32x4 v[4]; ln_load(F, xin, v);
    ln_row_v(F, v, xout, g, b, sh, sc, hout, slab, gres);
}

DI int srcmap(int kind, int n) {
    switch (kind) {
    case 0: {
        if (n < 256) return n;
        if (n < 512) return 1056 + (n - 256);
        if (n < 768) { const int c = n - 512, slot = (c & 127) >> 5, d = 32 * (c >> 7) + (c & 31); return slot < 2 ? 288 + slot * 64 + d : 416 + (slot - 2) * 64 + d; }
        if (n < 1280) { const int t = (n - 768) >> 8, c = (n - 768) & 255, slot = (c & 127) >> 5, d = 32 * (c >> 7) + (c & 31); return 1312 + (4 * t + slot) * 64 + d; }
        return 1824 + (n - 1280); }
    case 1: { const int half = (n & 7) >> 2, i = 4 * (n >> 3) + (n & 3); return 256 + half * 16 + i; }
    case 2: {
        if (n < 512) return (n >> 6) * 96 + (n & 63);
        const int c = n - 512, hd = c >> 5, j = c & 31, half = (j & 7) >> 2, i = 4 * (j >> 3) + (j & 3); return hd * 96 + 64 + half * 16 + i; }
    default: return n;
    }
}
DI void conv_item(const float* W, int K, int ld, int kind, const float* gain, bf16_t* WT, int item, int nblk, LAS float* scr, int lane) {
    const int kb = item / nblk, nb = item % nblk, k0 = 64 * kb, n0 = 32 * nb;
    const int sc_ = srcmap(kind, n0 + (lane & 31));
    float wv[32];
#pragma unroll
    for (int i = 0; i < 32; ++i) wv[i] = W[(size_t)(k0 + 2 * i + (lane >> 5)) * ld + sc_];
    if (gain) {
#pragma unroll
        for (int i = 0; i < 32; ++i) wv[i] *= gain[k0 + 2 * i + (lane >> 5)];
    }
#pragma unroll
    for (int i = 0; i < 32; ++i) scr[(2 * i + (lane >> 5)) * 33 + (lane & 31)] = wv[i];
    asm volatile("s_waitcnt lgkmcnt(0)" ::: "memory");
    const int c = lane & 7;
#pragma unroll
    for (int j = 0; j < 4; ++j) { const int n = (lane >> 3) + 8 * j; const LAS float* s = scr + (8 * c) * 33 + n;
        u32x4 o; o.x = pk2(s[0 * 33], s[1 * 33]); o.y = pk2(s[2 * 33], s[3 * 33]); o.z = pk2(s[4 * 33], s[5 * 33]); o.w = pk2(s[6 * 33], s[7 * 33]);
        *(u32x4*)(WT + (size_t)(n0 + n) * K + k0 + 8 * c) = o; }
    asm volatile("s_waitcnt lgkmcnt(0)" ::: "memory");
}
template <int Q0, int Q1>
DI void convert_weights(const Frame& F, int l, int crank, int ncu) {
    LAS float* scr = (LAS float*)(F.lds + F.wave * 16384);
    unsigned char* W = F.ws + WS_W;
    const int gw = crank * 8 + F.wave, NGW = ncu * 8;
    const float* w_in = pin(F, I_WIN) + (size_t)l * D * INC;
    struct It { const float* src; int K, ld, kind, N; const float* gain; size_t dst; };
    const It its[11] = {
        {w_in, 1024, INC, 0, NIN, nullptr, W_IN},
        {w_in, 1024, INC, 1, 32, nullptr, W_KR},
        {pin(F, I_WUK) + (size_t)l * 256 * 512, 256, 512, 9, 512, pin(F, I_MKVG) + l * 256, W_UKV},
        {pin(F, I_WUV) + (size_t)l * 256 * 512, 256, 512, 9, 512, pin(F, I_MKVG) + l * 256, W_UKV + 512 * 256 * 2},
        {pin(F, I_WUQ) + (size_t)l * 256 * 768, 256, 768, 2, 768, pin(F, I_MQG) + l * 256, W_UQ},
        {pin(F, I_WFO) + (size_t)l * 512 * 1024, 512, 1024, 9, 1024, nullptr, W_FO},
        {pin(F, I_WMO) + (size_t)l * 512 * 1024, 512, 1024, 9, 1024, nullptr, W_MO},
        {pin(F, I_WGO) + (size_t)l * 512 * 1024, 512, 1024, 9, 1024, nullptr, W_GO},
        {pin(F, I_WO) + (size_t)l * 1024 * 1024, 1024, 1024, 9, 1024, nullptr, W_O},
        {pin(F, I_W1) + (size_t)l * 1024 * 4096, 1024, 4096, 9, 4096, nullptr, W_1},
        {pin(F, I_W2) + (size_t)l * 4096 * 1024, 4096, 1024, 9, 1024, nullptr, W_2}};
    int base = 0;
#pragma unroll
    for (int q = Q0; q < Q1; ++q) {
        const int nblk = its[q].N / 32, nit = (its[q].K / 64) * nblk;
        int first = (gw - base) % NGW; if (first < 0) first += NGW;
        for (int it = first; it < nit; it += NGW) conv_item(its[q].src, its[q].K, its[q].ld, its[q].kind, its[q].gain, (bf16_t*)(W + its[q].dst), it, nblk, scr, F.lane);
        base = (base + nit) % NGW;
    }
}
DI void fold_fourier(const Frame& F, int l, int crank, int ncu) {
    __syncthreads();
    LAS float* u = (LAS float*)F.lds;
    LAS float* T = (LAS float*)(F.lds + 32768);
    if (F.tid < 128) T[F.tid] = cospif((float)F.tid * (1.f / 64.f));
    const float* w_in = pin(F, I_WIN) + (size_t)l * D * INC;
    bf16_t* WT = (bf16_t*)(F.ws + WS_W + W_T);
    for (int item = crank; item < 256; item += ncu) {
        const int g = item >> 6, k0 = (item & 63) * 16;
        __syncthreads();
        for (int e = F.tid; e < 16 * 128; e += 512) { const int kk = e >> 7, c = e & 127; u[kk * 129 + c] = w_in[(size_t)(k0 + kk) * INC + 544 + g * 128 + c]; }
        __syncthreads();
        const int kk = F.tid & 15, grp = F.tid >> 4;
        float a[8];
#pragma unroll
        for (int o = 0; o < 8; ++o) a[o] = 0.f;
        for (int c = 0; c < 128; ++c) { const float uv = u[kk * 129 + c];
#pragma unroll
            for (int o = 0; o < 8; ++o) { const int mcs = grp * 8 + o, mm = mcs >> 1, cs = mcs & 1; a[o] += uv * T[(mm * c - 32 * cs) & 127]; } }
#pragma unroll
        for (int o = 0; o < 8; ++o) { const int mcs = grp * 8 + o; unsigned short hv = (unsigned short)(pk2(a[o], 0.f) & 0xffffu); WT[(size_t)(g * 256 + mcs) * 1024 + k0 + kk] = hv; }
    }
    __syncthreads();
}
DI void krope_phase(const Frame& F, int crank, int ncu) {
    const bf16_t* H = (const bf16_t*)(F.ws + WS_HB); const bf16_t* Wk = (const bf16_t*)(F.ws + WS_W + W_KR); bf16_t* KR = (bf16_t*)(F.ws + WS_KR);
    const float* rm = (const float*)(F.ws + WS_ROPEM);
    const int r32 = F.lane & 31, h5 = F.lane >> 5, w = F.wave;
    LAS float* part = (LAS float*)F.lds;
    for (int it = crank; it < MT / 32; it += ncu) {
        const int row0 = it * 32;
        f32x16 acc;
#pragma unroll
        for (int i = 0; i < 16; ++i) acc[i] = 0.f;
        const bf16_t* hp = H + (size_t)(row0 + r32) * 1024 + 8 * h5 + 128 * w; const bf16_t* wp = Wk + (size_t)r32 * 1024 + 8 * h5 + 128 * w;
        bf16x8 a[8], b[8];
#pragma unroll
        for (int q = 0; q < 8; ++q) { a[q] = *(const bf16x8*)(wp + 16 * q); b[q] = *(const bf16x8*)(hp + 16 * q); }
#pragma unroll
        for (int q = 0; q < 8; ++q) acc = MFMA32(a[q], b[q], acc);
        __syncthreads();
#pragma unroll
        for (int i = 0; i < 16; ++i) part[(w * 16 + i) * 64 + F.lane] = acc[i];
        __syncthreads();
        if (w == 0) {
#pragma unroll
            for (int i = 0; i < 16; ++i) { float sacc = 0.f;
#pragma unroll
                for (int q = 0; q < 8; ++q) sacc += part[(q * 16 + i) * 64 + F.lane];
                acc[i] = sacc; }
            const int row = row0 + r32;
            f32x16 oth;
#pragma unroll
            for (int i = 0; i < 16; ++i) oth[i] = shx(acc[i], 32, F.lane);
            u32x2 wv[4];
#pragma unroll
            for (int g = 0; g < 4; ++g) { float o[4];
#pragma unroll
                for (int e = 0; e < 4; ++e) { const int i = 4 * g + e; float x1 = h5 ? oth[i] : acc[i], x2 = h5 ? acc[i] : oth[i]; float cs = 1.f, sn = 0.f;
                    if (row < ML) { cs = rm[(size_t)(row & 2047) * 32 + i]; sn = rm[(size_t)(row & 2047) * 32 + 16 + i]; }
                    o[e] = h5 ? (x1 * sn + x2 * cs) : (x1 * cs - x2 * sn); }
                wv[g].x = pk2(o[0], o[1]); wv[g].y = pk2(o[2], o[3]); }
#pragma unroll
            for (int g = 0; g < 4; ++g) *(u32x2*)(KR + (size_t)row * 32 + 8 * g + 4 * h5) = wv[g];
        }
    }
    __syncthreads();
}

DI void prologue_a(const Frame& F) {
    unsigned char* ws = F.ws;
    convert_weights<0, 5>(F, 0, F.vcu, F.G);
    fold_fourier(F, 0, F.bid, F.G);
    { const int gt = F.bid * 512 + F.tid, NT = F.G * 512;
      float* rm = (float*)(ws + WS_ROPEM); float* rg = (float*)(ws + WS_ROPEG);
      for (int e = gt; e < 2048 * 16; e += NT) { const int pos = e >> 4, i = e & 15; const float fr_ = powf(10000.f, -(float)(i & 7) / 8.f); const float p_ = (i < 8) ? (float)(pos >> 6) : (float)(pos & 63);
          float sn, cs; sincosf(p_ * fr_, &sn, &cs); rm[pos * 32 + i] = cs; rm[pos * 32 + 16 + i] = sn; }
      for (int e = gt; e < 2048 * 32; e += NT) { const int pos = e >> 5, i = e & 31; const float fr_ = powf(10000.f, -(float)(i & 15) / 16.f); const float p_ = (i < 16) ? (float)(pos >> 6) : (float)(pos & 63);
          float sn, cs; sincosf(p_ * fr_, &sn, &cs); rg[pos * 64 + i] = cs; rg[pos * 64 + 32 + i] = sn; }
      bf16_t* dm = (bf16_t*)(ws + WS_DFTM);
      for (int e = gt; e < 2048 * 1024; e += NT) { const int k = e >> 10, j2 = (e & 1023) * 2; unsigned wv[2];
#pragma unroll
          for (int q = 0; q < 2; ++q) { const int j = j2 + q * 2048; float v0, v1; { const int jj = j & 2047; const float a0 = (float)((k * jj) & 2047) * (1.f / 1024.f), a1 = (float)((k * (jj + 1)) & 2047) * (1.f / 1024.f);
              if (j < 2048) { v0 = cospif(a0); v1 = cospif(a1); } else { v0 = -sinpif(a0); v1 = -sinpif(a1); } }
              wv[q] = pk2(v0 * (1.f / 512.f), v1 * (1.f / 512.f)); }
          *(unsigned*)(dm + (size_t)k * 4096 + j2) = wv[0]; *(unsigned*)(dm + (size_t)k * 4096 + 2048 + j2) = wv[1]; }
      bf16_t* dc = (bf16_t*)(ws + WS_DFTMC); const float sc = 0.005524271728019903f;
      for (int e = gt; e < 256 * 512; e += NT) { const int k = e >> 9, j = e & 511, jj = j & 255; const float a0 = (float)((k * jj) & 255) * (1.f / 128.f);
          const float v = (j < 256) ? cospif(a0) : -sinpif(a0); dc[e] = (unsigned short)(pk2(v * sc, 0.f) & 0xffffu); }
    }
    { __syncthreads();
      LAS float* sl = (LAS float*)F.lds;
      LAS float* red = (LAS float*)(F.lds + 36864);
      for (int e = F.tid; e < 9 * 1024; e += 512) { const int r = e >> 10, k = e & 1023; const float c = r < 8 ? pin(F, I_C)[r * 1024 + k] : pin(F, I_CCTX)[k]; sl[e] = c / (1.f + __expf(-c)); }
      __syncthreads();
      const int col = F.tid & 63, kg = F.tid >> 6;
      for (int item = F.bid; item < 4 * 96; item += F.G) {
          const int l = item / 96, cb = (item % 96) * 64;
          const float* wa = pin(F, I_WADA) + (size_t)l * 1024 * 6144 + cb + col;
          float a[9];
#pragma unroll
          for (int r = 0; r < 9; ++r) a[r] = 0.f;
          for (int k0 = kg * 128; k0 < kg * 128 + 128; k0 += 16) { float wv[16];
#pragma unroll
              for (int q = 0; q < 16; ++q) wv[q] = wa[(size_t)(k0 + q) * 6144];
#pragma unroll
              for (int q = 0; q < 16; ++q)
#pragma unroll
                  for (int r = 0; r < 9; ++r) a[r] += sl[r * 1024 + k0 + q] * wv[q]; }
#pragma unroll
          for (int r = 0; r < 9; ++r) red[(kg * 9 + r) * 64 + col] = a[r];
          __syncthreads();
          for (int e = F.tid; e < 9 * 64; e += 512) { const int r = e >> 6, c2 = e & 63; float s = pin(F, I_BADA)[l * 6144 + cb + c2];
#pragma unroll
              for (int q = 0; q < 8; ++q) s += red[(q * 9 + r) * 64 + c2];
              ((float*)(ws + WS_MOD))[(size_t)(l * 9 + r) * 6144 + cb + c2] = s; }
          __syncthreads();
      }
    }
}
DI void prologue_b(const Frame& F) {
    const int gw = F.vcu * 8 + F.wave, NGW = F.G * 8;
    bf16_t* H = (bf16_t*)(F.ws + WS_HB);
    for (int row = gw; row < MT; row += NGW) {
        const int mr = row < ML ? (row >> 11) : 8;
        const float* xi = row < ML ? pin(F, I_X) + (size_t)row * D : pin(F, I_CTX) + (size_t)(row - ML) * D;
        ln_row(F, xi, nullptr, nullptr, nullptr, modp(F, 0, mr, 0), modp(F, 0, mr, 1), H + (size_t)row * D);
    }
}
DI void ln_phase(const Frame& F, int which) {
    const int gw = F.vcu * 8 + F.wave, NGW = F.G * 8; const int l = F.l;
    const int nrows = (l == NL - 1) ? ML : MT;
    bf16_t* H = (bf16_t*)(F.ws + WS_HB);
    const float* g = pin(F, which == 0 ? I_LN1G : I_LN2G) + l * 1024; const float* b = pin(F, which == 0 ? I_LN1B : I_LN2B) + l * 1024;
    const bool wh = !(which == 1 && l == NL - 1);
    f32x4 vc[4], vn[4];
    if (gw < nrows) ln_load(F, xrow_ptr(F, gw), vc);
    for (int row = gw; row < nrows; row += NGW) {
        if (row + NGW < nrows) ln_load(F, xrow_ptr(F, row + NGW), vn);
        const int mr = row < ML ? (row >> 11) : 8;
        const float* sh = which == 0 ? modp(F, l, mr, 3) : modp(F, l + 1 < NL ? l + 1 : l, mr, 0);
        const float* sc = which == 0 ? modp(F, l, mr, 4) : modp(F, l + 1 < NL ? l + 1 : l, mr, 1);
        const bool sl = (which == 1 && row >= ML);
        const bool st_only = row < ML && !(which == 1 && l == NL - 1);
        float* stp = st_only ? (float*)(F.ws + (which == 0 ? WS_ST1 : WS_ST2)) + 2 * (size_t)row : nullptr;
        ln_row_v(F, vc, st_only ? nullptr : xrow_ptr(F, row), g, b, sh, sc, wh ? H + (size_t)row * D : nullptr, sl ? (const float*)(F.ws + WS_KN) + (size_t)(row - ML) * 1024 : nullptr, modp(F, l, mr, 5), stp);
#pragma unroll
        for (int j = 0; j < 4; ++j) vc[j] = vn[j];
    }
}

DI void phase_g1(const Frame& F) {
    const unsigned char* W = F.ws + WS_W; const char* H = (const char*)(F.ws + WS_HB);
    pg8::Sched2 S; S.tileBytes = 256L * 1024 * 2; S.G = F.G; S.c = F.bid;
    S.j0 = pg8::JobD{H, (const char*)(W + W_IN), MT / 256, NIN / 256, 1, 0, 0};
    S.j1 = pg8::JobD{(const char*)(W + W_T), H, 4, MT / 256, 1, 0, 0};
    S.n0 = (MT / 256) * (NIN / 256); S.total = S.n0 + 4 * (MT / 256);
    krope_phase(F, F.bid, F.G);
    EpiG1 E{F};
    pg8::gemm_phase(F.lds, 1024, S, E, F.tid);
}
DI void phase_g2(const Frame& F) {
    const unsigned char* W = F.ws + WS_W;
    pg8::Sched2 S; S.tileBytes = 256L * 256 * 2; S.G = F.G; S.c = F.bid;
    S.j0 = pg8::JobD{(const char*)(F.ws + WS_CKV), (const char*)(W + W_UKV), MT / 256, 4, 1, 0, 0};
    S.j1 = pg8::JobD{(const char*)(F.ws + WS_CQ), (const char*)(W + W_UQ), MT / 256, 3, 1, 0, 0};
    S.n0 = (MT / 256) * 4; S.total = S.n0 + (MT / 256) * 3;
    EpiG2 E{F};
    pg8::gemm_phase(F.lds, 256, S, E, F.tid);
}
DI void phase_att(const Frame& F) {
    const bool lastl = (F.l == NL - 1);
    const int nun = (!lastl && F.vcu < 128) ? 5 : 4;
#pragma unroll 1
    for (int i = 0; i < nun; ++i) {
        int kind, b, h, q0, nt;
        if (i < 4) { const int idx = (i >> 1) * 256 + F.vcu; kind = i & 1; b = idx >> 6; h = (idx >> 3) & 7; q0 = b * SEQ + (idx & 7) * 256; nt = 36; }
        else { const int idx = F.vcu >> 1; kind = F.vcu & 1; b = idx >> 3; h = idx & 7; q0 = ML + b * CTXL; nt = 4; }
        if (kind == 0) attn_unit<0>(F, q0, h, ML + b * CTXL, b * SEQ, nt);
        else attn_unit<1>(F, q0, h, ML + b * CTXL, b * SEQ, nt);
    }
    __syncthreads();
#ifndef NO_DFT
    {
        pg8::Sched2 S; S.tileBytes = 256L * 4096 * 2; S.G = F.G; S.c = (F.bid + 128) & 255;
        S.j0 = pg8::JobD{(const char*)(F.ws + WS_DFTM), (const char*)(F.ws + WS_TF), 8, 2, 8, 0, 1024L * 2048 * 2}; S.j1 = S.j0;
        S.n0 = 128; S.total = 128;
        EpiDft E{(bf16_t*)(F.ws + WS_F), 2048, 512};
        pg8::gemm_phase(F.lds, 4096, S, E, F.tid);
#ifdef PROBE_DFT
        pg8::gemm_phase(F.lds, 4096, S, E, F.tid);
#endif
    }
    if (!lastl) {
        pg8::Sched2 S; S.tileBytes = 256L * 512 * 2; S.G = F.G; S.c = F.bid;
        S.j0 = pg8::JobD{(const char*)(F.ws + WS_DFTMC), (const char*)(F.ws + WS_TFC), 1, 2, 8, 0, 1024L * 256 * 2}; S.j1 = S.j0;
        S.n0 = 16; S.total = 16;
        EpiDft E{(bf16_t*)(F.ws + WS_F) + (size_t)ML * 512, 256, 512};
        pg8::gemm_phase(F.lds, 512, S, E, F.tid);
    }
#endif
    if (F.bid < 128) {
        __syncthreads();
        const int cr = (F.bid & 7) * 16 + (F.bid >> 3);
        convert_weights<5, 11>(F, F.l, cr, 128);
    }
}
DI void phase_g3(const Frame& F) {
    const unsigned char* W = F.ws + WS_W; const int nM = (F.l == NL - 1 ? ML : MT) / 256;
    pg8::Sched3 S; S.tileBytes = 256L * 512 * 2; S.G = F.G; S.c = F.bid; S.ntiles = nM * 4;
    S.j = pg8::JobD{(const char*)(F.ws + WS_F), (const char*)(W + W_FO), nM, 4, 1, 0, 0};
    S.A1 = (const char*)(F.ws + WS_AM); S.B1 = (const char*)(W + W_MO); S.A2 = (const char*)(F.ws + WS_QG); S.B2 = (const char*)(W + W_GO);
    EpiG3 E{F};
    pg8::gemm_phase(F.lds, 512, S, E, F.tid);
    if (F.l + 1 < NL && F.bid >= 32) {
        __syncthreads();
        convert_weights<0, 5>(F, F.l + 1, F.bid - 32, F.G - 32); fold_fourier(F, F.l + 1, F.bid - 32, F.G - 32);
    }
}
DI void phase_g4(const Frame& F) {
    const unsigned char* W = F.ws + WS_W; const int nM = (F.l == NL - 1 ? ML : MT) / 256;
    pg8::Sched2 S; S.tileBytes = 256L * 1024 * 2; S.G = F.G; S.c = F.bid;
    S.j0 = pg8::JobD{(const char*)(F.ws + WS_HB), (const char*)(W + W_O), nM, 4, 1, 0, 0}; S.j1 = S.j0; S.n0 = nM * 4; S.total = S.n0;
    EpiRes E{F, 2, true, F.l > 0 ? 2 : 0};
    pg8::gemm_phase(F.lds, 1024, S, E, F.tid);
}
DI void phase_g5(const Frame& F) {
    const unsigned char* W = F.ws + WS_W; const int nM = (F.l == NL - 1 ? ML : MT) / 256;
    pg8::Sched2 S; S.tileBytes = 256L * 1024 * 2; S.G = F.G; S.c = F.bid;
    S.j0 = pg8::JobD{(const char*)(F.ws + WS_HB), (const char*)(W + W_1), nM, 16, 1, 0, 0}; S.j1 = S.j0; S.n0 = nM * 16; S.total = S.n0;
    EpiW1 E{F};
    pg8::gemm_phase(F.lds, 1024, S, E, F.tid);
#ifdef PROBE_G5
    pg8::gemm_phase(F.lds, 1024, S, E, F.tid);
#endif
}
DI void phase_g6(const Frame& F) {
    const unsigned char* W = F.ws + WS_W;
    {
        pg8::Sched2 S; S.tileBytes = 256L * 4096 * 2; S.G = F.G; S.c = F.bid;
        S.j0 = pg8::JobD{(const char*)(F.ws + WS_U), (const char*)(W + W_2), ML / 256, 4, 1, 0, 0}; S.j1 = S.j0; S.n0 = (ML / 256) * 4; S.total = S.n0;
        EpiRes E{F, 5, false, 1};
        pg8::gemm_phase(F.lds, 4096, S, E, F.tid);
    }
    if (F.l < NL - 1) {
        pg8::Sched2 S; S.tileBytes = 256L * 4096 * 2; S.G = F.G; S.c = F.bid;
        S.j0 = pg8::JobD{(const char*)(F.ws + WS_U) + (size_t)ML * 4096 * 2, (const char*)(W + W_2), MC / 256, 4, 8, 512 * 2, 512 * 2}; S.j1 = S.j0; S.n0 = (MC / 256) * 4 * 8; S.total = S.n0;
        EpiSlab E{(float*)(F.ws + WS_KN)};
        pg8::gemm_phase<4096>(F.lds, 512, S, E, F.tid);
    }
}

constexpr int N_PHASES = 2 + 9 * NL;
template <int ONLY>
__global__ void __launch_bounds__(512, 2) fwd_kernel(Params prm) {
    extern __shared__ __attribute__((aligned(16))) unsigned char lds_raw[];
    Frame F;
    F.P = &prm; F.ws = prm.ws; F.lds = (LAS unsigned char*)lds_raw;
    F.tid = threadIdx.x; F.lane = F.tid & 63; F.wave = __builtin_amdgcn_readfirstlane(F.tid >> 6);
    F.G = gridDim.x; F.bid = blockIdx.x; F.vcu = (F.G % 8 == 0) ? (F.bid % 8) * (F.G / 8) + F.bid / 8 : F.bid; F.l = 0;
    volatile LAS unsigned* MISC = (volatile LAS unsigned*)(F.lds + MISC_OFF);
    for (int u = F.tid; u < (LDS_BYTES - RING_BYTES) / 4; u += 512) ((LAS unsigned*)(F.lds + RING_BYTES))[u] = 0u;
    __syncthreads();
#if MK_ONE_LAUNCH
    const int lo = 0, hi = N_PHASES;
#else
    const int lo = prm.ph_lo, hi = prm.ph_hi;
#endif
    XcdBarrier bar; bar.bar = (unsigned*)(F.ws + WS_CTL) + 4096; bar.x = 0; bar.st = nullptr;
    if (hi - lo > 1) {
        bar = xcd_barrier_post((unsigned*)(F.ws + WS_CTL) + 4096, MISC + 8);
        cg::this_grid().sync();
        if (threadIdx.x == 0) { unsigned nloc, nx; xcd_barrier_complete(bar.bar, bar.x, nloc, nx); bar.st[0] = nloc; bar.st[1] = nx; }
        __syncthreads();
    }
    const int wave_s = __builtin_amdgcn_readfirstlane(threadIdx.x >> 6);
    for (int ph = lo; ph < hi; ++ph) {
        { int lane_; asm volatile("v_mbcnt_lo_u32_b32 %0, -1, 0\n\tv_mbcnt_hi_u32_b32 %0, -1, %0" : "=v"(lane_));
          int z_ = 0, b_ = blockIdx.x, g_ = gridDim.x, t_ = wave_s * 64 + lane_;
#if (OPQ_MASK & 1)
          asm volatile("" : "+s"(z_));
#endif
#if (OPQ_MASK & 2)
          asm volatile("" : "+s"(b_), "+s"(g_));
#endif
#if (OPQ_MASK & 4)
          asm volatile("" : "+v"(t_));
#endif
          F.ws = prm.ws + z_; F.zo = z_;
          b_ &= 1023; g_ &= 1023; F.bid = b_; F.G = g_; F.vcu = (g_ % 8 == 0) ? (b_ % 8) * (g_ / 8) + b_ / 8 : b_; F.tid = t_ & 511; F.lane = t_ & 63; F.wave = __builtin_amdgcn_readfirstlane((t_ & 511) >> 6); }
        if constexpr (ONLY >= 0) {
            F.l = ph < 2 ? 0 : (ph - 2) / 9;
            if constexpr (ONLY == 100) prologue_a(F);
            else if constexpr (ONLY == 101) prologue_b(F);
            else if constexpr (ONLY == 0) phase_g1(F);
            else if constexpr (ONLY == 1) phase_g2(F);
            else if constexpr (ONLY == 2) phase_att(F);
            else if constexpr (ONLY == 3) phase_g3(F);
            else if constexpr (ONLY == 4) phase_g4(F);
            else if constexpr (ONLY == 5) ln_phase(F, 0);
            else if constexpr (ONLY == 6) phase_g5(F);
            else if constexpr (ONLY == 7) phase_g6(F);
            else ln_phase(F, 1);
            continue;
        }
        if (ph == 0) prologue_a(F);
        else if (ph == 1) prologue_b(F);
        else {
            const int q = ph - 2; F.l = q / 9; const int sub = q - F.l * 9;
            switch (sub) {
            case 0: phase_g1(F); break;
            case 1: phase_g2(F); break;
            case 2: phase_att(F); break;
            case 3: phase_g3(F); break;
            case 4: phase_g4(F); break;
            case 5: ln_phase(F, 0); break;
            case 6: phase_g5(F); break;
            case 7: phase_g6(F); break;
            default: ln_phase(F, 1); break;
            }
        }
        if (ph + 1 < hi) { XcdBarrier b2; b2.bar = (unsigned*)(F.ws + WS_CTL) + 4096; b2.x = xb_xcc_id(); b2.st = (volatile LAS unsigned*)(F.lds + MISC_OFF) + 8; xcd_barrier(b2, F.tid); }
    }
}

extern "C" void kernel_launch(void* const* d_in, const int* in_sizes, int n_in, void* d_out, int out_size, void* d_ws, size_t ws_size, hipStream_t stream) {
    static int grid = 0;
    if (grid == 0) {
        if (n_in != 25 || out_size != ML * D || ws_size < WS_END) { fprintf(stderr, "kernel_launch: unexpected shapes (n_in %d out %d ws %zu)\n", n_in, out_size, ws_size); grid = -1; return; }
        int dev = 0, cus = 0, per_cu = 0;
        (void)hipGetDevice(&dev); (void)hipDeviceGetAttribute(&cus, hipDeviceAttributeMultiprocessorCount, dev);
#if MK_ONE_LAUNCH
        (void)hipFuncSetAttribute((const void*)fwd_kernel<-1>, hipFuncAttributeMaxDynamicSharedMemorySize, LDS_BYTES);
        (void)hipOccupancyMaxActiveBlocksPerMultiprocessor(&per_cu, (const void*)fwd_kernel<-1>, 512, LDS_BYTES);
#else
        (void)hipFuncSetAttribute((const void*)fwd_kernel<100>, hipFuncAttributeMaxDynamicSharedMemorySize, LDS_BYTES);
        (void)hipFuncSetAttribute((const void*)fwd_kernel<101>, hipFuncAttributeMaxDynamicSharedMemorySize, LDS_BYTES);
        (void)hipFuncSetAttribute((const void*)fwd_kernel<0>, hipFuncAttributeMaxDynamicSharedMemorySize, LDS_BYTES);
        (void)hipFuncSetAttribute((const void*)fwd_kernel<1>, hipFuncAttributeMaxDynamicSharedMemorySize, LDS_BYTES);
        (void)hipFuncSetAttribute((const void*)fwd_kernel<2>, hipFuncAttributeMaxDynamicSharedMemorySize, LDS_BYTES);
        (void)hipFuncSetAttribute((const void*)fwd_kernel<3>, hipFuncAttributeMaxDynamicSharedMemorySize, LDS_BYTES);
        (void)hipFuncSetAttribute((const void*)fwd_kernel<4>, hipFuncAttributeMaxDynamicSharedMemorySize, LDS_BYTES);
        (void)hipFuncSetAttribute((const void*)fwd_kernel<5>, hipFuncAttributeMaxDynamicSharedMemorySize, LDS_BYTES);
        (void)hipFuncSetAttribute((const void*)fwd_kernel<6>, hipFuncAttributeMaxDynamicSharedMemorySize, LDS_BYTES);
        (void)hipFuncSetAttribute((const void*)fwd_kernel<7>, hipFuncAttributeMaxDynamicSharedMemorySize, LDS_BYTES);
        (void)hipFuncSetAttribute((const void*)fwd_kernel<8>, hipFuncAttributeMaxDynamicSharedMemorySize, LDS_BYTES);
#endif
        (void)hipGetLastError();
        if (per_cu < 1) per_cu = 1;
        grid = cus;
        if (grid != 256) fprintf(stderr, "kernel_launch: grid %d (expected 256)\n", grid);
    }
    if (grid < 0) return;
    (void)hipMemsetAsync((char*)d_ws + WS_CTL, 0, CTL_BYTES, stream);
    Params p{};
    for (int i = 0; i < 25; ++i) p.in[i] = (const float*)d_in[i];
    p.out = (float*)d_out; p.ws = (unsigned char*)d_ws;
#if MK_ONE_LAUNCH
    p.ph_lo = 0; p.ph_hi = N_PHASES;
    void* args[] = {&p};
    hipError_t e = hipLaunchCooperativeKernel((const void*)fwd_kernel<-1>, dim3(grid), dim3(512), args, LDS_BYTES, stream);
    if (e != hipSuccess) fprintf(stderr, "cooperative launch failed: %s\n", hipGetErrorString(e));
#else
    for (int ph = 0; ph < N_PHASES; ++ph) {
        p.ph_lo = ph; p.ph_hi = ph + 1;
        const int sub = ph < 2 ? 100 + ph : (ph - 2) % 9;
        switch (sub) {
        case 100: hipLaunchKernelGGL(fwd_kernel<100>, dim3(grid), dim3(512), LDS_BYTES, stream, p); break;
        case 101: hipLaunchKernelGGL(fwd_kernel<101>, dim3(grid), dim3(512), LDS_BYTES, stream, p); break;
        case 0: hipLaunchKernelGGL(fwd_kernel<0>, dim3(grid), dim3(512), LDS_BYTES, stream, p); break;
        case 1: hipLaunchKernelGGL(fwd_kernel<1>, dim3(grid), dim3(512), LDS_BYTES, stream, p); break;
        case 2: hipLaunchKernelGGL(fwd_kernel<2>, dim3(grid), dim3(512), LDS_BYTES, stream, p); break;
        case 3: hipLaunchKernelGGL(fwd_kernel<3>, dim3(grid), dim3(512), LDS_BYTES, stream, p); break;
        case 4: hipLaunchKernelGGL(fwd_kernel<4>, dim3(grid), dim3(512), LDS_BYTES, stream, p); break;
        case 5: hipLaunchKernelGGL(fwd_kernel<5>, dim3(grid), dim3(512), LDS_BYTES, stream, p); break;
        case 6: hipLaunchKernelGGL(fwd_kernel<6>, dim3(grid), dim3(512), LDS_BYTES, stream, p); break;
        case 7: hipLaunchKernelGGL(fwd_kernel<7>, dim3(grid), dim3(512), LDS_BYTES, stream, p); break;
        default: hipLaunchKernelGGL(fwd_kernel<8>, dim3(grid), dim3(512), LDS_BYTES, stream, p); break;
        }
    }
#endif
}
```

```cpp
#include <hip/hip_runtime.h>
#include <hip/hip_cooperative_groups.h>
#include <cstdio>
#include <cstdint>
namespace cg = cooperative_groups;

#define LAS __attribute__((address_space(3)))
#define DI __device__ __forceinline__
typedef unsigned short bf16_t;
typedef short bf16x8 __attribute__((ext_vector_type(8)));
typedef short s16x4 __attribute__((ext_vector_type(4)));
typedef float f32x2 __attribute__((ext_vector_type(2)));
typedef float f32x4 __attribute__((ext_vector_type(4)));
typedef float f32x16 __attribute__((ext_vector_type(16)));
typedef unsigned u32x4 __attribute__((ext_vector_type(4)));
typedef unsigned u32x2 __attribute__((ext_vector_type(2)));
typedef __bf16 bf16x2_t __attribute__((ext_vector_type(2)));

#ifndef MK_ONE_LAUNCH
#define MK_ONE_LAUNCH 1
#endif
#ifndef OPQ_MASK
#if MK_ONE_LAUNCH
#define OPQ_MASK 7
#else
#define OPQ_MASK 0
#endif
#endif

constexpr int D = 1024, NB = 8, SEQ = 2048, CTXL = 256, NL = 4;
constexpr int ML = NB * SEQ, MC = NB * CTXL, MT = ML + MC;
constexpr int DFF = 4096, INC = 4896;
constexpr float EPS = 1e-6f;
constexpr float ALPHA = 1.6817928305074290f;
constexpr float QS_MLA = (float)(0.10206207261596575 * 1.4426950408889634);
constexpr float QS_GQA = (float)(0.125 * 1.4426950408889634);
constexpr int NIN = 4352;

constexpr size_t MiB = 1u << 20;
constexpr size_t WS_CTL = 0, CTL_BYTES = 65536;
constexpr size_t WS_MOD = 1 * MiB;
constexpr size_t WS_ROPEM = 2 * MiB;
constexpr size_t WS_ROPEG = 2 * MiB + 262144;
constexpr size_t WS_SSKV = 3 * MiB, WS_SSQ = 3 * MiB + 524288;
constexpr size_t WS_DFTMC = 4 * MiB;
constexpr size_t WS_ST1 = 4 * MiB + 524288, WS_ST2 = 4 * MiB + 786432;
constexpr size_t WS_DFTM = 5 * MiB;
constexpr size_t WS_W = 21 * MiB;
constexpr size_t W_IN = 0, W_KR = 8 * MiB + 524288, W_T = 9 * MiB, W_UKV = 11 * MiB, W_UQ = 11 * MiB + 524288, W_FO = 12 * MiB, W_MO = 13 * MiB,
                 W_GO = 14 * MiB, W_O = 15 * MiB, W_1 = 17 * MiB, W_2 = 25 * MiB;
constexpr size_t WS_XC = 54 * MiB;
constexpr size_t WS_HB = 62 * MiB;
constexpr size_t WS_CKV = 98 * MiB, WS_CQ = 107 * MiB, WS_KG = 116 * MiB, WS_VG = 120 * MiB + 524288, WS_QG = 125 * MiB, WS_KR = 143 * MiB;
constexpr size_t WS_KN = 145 * MiB, WS_VM = 163 * MiB, WS_QM = 181 * MiB;
constexpr size_t WS_F = 208 * MiB, WS_AM = 226 * MiB;
constexpr size_t WS_GATE = 244 * MiB, WS_TF = 352 * MiB, WS_TFC = 384 * MiB, WS_U = 244 * MiB;
constexpr size_t WS_END = 388 * MiB;

constexpr int LDS_BYTES = 147456, RING_BYTES = 131072, MISC_OFF = RING_BYTES + 320;

struct Params {
    const float* in[25];
    float* out;
    unsigned char* ws;
    int ph_lo, ph_hi;
};
enum { I_X = 0, I_C, I_CTX, I_CCTX, I_WADA, I_BADA, I_WIN, I_BGATE, I_MQG, I_MKVG, I_WUQ, I_WUK, I_WUV, I_GQG, I_GKG, I_WFO, I_WMO, I_WGO, I_WO,
       I_LN1G, I_LN1B, I_W1, I_W2, I_LN2G, I_LN2B };

DI unsigned pk2(float lo, float hi) { f32x2 v = {lo, hi}; bf16x2_t b = __builtin_convertvector(v, bf16x2_t); return __builtin_bit_cast(unsigned, b); }
DI u32x4 pk8(const f32x4& a, const f32x4& b) { u32x4 w; w.x = pk2(a[0], a[1]); w.y = pk2(a[2], a[3]); w.z = pk2(b[0], b[1]); w.w = pk2(b[2], b[3]); return w; }
DI float bf2f(unsigned short h) { return __uint_as_float((unsigned)h << 16); }
DI void unpk8(const u32x4& w, float* f) {
    f[0] = __uint_as_float(w.x << 16); f[1] = __uint_as_float(w.x & 0xffff0000u); f[2] = __uint_as_float(w.y << 16); f[3] = __uint_as_float(w.y & 0xffff0000u);
    f[4] = __uint_as_float(w.z << 16); f[5] = __uint_as_float(w.z & 0xffff0000u); f[6] = __uint_as_float(w.w << 16); f[7] = __uint_as_float(w.w & 0xffff0000u);
}
DI float shx(float v, int m, int lane) { return __int_as_float(__builtin_amdgcn_ds_bpermute((lane ^ m) << 2, __float_as_int(v))); }
DI float wave_sum(float v, int lane) {
#pragma unroll
    for (int o = 1; o < 64; o <<= 1) v += shx(v, o, lane);
    return v;
}

#define XB_TMO      128
#define XB_XCNT(j)  (256  + 64 * (j))
#define XB_XSUB(j)  (1280 + 64 * (j))
#define XB_XGEN(j)  (2304 + 64 * (j))
#define XB_TOP      3328
#define XB_TOPGEN   3392
#define XB_SPIN_CAP (1u << 22)
DI unsigned xb_ld(unsigned* p)              { return __hip_atomic_load(p, __ATOMIC_RELAXED, __HIP_MEMORY_SCOPE_AGENT); }
DI unsigned xb_add(unsigned* p, unsigned v) { return __hip_atomic_fetch_add(p, v, __ATOMIC_RELAXED, __HIP_MEMORY_SCOPE_AGENT); }
DI unsigned xb_xcc_id() { return (unsigned)__builtin_amdgcn_s_getreg((3 << 11) | 20) & 0xFu; }
#define XB_SPIN(cond, bar) do { unsigned _sp = 0; while (cond) { __builtin_amdgcn_s_sleep(1); \
    if ((++_sp & 255u) == 0u) { if (xb_ld(&(bar)[XB_TMO])) break; if (_sp > XB_SPIN_CAP) { atomicAdd(&(bar)[XB_TMO], 1u); break; } } } } while (0)
struct XcdBarrier { unsigned* bar; unsigned x; volatile LAS unsigned* st; };
DI XcdBarrier xcd_barrier_post(unsigned* bar, volatile LAS unsigned* st) {
    XcdBarrier b; b.bar = bar; b.x = xb_xcc_id(); b.st = st;
    if (threadIdx.x == 0) (void)xb_add(&bar[XB_XCNT(b.x)], 1u);
    return b;
}
DI void xcd_barrier_complete(unsigned* bar, unsigned x, unsigned& nloc, unsigned& nx) {
    const unsigned G = gridDim.x * gridDim.y * gridDim.z;
    unsigned sum, cnt, mine, sp = 0u;
    for (;;) {
        sum = 0u; cnt = 0u; mine = 0u;
#pragma unroll
        for (unsigned j = 0; j < 16; ++j) { const unsigned c = xb_ld(&bar[XB_XCNT(j)]); sum += c; cnt += (c > 0u) ? 1u : 0u; mine = (j == x) ? c : mine; }
        if (sum == G) break;
        __builtin_amdgcn_s_sleep(1);
        if ((++sp & 255u) == 0u) { if (xb_ld(&bar[XB_TMO])) break; if (sp > XB_SPIN_CAP) { atomicAdd(&bar[XB_TMO], 1u); break; } }
    }
    nloc = mine > 0u ? mine : 1u; nx = cnt > 0u ? cnt : 1u;
}
DI void xcd_barrier(const XcdBarrier& b, const int tid) {
    asm volatile("s_waitcnt vmcnt(0)" ::: "memory");
    __syncthreads();
    if (tid == 0) {
        unsigned* bar = b.bar;
        __builtin_amdgcn_s_waitcnt(0);
        unsigned nloc = b.st[0], nx = b.st[1];
        const unsigned old = xb_add(&bar[XB_XSUB(b.x)], 1u);
        const unsigned gen = old / nloc;
        if (old + 1u == (gen + 1u) * nloc) {
            __builtin_amdgcn_fence(__ATOMIC_RELEASE, "agent");
            asm volatile("s_waitcnt vmcnt(0)" ::: "memory");
            const unsigned og = xb_add(&bar[XB_TOP], 1u);
            const unsigned tg = og / nx;
            if (og + 1u == (tg + 1u) * nx) xb_add(&bar[XB_TOPGEN], 1u);
            else XB_SPIN(xb_ld(&bar[XB_TOPGEN]) == tg, bar);
            __builtin_amdgcn_fence(__ATOMIC_ACQUIRE, "agent");
            xb_add(&bar[XB_XGEN(b.x)], 1u);
            asm volatile("s_waitcnt vmcnt(0)" ::: "memory");
        } else {
            XB_SPIN(xb_ld(&bar[XB_XGEN(b.x)]) == gen, bar);
            __builtin_amdgcn_fence(__ATOMIC_ACQUIRE, "agent");
            asm volatile("s_waitcnt vmcnt(0)" ::: "memory");
        }
    }
    __syncthreads();
}

namespace pg8 {
constexpr int BM = 256, BK = 64, HALF = 128, HTB = HALF * BK * 2;
DI int lds_byte(int r, int c) { const int st = (r >> 4) * 2 + (c >> 5), rr = r & 15, cc = c & 31, ob = rr * 64 + cc * 2; return st * 1024 + (ob ^ (((ob >> 9) & 1) << 5)); }
DI void stage_rc(int b, int& R, int& C) { const int st = b / 1024, sb = b % 1024, swz = sb ^ (((sb >> 9) & 1) << 5); R = (st >> 1) * 16 + swz / 64; C = (st & 1) * 32 + (swz % 64) / 2; }
DI int perm32(int rho) { const int n = rho >> 4, i = rho & 15; return 8 * (i >> 2) + 4 * n + (i & 3); }

struct Unit { const char* A; const char* B; int job, pm, pn, z, seg; bool last; };
struct JobD { const char* A; const char* B; int nM, nN, nZ; long Az, Bz; };
DI void decode(const JobD& j, int t, long tileBytes, int jobid, Unit& u) {
    const int nMt = j.nM * j.nZ, nwg = nMt * j.nN;
    int wg; { const int q = nwg >> 3, r = nwg & 7, xcd = t & 7, off = t >> 3; wg = (xcd < r ? xcd * (q + 1) : r * (q + 1) + (xcd - r) * q) + off; }
    const int nig = 8 * j.nN, gid = wg / nig, fm = gid * 8, gsz = (nMt - fm) < 8 ? (nMt - fm) : 8;
    const int rem = wg - gid * nig, pn = rem / gsz, pmt = fm + (rem - pn * gsz);
    const int z = pmt / j.nM, pm = pmt - z * j.nM;
    u.A = j.A + (long)z * j.Az + (long)pm * tileBytes; u.B = j.B + (long)z * j.Bz + (long)pn * tileBytes;
    u.job = jobid; u.pm = pm; u.pn = pn; u.z = z; u.seg = 0; u.last = true;
}
struct Sched2 {
    JobD j0, j1; int n0, total, G, c; long tileBytes;
    DI bool next(int i, Unit& u) const {
        const long L = (long)i * G + c; if (L >= total) return false;
        if ((int)L < n0) decode(j0, (int)L, tileBytes, 0, u); else decode(j1, (int)L - n0, tileBytes, 1, u);
        return true;
    }
};
struct Sched3 {
    JobD j; const char* A1; const char* A2; const char* B1; const char* B2; int ntiles, G, c; long tileBytes;
    DI bool next(int i, Unit& u) const {
        const int ti = i / 3, seg = i - ti * 3; const long L = (long)ti * G + c; if (L >= ntiles) return false;
        decode(j, (int)L, tileBytes, 0, u);
        if (seg == 1) { u.A = A1 + (u.A - j.A); u.B = B1 + (u.B - j.B); }
        if (seg == 2) { u.A = A2 + (u.A - j.A); u.B = B2 + (u.B - j.B); }
        u.seg = seg; u.last = (seg == 2);
        return true;
    }
};

typedef f32x4 Acc[2][2][4][2];
template <int PITCH = 0, class Epi, class Sched>
DI void gemm_phase(LAS unsigned char* lds, const int K_, const Sched& S, const Epi& E, const int tid_in) {
    int Kq = K_; asm volatile("" : "+s"(Kq)); const int K = Kq & 0x1fc0;
    int tid_ = tid_in;
#ifndef NO_OPQ_TID
    asm volatile("" : "+v"(tid_));
#endif
    const int tid = tid_ & 511, wid = __builtin_amdgcn_readfirstlane(tid >> 6), lane = tid & 63, wr = wid >> 2, wc = wid & 3, fr = lane & 15, fq = lane >> 4;
    const int nt = K / BK;
    unsigned voffA[2], voffB[2];
#pragma unroll
    for (int i = 0; i < 2; ++i) { int R, C; stage_rc(tid * 16 + i * 8192, R, C); const int Rb = (R & ~31) + perm32(R & 31);
        voffA[i] = (unsigned)(R * (PITCH ? PITCH : K) + C) * 2u; voffB[i] = (unsigned)(Rb * (PITCH ? PITCH : K) + C) * 2u; }
    const size_t kstep = (size_t)(BK * 2);
    const size_t hstep = (size_t)HALF * (PITCH ? PITCH : K) * 2;
    const unsigned ldsw = (unsigned)wid * 1024u;
    const int aoff = lds_byte(wr * 64 + fr, fq * 8), boff = lds_byte(wc * 32 + fr, fq * 8);
#define PG8_SA(b, h) (((b) * 2 + (h)) * HTB)
#define PG8_SB(b, h) ((4 + (b) * 2 + (h)) * HTB)
#define PG8_STAGE(bufoff, gbase, voff) do { _Pragma("unroll") for (int _i = 0; _i < 2; ++_i) \
        __builtin_amdgcn_global_load_lds((const unsigned*)((const char*)(gbase) + (voff)[_i]), (LAS unsigned*)(lds + (bufoff) + ldsw + _i * 8192), 16, 0, 0); } while (0)
#define PG8_LDA(dst, b, h) do { _Pragma("unroll") for (int m = 0; m < 4; ++m) _Pragma("unroll") for (int k = 0; k < 2; ++k) dst[m][k] = *(const LAS bf16x8*)(lds + PG8_SA(b, h) + aoff + m * 2048 + k * 1024); } while (0)
#define PG8_LDB(dst, b, h) do { _Pragma("unroll") for (int n = 0; n < 2; ++n) _Pragma("unroll") for (int k = 0; k < 2; ++k) dst[n][k] = *(const LAS bf16x8*)(lds + PG8_SB(b, h) + boff + n * 2048 + k * 1024); } while (0)
#define PG8_MMA(ai, bj, At, Bt) do { __builtin_amdgcn_s_setprio(1); _Pragma("unroll") for (int m = 0; m < 4; ++m) _Pragma("unroll") for (int n = 0; n < 2; ++n) _Pragma("unroll") for (int k = 0; k < 2; ++k) \
        acc[ai][bj][m][n] = __builtin_amdgcn_mfma_f32_16x16x32_bf16(Bt[n][k], At[m][k], acc[ai][bj][m][n], 0, 0, 0); __builtin_amdgcn_s_setprio(0); } while (0)
#define PG8_WAIT_V(n) asm volatile("s_waitcnt vmcnt(" #n ")" ::: "memory")
#define PG8_WAIT_L(n) asm volatile("s_waitcnt lgkmcnt(" #n ")" ::: "memory")
#define PG8_BAR __builtin_amdgcn_s_barrier()
#define PG8_SCHED __builtin_amdgcn_sched_barrier(0)
    Unit cur, nxt; int ui = 0;
    if (!S.next(0, cur)) return;
    Acc acc;
#pragma unroll
    for (int a = 0; a < 2; ++a)
#pragma unroll
        for (int b = 0; b < 2; ++b)
#pragma unroll
            for (int m = 0; m < 4; ++m)
#pragma unroll
                for (int n = 0; n < 2; ++n) acc[a][b][m][n] = (f32x4){0.f, 0.f, 0.f, 0.f};
    bf16x8 At[4][2], B0[2][2], B1[2][2];
    const char* cA = cur.A; const char* cB = cur.B;
    PG8_STAGE(PG8_SB(0, 0), cB, voffB); PG8_STAGE(PG8_SB(0, 1), cB + hstep, voffB); PG8_STAGE(PG8_SA(0, 0), cA, voffA); PG8_STAGE(PG8_SA(0, 1), cA + hstep, voffA);
    if (wr == 1) PG8_BAR;
    PG8_WAIT_V(2); PG8_BAR;
    PG8_STAGE(PG8_SB(1, 0), cB + kstep, voffB); PG8_STAGE(PG8_SA(1, 0), cA + kstep, voffA); PG8_STAGE(PG8_SB(1, 1), cB + hstep + kstep, voffB);
    PG8_WAIT_V(6); PG8_BAR;
    for (;;) {
        const bool has_next = S.next(ui + 1, nxt);
        const char* nA = has_next ? nxt.A : cA; const char* nB = has_next ? nxt.B : cB;
        for (int t = 0; t < nt; t += 2) {
            const bool last = (t == nt - 2);
            const char* a1 = cA + (size_t)(t + 1) * kstep;
            const char* a2 = last ? nA : cA + (size_t)(t + 2) * kstep; const char* b2 = last ? nB : cB + (size_t)(t + 2) * kstep;
            const char* a3 = a2 + kstep; const char* b3 = b2 + kstep;
            PG8_LDB(B0, 0, 0); PG8_LDB(B1, 0, 1); PG8_SCHED; PG8_LDA(At, 0, 0); PG8_STAGE(PG8_SA(1, 1), a1 + hstep, voffA);
            PG8_WAIT_V(8); PG8_WAIT_L(0); PG8_BAR; PG8_MMA(0, 0, At, B0); PG8_MMA(0, 1, At, B1); PG8_BAR; PG8_SCHED;
            PG8_LDA(At, 0, 1); PG8_STAGE(PG8_SB(0, 0), b2, voffB); PG8_STAGE(PG8_SB(0, 1), b2 + hstep, voffB); PG8_STAGE(PG8_SA(0, 0), a2, voffA);
            PG8_WAIT_V(8); PG8_WAIT_L(0); PG8_BAR; PG8_MMA(1, 0, At, B0); PG8_MMA(1, 1, At, B1); PG8_BAR; PG8_SCHED;
            PG8_LDB(B0, 1, 0); PG8_LDB(B1, 1, 1); PG8_SCHED; PG8_LDA(At, 1, 0); PG8_STAGE(PG8_SA(0, 1), a2 + hstep, voffA);
            PG8_WAIT_V(8); PG8_WAIT_L(0); PG8_BAR; PG8_MMA(0, 0, At, B0); PG8_MMA(0, 1, At, B1); PG8_BAR; PG8_SCHED;
            PG8_LDA(At, 1, 1); PG8_STAGE(PG8_SB(1, 0), b3, voffB); PG8_STAGE(PG8_SB(1, 1), b3 + hstep, voffB); PG8_STAGE(PG8_SA(1, 0), a3, voffA);
            PG8_WAIT_V(8); PG8_WAIT_L(0); PG8_BAR; PG8_MMA(1, 0, At, B0); PG8_MMA(1, 1, At, B1); PG8_BAR; PG8_SCHED;
        }
        if (wr == 0) PG8_BAR;
        E(acc, cur, wr, wc, fr, fq);
        if (!has_next) break;
        if (cur.last) {
#pragma unroll
            for (int a = 0; a < 2; ++a)
#pragma unroll
                for (int b = 0; b < 2; ++b)
#pragma unroll
                    for (int m = 0; m < 4; ++m)
#pragma unroll
                        for (int n = 0; n < 2; ++n) acc[a][b][m][n] = (f32x4){0.f, 0.f, 0.f, 0.f};
        }
        cur = nxt; cA = nA; cB = nB; ++ui;
        if (wr == 1) PG8_BAR;
    }
    PG8_WAIT_V(0);
    PG8_BAR;
#undef PG8_SA
#undef PG8_SB
#undef PG8_STAGE
#undef PG8_LDA
#undef PG8_LDB
#undef PG8_MMA
#undef PG8_WAIT_V
#undef PG8_WAIT_L
#undef PG8_BAR
#undef PG8_SCHED
}
}
using pg8::Acc; using pg8::Unit;

struct Frame {
    const Params* P;
    unsigned char* ws;
    LAS unsigned char* lds;
    int tid, lane, wave, G, bid, vcu;
    int l;
    int zo;
};
DI const float* pin(const Frame& F, int idx) { return F.P->in[idx + F.zo]; }
DI const float* inl(const Frame& F, int idx, size_t per_layer) { return pin(F, idx) + (size_t)F.l * per_layer; }
DI const float* modp(const Frame& F, int l, int mr, int which) { return (const float*)(F.ws + WS_MOD) + ((size_t)(l * 9 + mr) * 6 + which) * 1024; }
DI int modrow_of_tile(int row0) { return row0 < ML ? (row0 >> 11) : 8; }
DI float* xrow_ptr(const Frame& F, int row) { return row < ML ? F.P->out + (size_t)row * D : (float*)(F.ws + WS_XC) + (size_t)(row - ML) * D; }
DI const float* xin_ptr(const Frame& F, int row) {
    if (F.l == 0) return row < ML ? pin(F, I_X) + (size_t)row * D : pin(F, I_CTX) + (size_t)(row - ML) * D;
    return xrow_ptr(F, row);
}

#define EPI_ROWS(ai, m) (128 * (ai) + 64 * wr + 16 * (m) + fr)
#define EPI_COL8(bj) (128 * (bj) + 32 * wc + 8 * fq)
#define FOR_AI_M _Pragma("unroll") for (int ai = 0; ai < 2; ++ai) _Pragma("unroll") for (int m = 0; m < 4; ++m)
#define ROW_FENCE asm volatile("" ::: "memory")

struct EpiG1 {
    const Frame& F;
    DI void operator()(Acc& acc, const Unit& u, int wr, int wc, int fr, int fq) const {
        unsigned char* ws = F.ws;
        if (u.job == 1) {
            bf16_t* base; int ld;
            if (u.pn < 64) { base = (bf16_t*)(ws + WS_TF) + (size_t)(u.pn >> 3) * 1024 * 2048 + (u.pn & 7) * 256; ld = 2048; }
            else { base = (bf16_t*)(ws + WS_TFC) + (size_t)(u.pn - 64) * 1024 * 256; ld = 256; }
            FOR_AI_M { const int r = u.pm * 256 + EPI_ROWS(ai, m);
#pragma unroll
                for (int bj = 0; bj < 2; ++bj) *(u32x4*)(base + (size_t)r * ld + EPI_COL8(bj)) = pk8(acc[ai][bj][m][0], acc[ai][bj][m][1]); }
            return;
        }
        const int row0 = u.pm * 256;
        if (u.pn <= 1) {
            bf16_t* dst = (bf16_t*)(ws + (u.pn == 0 ? WS_CKV : WS_CQ)); float* ss = (float*)(ws + (u.pn == 0 ? WS_SSKV : WS_SSQ));
            FOR_AI_M { const int r = row0 + EPI_ROWS(ai, m); float s = 0.f;
#pragma unroll
                for (int bj = 0; bj < 2; ++bj) { const f32x4 a = acc[ai][bj][m][0], b = acc[ai][bj][m][1];
                    s += (a[0] * a[0] + a[1] * a[1]) + (a[2] * a[2] + a[3] * a[3]) + (b[0] * b[0] + b[1] * b[1]) + (b[2] * b[2] + b[3] * b[3]);
                    *(u32x4*)(dst + (size_t)r * 256 + EPI_COL8(bj)) = pk8(a, b); }
                s += shx(s, 16, fr + 16 * fq); s += shx(s, 32, fr + 16 * fq);
                if (fq == 0) ss[(size_t)r * 4 + wc] = s; }
            return;
        }
        if (u.pn >= 5) {
            const int cb = (u.pn - 5) * 256; const float* bg = inl(F, I_BGATE, 3072) + cb; bf16_t* dst = (bf16_t*)(ws + WS_GATE) + cb;
            f32x4 bv[2][2];
#pragma unroll
            for (int bj = 0; bj < 2; ++bj) { bv[bj][0] = *(const f32x4*)(bg + EPI_COL8(bj)); bv[bj][1] = *(const f32x4*)(bg + EPI_COL8(bj) + 4); }
            FOR_AI_M { const int r = row0 + EPI_ROWS(ai, m);
#pragma unroll
                for (int bj = 0; bj < 2; ++bj) { f32x4 a = acc[ai][bj][m][0] + bv[bj][0], b = acc[ai][bj][m][1] + bv[bj][1];
#pragma unroll
                    for (int e = 0; e < 4; ++e) { a[e] = __builtin_amdgcn_rcpf(1.f + __builtin_amdgcn_exp2f(-1.4426950408889634f * a[e])); b[e] = __builtin_amdgcn_rcpf(1.f + __builtin_amdgcn_exp2f(-1.4426950408889634f * b[e])); }
                    *(u32x4*)(dst + (size_t)r * 3072 + EPI_COL8(bj)) = pk8(a, b); } }
            return;
        }
        const bool is_q = (u.pn >= 3);
        const bool is_v = (!is_q) && (wc >= 2);
        const float* gain = is_q ? inl(F, I_GQG, 64) : inl(F, I_GKG, 64);
        f32x4 gv[2][2];
#pragma unroll
        for (int bj = 0; bj < 2; ++bj) { gv[bj][0] = *(const f32x4*)(gain + 32 * bj + 8 * fq); gv[bj][1] = *(const f32x4*)(gain + 32 * bj + 8 * fq + 4); }
        bf16_t* dst; int ld, colb;
        if (is_q) { dst = (bf16_t*)(ws + WS_QG); ld = 512; colb = ((u.pn - 3) * 4 + wc) * 64; }
        else if (!is_v) { dst = (bf16_t*)(ws + WS_KG); ld = 128; colb = wc * 64; }
        else { dst = (bf16_t*)(ws + WS_VG); ld = 128; colb = (wc - 2) * 64; }
        const bool rope = (row0 < ML);
        const float* rg = (const float*)(ws + WS_ROPEG);
        const float qs = is_q ? QS_GQA : 1.f;
        FOR_AI_M { const int r = row0 + EPI_ROWS(ai, m);
            f32x4 x[2][2];
#pragma unroll
            for (int bj = 0; bj < 2; ++bj) { x[bj][0] = acc[ai][bj][m][0]; x[bj][1] = acc[ai][bj][m][1]; }
            if (!is_v) {
                float s = 0.f;
#pragma unroll
                for (int bj = 0; bj < 2; ++bj)
#pragma unroll
                    for (int n = 0; n < 2; ++n) s += (x[bj][n][0] * x[bj][n][0] + x[bj][n][1] * x[bj][n][1]) + (x[bj][n][2] * x[bj][n][2] + x[bj][n][3] * x[bj][n][3]);
                s += shx(s, 16, fr + 16 * fq); s += shx(s, 32, fr + 16 * fq);
                const float rstd = 1.f / sqrtf(s * (1.f / 64.f) + EPS);
#pragma unroll
                for (int bj = 0; bj < 2; ++bj)
#pragma unroll
                    for (int n = 0; n < 2; ++n) x[bj][n] = x[bj][n] * rstd * gv[bj][n];
                if (rope) {
                    const float* rr = rg + (size_t)(r & 2047) * 64 + 8 * fq;
#pragma unroll
                    for (int n = 0; n < 2; ++n) { const f32x4 cs = *(const f32x4*)(rr + 4 * n), sn = *(const f32x4*)(rr + 32 + 4 * n);
                        const f32x4 x1 = x[0][n], x2 = x[1][n]; x[0][n] = x1 * cs - x2 * sn; x[1][n] = x1 * sn + x2 * cs; }
                }
#pragma unroll
                for (int bj = 0; bj < 2; ++bj)
#pragma unroll
                    for (int n = 0; n < 2; ++n) x[bj][n] = x[bj][n] * qs;
            }
#pragma unroll
            for (int bj = 0; bj < 2; ++bj) *(u32x4*)(dst + (size_t)r * ld + colb + 32 * bj + 8 * fq) = pk8(x[bj][0], x[bj][1]);
            if (m & 1) ROW_FENCE;
        }
    }
};

struct EpiG2 {
    const Frame& F;
    DI void operator()(Acc& acc, const Unit& u, int wr, int wc, int fr, int fq) const {
        unsigned char* ws = F.ws; const int row0 = u.pm * 256;
        const float* ss = (const float*)(ws + (u.job == 0 ? WS_SSKV : WS_SSQ));
        bf16_t* dst; int ld; float sc = 1.f;
        if (u.job == 0) { dst = (bf16_t*)(ws + (u.pn < 2 ? WS_KN : WS_VM)) + (u.pn & 1) * 256; ld = 512; }
        else { dst = (bf16_t*)(ws + WS_QM); ld = 768; sc = QS_MLA; }
        const bool ropet = (u.job == 1 && u.pn == 2);
        const bool rope = ropet && row0 < ML;
        const float* rm = (const float*)(ws + WS_ROPEM) + 4 * fq;
        int colv[2];
#pragma unroll
        for (int bj = 0; bj < 2; ++bj) {
            if (u.job == 0) colv[bj] = EPI_COL8(bj);
            else if (!ropet) { const int c = u.pn * 256 + EPI_COL8(bj); colv[bj] = (c >> 6) * 96 + (c & 63); }
            else { const int c = EPI_COL8(bj); colv[bj] = (c >> 5) * 96 + 64 + (c & 31); }
        }
        FOR_AI_M { const int r = row0 + EPI_ROWS(ai, m);
            const f32x4 s4 = *(const f32x4*)(ss + (size_t)r * 4);
            const float rstd = sc * __builtin_amdgcn_rsqf(((s4[0] + s4[1]) + (s4[2] + s4[3])) * (1.f / 256.f) + EPS);
            f32x4 cs = {1.f, 1.f, 1.f, 1.f}, sn = {0.f, 0.f, 0.f, 0.f};
            if (rope) { const float* rr = rm + (size_t)(r & 2047) * 32; cs = *(const f32x4*)rr; sn = *(const f32x4*)(rr + 16); }
#pragma unroll
            for (int bj = 0; bj < 2; ++bj) {
                const f32x4 x1 = acc[ai][bj][m][0] * rstd, x2 = acc[ai][bj][m][1] * rstd;
                f32x4 a = x1, b = x2;
                if (ropet) { a = x1 * cs - x2 * sn; b = x1 * sn + x2 * cs; }
                *(u32x4*)(dst + (size_t)r * ld + colv[bj]) = pk8(a, b);
            }
            ROW_FENCE;
        }
    }
};

struct EpiDft {
    bf16_t* dst; int zrows, ld;
    DI void operator()(Acc& acc, const Unit& u, int wr, int wc, int fr, int fq) const {
        FOR_AI_M { const int r = u.z * zrows + u.pm * 256 + EPI_ROWS(ai, m);
#pragma unroll
            for (int bj = 0; bj < 2; ++bj) *(u32x4*)(dst + (size_t)r * ld + u.pn * 256 + EPI_COL8(bj)) = pk8(acc[ai][bj][m][0], acc[ai][bj][m][1]); }
    }
};

struct EpiG3 {
    const Frame& F;
    DI void operator()(Acc& acc, const Unit& u, int wr, int wc, int fr, int fq) const {
        const bf16_t* gate = (const bf16_t*)(F.ws + WS_GATE); bf16_t* Y = (bf16_t*)(F.ws + WS_HB);
        const int row0 = u.pm * 256, col0 = u.pn * 256;
        const int s1 = u.seg < 2 ? u.seg + 1 : u.seg;
#pragma unroll
        for (int aim = 0; aim < 4; ++aim) { const int ai = aim >> 1, mb = (aim & 1) * 2;
            u32x4 ga[4][2], gb[4][2];
#pragma unroll
            for (int m = mb; m < mb + 2; ++m)
#pragma unroll
                for (int bj = 0; bj < 2; ++bj) { const size_t o = (size_t)(row0 + EPI_ROWS(ai, m)) * 3072 + col0 + EPI_COL8(bj);
                    ga[m][bj] = *(const u32x4*)(gate + o + u.seg * 1024); if (u.seg < 2) gb[m][bj] = *(const u32x4*)(gate + o + s1 * 1024); }
#pragma unroll
            for (int m = mb; m < mb + 2; ++m) { const int r = row0 + EPI_ROWS(ai, m);
#pragma unroll
                for (int bj = 0; bj < 2; ++bj) {
                    float g0[8]; unpk8(ga[m][bj], g0);
                    if (u.seg < 2) { float g1[8]; unpk8(gb[m][bj], g1);
#pragma unroll
                        for (int e = 0; e < 8; ++e) g0[e] = g0[e] * __builtin_amdgcn_rcpf(fmaxf(g1[e], 1e-20f)); }
#pragma unroll
                    for (int e = 0; e < 4; ++e) { acc[ai][bj][m][0][e] *= g0[e]; acc[ai][bj][m][1][e] *= g0[4 + e]; }
                    if (u.seg == 2) *(u32x4*)(Y + (size_t)r * 1024 + col0 + EPI_COL8(bj)) = pk8(acc[ai][bj][m][0], acc[ai][bj][m][1]);
                }
            }
            ROW_FENCE;
        }
    }
};

struct EpiRes {
    const Frame& F; int which; bool from_input;
    int lnmode;
    DI void operator()(Acc& acc, const Unit& u, int wr, int wc, int fr, int fq) const {
        const int row0 = u.pm * 256, col0 = u.pn * 256;
        const float* g = modp(F, F.l, modrow_of_tile(row0), which) + col0;
        const bool ln = (lnmode != 0) && row0 < ML;
        const float* st = (const float*)(F.ws + (lnmode == 1 ? WS_ST1 : WS_ST2));
        const float* lg = lnmode == 1 ? pin(F, I_LN1G) + F.l * 1024 : pin(F, I_LN2G) + (F.l > 0 ? F.l - 1 : 0) * 1024;
        const float* lb = lnmode == 1 ? pin(F, I_LN1B) + F.l * 1024 : pin(F, I_LN2B) + (F.l > 0 ? F.l - 1 : 0) * 1024;
        {
#pragma unroll
            for (int bj = 0; bj < 2; ++bj) {
                f32x4 gv0 = *(const f32x4*)(g + EPI_COL8(bj)), gv1 = *(const f32x4*)(g + EPI_COL8(bj) + 4);
                f32x4 c0 = {0.f, 0.f, 0.f, 0.f}, c1 = {0.f, 0.f, 0.f, 0.f};
                if (ln) { c0 = *(const f32x4*)(lb + col0 + EPI_COL8(bj)) * ALPHA; c1 = *(const f32x4*)(lb + col0 + EPI_COL8(bj) + 4) * ALPHA; }
#pragma unroll
                for (int ai = 0; ai < 2; ++ai)
#pragma unroll
                    for (int m = 0; m < 4; ++m) { acc[ai][bj][m][0] = acc[ai][bj][m][0] * gv0 + c0; acc[ai][bj][m][1] = acc[ai][bj][m][1] * gv1 + c1; }
            }
        }
        f32x4 la[2][2];
#pragma unroll
        for (int bj = 0; bj < 2; ++bj) {
#pragma unroll
            for (int n = 0; n < 2; ++n) la[bj][n] = (f32x4){ALPHA, ALPHA, ALPHA, ALPHA};
            if (ln) {
#pragma unroll
                for (int n = 0; n < 2; ++n) la[bj][n] = *(const f32x4*)(lg + col0 + EPI_COL8(bj) + 4 * n) * ALPHA; } }
        const float* xib = (from_input ? xin_ptr(F, row0) : xrow_ptr(F, row0)) + col0; float* xob = xrow_ptr(F, row0) + col0;
        int oz_ = 0; asm volatile("" : "+v"(oz_));
#pragma unroll
        for (int aim = 0; aim < 8; ++aim) { const int ai = aim >> 2, m = aim & 3;
            f32x4 xa[2][2]; f32x2 sv = {0.f, 1.f};
            if (ln) sv = *(const f32x2*)(st + 2 * (size_t)(row0 + EPI_ROWS(ai, m) + oz_));
#pragma unroll
            for (int bj = 0; bj < 2; ++bj) { const float* p = xib + (size_t)(EPI_ROWS(ai, m) + oz_) * D + EPI_COL8(bj); xa[bj][0] = *(const f32x4*)p; xa[bj][1] = *(const f32x4*)(p + 4); }
#pragma unroll
            for (int bj = 0; bj < 2; ++bj) { float* p = xob + (size_t)(EPI_ROWS(ai, m) + oz_) * D + EPI_COL8(bj);
                *(f32x4*)p = ((xa[bj][0] - sv[0]) * sv[1]) * la[bj][0] + acc[ai][bj][m][0];
                *(f32x4*)(p + 4) = ((xa[bj][1] - sv[0]) * sv[1]) * la[bj][1] + acc[ai][bj][m][1]; }
            if (m & 1) ROW_FENCE;
        }
    }
};

struct EpiSlab {
    float* slab;
    DI void operator()(Acc& acc, const Unit& u, int wr, int wc, int fr, int fq) const {
        FOR_AI_M { const int r = u.z * MC + u.pm * 256 + EPI_ROWS(ai, m);
#pragma unroll
            for (int bj = 0; bj < 2; ++bj) { float* o = slab + (size_t)r * 1024 + u.pn * 256 + EPI_COL8(bj);
                *(f32x4*)o = acc[ai][bj][m][0]; *(f32x4*)(o + 4) = acc[ai][bj][m][1]; } }
    }
};

struct EpiW1 {
    const Frame& F;
    DI void operator()(Acc& acc, const Unit& u, int wr, int wc, int fr, int fq) const {
        bf16_t* U = (bf16_t*)(F.ws + WS_U);
        FOR_AI_M { const int r = u.pm * 256 + EPI_ROWS(ai, m);
#pragma unroll
            for (int bj = 0; bj < 2; ++bj) { f32x4 a = acc[ai][bj][m][0], b = acc[ai][bj][m][1];
#pragma unroll
                for (int e = 0; e < 4; ++e) { const float x = fmaxf(a[e], 0.f), y = fmaxf(b[e], 0.f); a[e] = x * x; b[e] = y * y; }
                *(u32x4*)(U + (size_t)r * DFF + u.pn * 256 + EPI_COL8(bj)) = pk8(a, b); } }
    }
};

#define MFMA32(a, b, c) __builtin_amdgcn_mfma_f32_32x32x16_bf16((a), (b), (c), 0, 0, 0)
constexpr int ATT_KBUF = 14336;
constexpr int ATT_KR = 9216, ATT_VB = 28672, ATT_VBUF = 8192, ATT_OST = 57344;
template <int KIND>
DI void attn_unit(const Frame& F, int qrow0, int head, int ctx_row0, int lat_row0, int ntiles) {
    constexpr int ND = KIND == 0 ? 6 : 4;
    unsigned char* ws = F.ws; LAS unsigned char* lds = F.lds;
    int tid_ = F.tid; asm volatile("" : "+v"(tid_));
    const int tid = tid_ & 511, lane = tid & 63, w = __builtin_amdgcn_readfirstlane(tid >> 6), r32 = lane & 31, h5 = lane >> 5;
    const bf16_t *Kp, *Vp, *Qp; bf16_t* Op; int ldk, ldq, ldo;
    if (KIND == 0) { Kp = (const bf16_t*)(ws + WS_KN) + head * 64; Vp = (const bf16_t*)(ws + WS_VM) + head * 64; ldk = 512; Qp = (const bf16_t*)(ws + WS_QM) + head * 96; ldq = 768;
                     Op = (bf16_t*)(ws + WS_AM) + head * 64; ldo = 512; }
    else { Kp = (const bf16_t*)(ws + WS_KG) + (head >> 2) * 64; Vp = (const bf16_t*)(ws + WS_VG) + (head >> 2) * 64; ldk = 128; Qp = (const bf16_t*)(ws + WS_QG) + head * 64; ldq = 512;
           Op = (bf16_t*)(ws + WS_QG) + head * 64; ldo = 512; }
    const bf16_t* Krp = (const bf16_t*)(ws + WS_KR);
    bf16x8 qf[ND];
    { const bf16_t* qr = Qp + (size_t)(qrow0 + 32 * w + r32) * ldq + 8 * h5;
#pragma unroll
      for (int ds = 0; ds < ND; ++ds) qf[ds] = *(const bf16x8*)(qr + 16 * ds); }
    const int skey = tid >> 3, sch = tid & 7;
    const int skey_r = (tid & 255) >> 2, sch_r = tid & 3;
    const unsigned kdst = skey * 144 + sch * 16;
    const unsigned vdst = (sch >> 2) * 4096 + skey * 64 + (sch & 3) * 16;
    const unsigned rdst = ATT_KR + skey_r * 80 + sch_r * 16;
    u32x4 kreg, vreg, rreg;
#define ATT_KEYROW(t) ((t) < 4 ? ctx_row0 + 64 * (t) : lat_row0 + 64 * ((t) - 4))
    const unsigned kbase = r32 * 144 + h5 * 16, rbase = ATT_KR + r32 * 80 + h5 * 16;
    const unsigned voff = (4 * h5 + ((lane & 15) >> 2)) * 64 + ((lane >> 4) & 1) * 32 + (lane & 3) * 8;
    float mref = 0.f, lsum = 0.f;
    f32x16 o0, o1;
#pragma unroll
    for (int i = 0; i < 16; ++i) { o0[i] = 0.f; o1[i] = 0.f; }
#define ATT_QK1(S, buf, kb, C) do { LAS unsigned char* kq_ = lds + (buf) * ATT_KBUF + (kb) * 32 * 144; LAS unsigned char* kr_ = lds + (buf) * ATT_KBUF + (kb) * 32 * 80; \
        bf16x8 kf_[ND]; \
        _Pragma("unroll") for (int ds = 0; ds < ND; ++ds) kf_[ds] = ds < 4 ? *(const LAS bf16x8*)(kq_ + kbase + ds * 32) : *(const LAS bf16x8*)(kr_ + rbase + (ds - 4) * 32); \
        _Pragma("unroll") for (int ds = 0; ds < ND; ++ds) { if (ds == 0) S = MFMA32(kf_[0], qf[0], C); else S = MFMA32(kf_[ds], qf[ds], S); } } while (0)
#define ATT_QKM(S0, S1, buf, C) do { ATT_QK1(S0, buf, 0, C); ATT_QK1(S1, buf, 1, C); } while (0)
#define ATT_VFRAG(dst, vb, kb) do { \
        _Pragma("unroll") for (int s = 0; s < 2; ++s) _Pragma("unroll") for (int db = 0; db < 2; ++db) { \
            const unsigned a_ = voff + db * 4096 + (32 * (kb) + 16 * s) * 64; \
            const s16x4 lo = __builtin_bit_cast(s16x4, __builtin_amdgcn_ds_read_tr16_b64_v4i16((LAS s16x4*)((vb) + a_))); \
            const s16x4 hi = __builtin_bit_cast(s16x4, __builtin_amdgcn_ds_read_tr16_b64_v4i16((LAS s16x4*)((vb) + a_ + 512))); \
            dst[s][db] = __builtin_shufflevector(lo, hi, 0, 1, 2, 3, 4, 5, 6, 7); } } while (0)
#define ATT_PV(PF, vb) do { \
        { bf16x8 va[2][2]; ATT_VFRAG(va, vb, 0); \
          _Pragma("unroll") for (int s = 0; s < 2; ++s) { o0 = MFMA32(va[s][0], PF[0][s], o0); o1 = MFMA32(va[s][1], PF[0][s], o1); } } \
        { bf16x8 vb2[2][2]; ATT_VFRAG(vb2, vb, 1); \
          _Pragma("unroll") for (int s = 0; s < 2; ++s) { o0 = MFMA32(vb2[s][0], PF[1][s], o0); o1 = MFMA32(vb2[s][1], PF[1][s], o1); } } } while (0)
    bf16x8 pfa[2][2], pfb[2][2];
    f32x16 s0, s1, n0, n1;
#define ATT_LOADK2(t, KR_, RR_) do { const int kr_ = ATT_KEYROW(t); KR_ = *(const u32x4*)(Kp + (size_t)(kr_ + skey) * ldk + sch * 8); \
        if (KIND == 0 && tid < 256) RR_ = *(const u32x4*)(Krp + (size_t)(kr_ + skey_r) * 32 + sch_r * 8); } while (0)
#define ATT_LOADV2(t, VR_) do { const int kr_ = ATT_KEYROW(t); VR_ = *(const u32x4*)(Vp + (size_t)(kr_ + skey) * ldk + sch * 8); } while (0)
#define ATT_STOREK2(buf, KR_, RR_) do { LAS unsigned char* b_ = lds + (buf) * ATT_KBUF; *(LAS u32x4*)(b_ + kdst) = KR_; if (KIND == 0 && tid < 256) *(LAS u32x4*)(b_ + rdst) = RR_; } while (0)
#define ATT_STOREV2(vsl, VR_) do { *(LAS u32x4*)(lds + ATT_VB + (vsl) + vdst) = VR_; } while (0)
#define ATT_PACK(PF_, A0, A1) do { _Pragma("unroll") for (int s = 0; s < 2; ++s) { \
            u32x4 a, b; \
            a.x = pk2(A0[8 * s + 0], A0[8 * s + 1]); a.y = pk2(A0[8 * s + 2], A0[8 * s + 3]); a.z = pk2(A0[8 * s + 4], A0[8 * s + 5]); a.w = pk2(A0[8 * s + 6], A0[8 * s + 7]); \
            b.x = pk2(A1[8 * s + 0], A1[8 * s + 1]); b.y = pk2(A1[8 * s + 2], A1[8 * s + 3]); b.z = pk2(A1[8 * s + 4], A1[8 * s + 5]); b.w = pk2(A1[8 * s + 6], A1[8 * s + 7]); \
            PF_[0][s] = __builtin_bit_cast(bf16x8, a); PF_[1][s] = __builtin_bit_cast(bf16x8, b); } } while (0)
#define ATT_BODY(t, KS, VS, RS, KL, VL, RL, C0, C1, N0, N1, PFN, PFP, HAS_PV, HAS_QK) do { \
        const bool more = (t + 1 < ntiles), more2 = (t + 2 < ntiles); \
        if (more2) ATT_LOADK2(t + 2, KS, RS); \
        if (more) ATT_LOADV2(t + 1, VS); \
        if (HAS_QK) { f32x16 ng_; _Pragma("unroll") for (int i = 0; i < 16; ++i) ng_[i] = -mref; ATT_QKM(N0, N1, (t + 1) & 1, ng_); } \
        if (HAS_PV) ATT_PV(PFP, lds + ATT_VB + (vs_c == 0 ? 2 * ATT_VBUF : vs_c - ATT_VBUF)); \
        float psa = 0.f, psb = 0.f; \
        _Pragma("unroll") for (int i = 0; i < 16; ++i) { C0[i] = __builtin_amdgcn_exp2f(C0[i]); C1[i] = __builtin_amdgcn_exp2f(C1[i]); psa += C0[i]; psb += C1[i]; } \
        psa += psb; \
        ATT_PACK(PFN, C0, C1); \
        if (__builtin_expect(__any(psa > BIGP), 0)) { \
            float mx = fmaxf(C0[0], C1[0]); \
            _Pragma("unroll") for (int i = 1; i < 16; ++i) mx = fmaxf(mx, fmaxf(C0[i], C1[i])); \
            { auto rr = __builtin_amdgcn_permlane32_swap(__float_as_uint(mx), __float_as_uint(mx), false, false); mx = fmaxf(__uint_as_float(rr[0]), __uint_as_float(rr[1])); } \
            const float dl = mx > 1.f ? ceilf(__log2f(mx)) : 0.f; const float f = __builtin_amdgcn_exp2f(-dl); \
            mref += dl; lsum *= f; psa *= f; \
            _Pragma("unroll") for (int i = 0; i < 16; ++i) { C0[i] *= f; C1[i] *= f; o0[i] *= f; o1[i] *= f; N0[i] -= dl; N1[i] -= dl; } \
            ATT_PACK(PFN, C0, C1); \
        } \
        lsum += psa; \
        if (more2) ATT_STOREK2(t & 1, KS, RS); \
        if (more) ATT_STOREV2((vs_c == 2 * ATT_VBUF ? 0 : vs_c + ATT_VBUF), VS); \
        asm volatile("s_waitcnt lgkmcnt(0)\n\ts_barrier" ::: "memory"); \
        vs_c = (vs_c == 2 * ATT_VBUF ? 0 : vs_c + ATT_VBUF); \
    } while (0)
    constexpr float BIGP = 65536.f;
    int vs_c = 0;
    ATT_LOADK2(0, kreg, rreg); ATT_LOADV2(0, vreg);
    ATT_STOREK2(0, kreg, rreg); ATT_STOREV2(0, vreg);
    ATT_LOADK2(1, kreg, rreg); ATT_STOREK2(1, kreg, rreg);
    __syncthreads();
    { f32x16 z_; _Pragma("unroll") for (int i = 0; i < 16; ++i) z_[i] = 0.f; ATT_QKM(s0, s1, 0, z_); }
    {
        float mx = fmaxf(s0[0], s1[0]);
#pragma unroll
        for (int i = 1; i < 16; ++i) mx = fmaxf(mx, fmaxf(s0[i], s1[i]));
        { auto rr = __builtin_amdgcn_permlane32_swap(__float_as_uint(mx), __float_as_uint(mx), false, false); mx = fmaxf(__uint_as_float(rr[0]), __uint_as_float(rr[1])); }
        mref = mx;
#pragma unroll
        for (int i = 0; i < 16; ++i) { s0[i] -= mx; s1[i] -= mx; }
    }
    { const int t = 0; ATT_BODY(t, kreg, vreg, rreg, kreg, vreg, rreg, s0, s1, n0, n1, pfa, pfb, 0, 1); }
    for (int t2 = 1; t2 < ntiles - 1; t2 += 2) {
        { const int t = t2; ATT_BODY(t, kreg, vreg, rreg, kreg, vreg, rreg, n0, n1, s0, s1, pfb, pfa, 1, 1); }
        { const int t = t2 + 1; ATT_BODY(t, kreg, vreg, rreg, kreg, vreg, rreg, s0, s1, n0, n1, pfa, pfb, 1, 1); }
    }
    { const int t = ntiles - 1; ATT_BODY(t, kreg, vreg, rreg, kreg, vreg, rreg, n0, n1, s0, s1, pfb, pfa, 1, 0); }
    ATT_PV(pfb, lds + ATT_VB + (vs_c == 0 ? 2 * ATT_VBUF : vs_c - ATT_VBUF));
    { auto rr = __builtin_amdgcn_permlane32_swap(__float_as_uint(lsum), __float_as_uint(lsum), false, false); lsum = __uint_as_float(rr[0]) + __uint_as_float(rr[1]); }
    const float inv = 1.f / lsum;
    {
        LAS unsigned char* stg = lds + ATT_OST + w * 4608;
        LAS unsigned char* mine = stg + r32 * 144 + 8 * h5;
#pragma unroll
        for (int g = 0; g < 4; ++g) {
            u32x2 a, b;
            a.x = pk2(o0[4 * g] * inv, o0[4 * g + 1] * inv); a.y = pk2(o0[4 * g + 2] * inv, o0[4 * g + 3] * inv);
            b.x = pk2(o1[4 * g] * inv, o1[4 * g + 1] * inv); b.y = pk2(o1[4 * g + 2] * inv, o1[4 * g + 3] * inv);
            *(LAS u32x2*)(mine + 16 * g) = a; *(LAS u32x2*)(mine + 64 + 16 * g) = b;
        }
        asm volatile("s_waitcnt lgkmcnt(0)" ::: "memory");
        bf16_t* ob = Op + (size_t)(qrow0 + 32 * w) * ldo;
#pragma unroll
        for (int it = 0; it < 4; ++it) { const int row = it * 8 + (lane >> 3), ch = lane & 7;
            const u32x4 v = *(const LAS u32x4*)(stg + row * 144 + ch * 16);
            *(u32x4*)(ob + (size_t)row * ldo + ch * 8) = v; }
    }
    asm volatile("s_waitcnt lgkmcnt(0)\n\ts_barrier" ::: "memory");
#undef ATT_PV
#undef ATT_PACK
#undef ATT_LOADK
#undef ATT_LOADV
#undef ATT_STOREK
#undef ATT_STOREV
#undef ATT_QK1
#undef ATT_BODY
#undef ATT_LOADK2
#undef ATT_LOADV2
#undef ATT_STOREK2
#undef ATT_STOREV2
#undef ATT_QKM
#undef ATT_VFRAG
#undef ATT_KEYROW
#undef ATT_LOAD
#undef ATT_STORE
}

DI void wave_sum2(float& a, float& b, int lane) {
#pragma unroll
    for (int o = 1; o < 64; o <<= 1) { const float ta = shx(a, o, lane), tb = shx(b, o, lane); a += ta; b += tb; }
}
DI void ln_row_v(const Frame& F, f32x4 (&v)[4], float* xout, const float* g, const float* b, const float* sh, const float* sc, bf16_t* hout, const float* slab, const float* gres, float* stat = nullptr) {
    if (slab) {
#pragma unroll
        for (int j = 0; j < 4; ++j) { f32x4 a = ((const f32x4*)slab)[F.lane + 64 * j];
#pragma unroll
            for (int z = 1; z < 8; ++z) a += ((const f32x4*)(slab + (size_t)z * MC * 1024))[F.lane + 64 * j];
            v[j] = v[j] * ALPHA + ((const f32x4*)gres)[F.lane + 64 * j] * a; }
    }
    if (g) {
        float s = 0.f, s2 = 0.f;
#pragma unroll
        for (int j = 0; j < 4; ++j) { s += (v[j][0] + v[j][1]) + (v[j][2] + v[j][3]); s2 += (v[j][0] * v[j][0] + v[j][1] * v[j][1]) + (v[j][2] * v[j][2] + v[j][3] * v[j][3]); }
        wave_sum2(s, s2, F.lane);
        const float mean = s * (1.f / D); const float rstd = 1.f / sqrtf(fmaxf(s2 * (1.f / D) - mean * mean, 0.f) + EPS);
        if (stat && F.lane == 0) { f32x2 sv = {mean, rstd}; *(f32x2*)stat = sv; }
#pragma unroll
        for (int j = 0; j < 4; ++j) { const f32x4 gg = ((const f32x4*)g)[F.lane + 64 * j], bb = ((const f32x4*)b)[F.lane + 64 * j];
            v[j] = (v[j] - mean) * rstd * gg + bb; if (xout) ((f32x4*)xout)[F.lane + 64 * j] = v[j]; }
    }
    if (hout) {
        float s = 0.f, s2 = 0.f;
#pragma unroll
        for (int j = 0; j < 4; ++j) { s += (v[j][0] + v[j][1]) + (v[j][2] + v[j][3]); s2 += (v[j][0] * v[j][0] + v[j][1] * v[j][1]) + (v[j][2] * v[j][2] + v[j][3] * v[j][3]); }
        wave_sum2(s, s2, F.lane);
        const float mean = s * (1.f / D); const float rstd = 1.f / sqrtf(fmaxf(s2 * (1.f / D) - mean * mean, 0.f) + EPS);
#pragma unroll
        for (int j = 0; j < 4; ++j) { const f32x4 hh = ((const f32x4*)sh)[F.lane + 64 * j], cc = ((const f32x4*)sc)[F.lane + 64 * j];
            const f32x4 o = (v[j] - mean) * rstd * (cc + 1.f) + hh; u32x2 wv; wv.x = pk2(o[0], o[1]); wv.y = pk2(o[2], o[3]);
            ((u32x2*)hout)[F.lane + 64 * j] = wv; }
    }
}
DI void ln_load(const Frame& F, const float* xin, f32x4 (&v)[4]) {
    const f32x4* xr = (const f32x4*)xin + F.lane;
#pragma unroll
    for (int j = 0; j < 4; ++j) v[j] = xr[64 * j];
}
DI void ln_row(const Frame& F, const float* xin, float* xout, const float* g, const float* b, const float* sh, const float* sc, bf16_t* hout, const float* slab = nullptr, const float* gres = nullptr) {
    f32x4 v[4]; ln_load(F, xin, v);
    ln_row_v(F, v, xout, g, b, sh, sc, hout, slab, gres);
}

DI int srcmap(int kind, int n) {
    switch (kind) {
    case 0: {
        if (n < 256) return n;
        if (n < 512) return 1056 + (n - 256);
        if (n < 768) { const int c = n - 512, slot = (c & 127) >> 5, d = 32 * (c >> 7) + (c & 31); return slot < 2 ? 288 + slot * 64 + d : 416 + (slot - 2) * 64 + d; }
        if (n < 1280) { const int t = (n - 768) >> 8, c = (n - 768) & 255, slot = (c & 127) >> 5, d = 32 * (c >> 7) + (c & 31); return 1312 + (4 * t + slot) * 64 + d; }
        return 1824 + (n - 1280); }
    case 1: { const int half = (n & 7) >> 2, i = 4 * (n >> 3) + (n & 3); return 256 + half * 16 + i; }
    case 2: {
        if (n < 512) return (n >> 6) * 96 + (n & 63);
        const int c = n - 512, hd = c >> 5, j = c & 31, half = (j & 7) >> 2, i = 4 * (j >> 3) + (j & 3); return hd * 96 + 64 + half * 16 + i; }
    default: return n;
    }
}
DI void conv_item(const float* W, int K, int ld, int kind, const float* gain, bf16_t* WT, int item, int nblk, LAS float* scr, int lane) {
    const int kb = item / nblk, nb = item % nblk, k0 = 64 * kb, n0 = 32 * nb;
    const int sc_ = srcmap(kind, n0 + (lane & 31));
    float wv[32];
#pragma unroll
    for (int i = 0; i < 32; ++i) wv[i] = W[(size_t)(k0 + 2 * i + (lane >> 5)) * ld + sc_];
    if (gain) {
#pragma unroll
        for (int i = 0; i < 32; ++i) wv[i] *= gain[k0 + 2 * i + (lane >> 5)];
    }
#pragma unroll
    for (int i = 0; i < 32; ++i) scr[(2 * i + (lane >> 5)) * 33 + (lane & 31)] = wv[i];
    asm volatile("s_waitcnt lgkmcnt(0)" ::: "memory");
    const int c = lane & 7;
#pragma unroll
    for (int j = 0; j < 4; ++j) { const int n = (lane >> 3) + 8 * j; const LAS float* s = scr + (8 * c) * 33 + n;
        u32x4 o; o.x = pk2(s[0 * 33], s[1 * 33]); o.y = pk2(s[2 * 33], s[3 * 33]); o.z = pk2(s[4 * 33], s[5 * 33]); o.w = pk2(s[6 * 33], s[7 * 33]);
        *(u32x4*)(WT + (size_t)(n0 + n) * K + k0 + 8 * c) = o; }
    asm volatile("s_waitcnt lgkmcnt(0)" ::: "memory");
}
template <int Q0, int Q1>
DI void convert_weights(const Frame& F, int l, int crank, int ncu) {
    LAS float* scr = (LAS float*)(F.lds + F.wave * 16384);
    unsigned char* W = F.ws + WS_W;
    const int gw = crank * 8 + F.wave, NGW = ncu * 8;
    const float* w_in = pin(F, I_WIN) + (size_t)l * D * INC;
    struct It { const float* src; int K, ld, kind, N; const float* gain; size_t dst; };
    const It its[11] = {
        {w_in, 1024, INC, 0, NIN, nullptr, W_IN},
        {w_in, 1024, INC, 1, 32, nullptr, W_KR},
        {pin(F, I_WUK) + (size_t)l * 256 * 512, 256, 512, 9, 512, pin(F, I_MKVG) + l * 256, W_UKV},
        {pin(F, I_WUV) + (size_t)l * 256 * 512, 256, 512, 9, 512, pin(F, I_MKVG) + l * 256, W_UKV + 512 * 256 * 2},
        {pin(F, I_WUQ) + (size_t)l * 256 * 768, 256, 768, 2, 768, pin(F, I_MQG) + l * 256, W_UQ},
        {pin(F, I_WFO) + (size_t)l * 512 * 1024, 512, 1024, 9, 1024, nullptr, W_FO},
        {pin(F, I_WMO) + (size_t)l * 512 * 1024, 512, 1024, 9, 1024, nullptr, W_MO},
        {pin(F, I_WGO) + (size_t)l * 512 * 1024, 512, 1024, 9, 1024, nullptr, W_GO},
        {pin(F, I_WO) + (size_t)l * 1024 * 1024, 1024, 1024, 9, 1024, nullptr, W_O},
        {pin(F, I_W1) + (size_t)l * 1024 * 4096, 1024, 4096, 9, 4096, nullptr, W_1},
        {pin(F, I_W2) + (size_t)l * 4096 * 1024, 4096, 1024, 9, 1024, nullptr, W_2}};
    int base = 0;
#pragma unroll
    for (int q = Q0; q < Q1; ++q) {
        const int nblk = its[q].N / 32, nit = (its[q].K / 64) * nblk;
        int first = (gw - base) % NGW; if (first < 0) first += NGW;
        for (int it = first; it < nit; it += NGW) conv_item(its[q].src, its[q].K, its[q].ld, its[q].kind, its[q].gain, (bf16_t*)(W + its[q].dst), it, nblk, scr, F.lane);
        base = (base + nit) % NGW;
    }
}
DI void fold_fourier(const Frame& F, int l, int crank, int ncu) {
    __syncthreads();
    LAS float* u = (LAS float*)F.lds;
    LAS float* T = (LAS float*)(F.lds + 32768);
    if (F.tid < 128) T[F.tid] = cospif((float)F.tid * (1.f / 64.f));
    const float* w_in = pin(F, I_WIN) + (size_t)l * D * INC;
    bf16_t* WT = (bf16_t*)(F.ws + WS_W + W_T);
    for (int item = crank; item < 256; item += ncu) {
        const int g = item >> 6, k0 = (item & 63) * 16;
        __syncthreads();
        for (int e = F.tid; e < 16 * 128; e += 512) { const int kk = e >> 7, c = e & 127; u[kk * 129 + c] = w_in[(size_t)(k0 + kk) * INC + 544 + g * 128 + c]; }
        __syncthreads();
        const int kk = F.tid & 15, grp = F.tid >> 4;
        float a[8];
#pragma unroll
        for (int o = 0; o < 8; ++o) a[o] = 0.f;
        for (int c = 0; c < 128; ++c) { const float uv = u[kk * 129 + c];
#pragma unroll
            for (int o = 0; o < 8; ++o) { const int mcs = grp * 8 + o, mm = mcs >> 1, cs = mcs & 1; a[o] += uv * T[(mm * c - 32 * cs) & 127]; } }
#pragma unroll
        for (int o = 0; o < 8; ++o) { const int mcs = grp * 8 + o; unsigned short hv = (unsigned short)(pk2(a[o], 0.f) & 0xffffu); WT[(size_t)(g * 256 + mcs) * 1024 + k0 + kk] = hv; }
    }
    __syncthreads();
}
DI void krope_phase(const Frame& F, int crank, int ncu) {
    const bf16_t* H = (const bf16_t*)(F.ws + WS_HB); const bf16_t* Wk = (const bf16_t*)(F.ws + WS_W + W_KR); bf16_t* KR = (bf16_t*)(F.ws + WS_KR);
    const float* rm = (const float*)(F.ws + WS_ROPEM);
    const int r32 = F.lane & 31, h5 = F.lane >> 5, w = F.wave;
    LAS float* part = (LAS float*)F.lds;
    for (int it = crank; it < MT / 32; it += ncu) {
        const int row0 = it * 32;
        f32x16 acc;
#pragma unroll
        for (int i = 0; i < 16; ++i) acc[i] = 0.f;
        const bf16_t* hp = H + (size_t)(row0 + r32) * 1024 + 8 * h5 + 128 * w; const bf16_t* wp = Wk + (size_t)r32 * 1024 + 8 * h5 + 128 * w;
        bf16x8 a[8], b[8];
#pragma unroll
        for (int q = 0; q < 8; ++q) { a[q] = *(const bf16x8*)(wp + 16 * q); b[q] = *(const bf16x8*)(hp + 16 * q); }
#pragma unroll
        for (int q = 0; q < 8; ++q) acc = MFMA32(a[q], b[q], acc);
        __syncthreads();
#pragma unroll
        for (int i = 0; i < 16; ++i) part[(w * 16 + i) * 64 + F.lane] = acc[i];
        __syncthreads();
        if (w == 0) {
#pragma unroll
            for (int i = 0; i < 16; ++i) { float sacc = 0.f;
#pragma unroll
                for (int q = 0; q < 8; ++q) sacc += part[(q * 16 + i) * 64 + F.lane];
                acc[i] = sacc; }
            const int row = row0 + r32;
            f32x16 oth;
#pragma unroll
            for (int i = 0; i < 16; ++i) oth[i] = shx(acc[i], 32, F.lane);
            u32x2 wv[4];
#pragma unroll
            for (int g = 0; g < 4; ++g) { float o[4];
#pragma unroll
                for (int e = 0; e < 4; ++e) { const int i = 4 * g + e; float x1 = h5 ? oth[i] : acc[i], x2 = h5 ? acc[i] : oth[i]; float cs = 1.f, sn = 0.f;
                    if (row < ML) { cs = rm[(size_t)(row & 2047) * 32 + i]; sn = rm[(size_t)(row & 2047) * 32 + 16 + i]; }
                    o[e] = h5 ? (x1 * sn + x2 * cs) : (x1 * cs - x2 * sn); }
                wv[g].x = pk2(o[0], o[1]); wv[g].y = pk2(o[2], o[3]); }
#pragma unroll
            for (int g = 0; g < 4; ++g) *(u32x2*)(KR + (size_t)row * 32 + 8 * g + 4 * h5) = wv[g];
        }
    }
    __syncthreads();
}

DI void prologue_a(const Frame& F) {
    unsigned char* ws = F.ws;
    convert_weights<0, 5>(F, 0, F.vcu, F.G);
    fold_fourier(F, 0, F.bid, F.G);
    { const int gt = F.bid * 512 + F.tid, NT = F.G * 512;
      float* rm = (float*)(ws + WS_ROPEM); float* rg = (float*)(ws + WS_ROPEG);
      for (int e = gt; e < 2048 * 16; e += NT) { const int pos = e >> 4, i = e & 15; const float fr_ = powf(10000.f, -(float)(i & 7) / 8.f); const float p_ = (i < 8) ? (float)(pos >> 6) : (float)(pos & 63);
          float sn, cs; sincosf(p_ * fr_, &sn, &cs); rm[pos * 32 + i] = cs; rm[pos * 32 + 16 + i] = sn; }
      for (int e = gt; e < 2048 * 32; e += NT) { const int pos = e >> 5, i = e & 31; const float fr_ = powf(10000.f, -(float)(i & 15) / 16.f); const float p_ = (i < 16) ? (float)(pos >> 6) : (float)(pos & 63);
          float sn, cs; sincosf(p_ * fr_, &sn, &cs); rg[pos * 64 + i] = cs; rg[pos * 64 + 32 + i] = sn; }
      bf16_t* dm = (bf16_t*)(ws + WS_DFTM);
      for (int e = gt; e < 2048 * 1024; e += NT) { const int k = e >> 10, j2 = (e & 1023) * 2; unsigned wv[2];
#pragma unroll
          for (int q = 0; q < 2; ++q) { const int j = j2 + q * 2048; float v0, v1; { const int jj = j & 2047; const float a0 = (float)((k * jj) & 2047) * (1.f / 1024.f), a1 = (float)((k * (jj + 1)) & 2047) * (1.f / 1024.f);
              if (j < 2048) { v0 = cospif(a0); v1 = cospif(a1); } else { v0 = -sinpif(a0); v1 = -sinpif(a1); } }
              wv[q] = pk2(v0 * (1.f / 512.f), v1 * (1.f / 512.f)); }
          *(unsigned*)(dm + (size_t)k * 4096 + j2) = wv[0]; *(unsigned*)(dm + (size_t)k * 4096 + 2048 + j2) = wv[1]; }
      bf16_t* dc = (bf16_t*)(ws + WS_DFTMC); const float sc = 0.005524271728019903f;
      for (int e = gt; e < 256 * 512; e += NT) { const int k = e >> 9, j = e & 511, jj = j & 255; const float a0 = (float)((k * jj) & 255) * (1.f / 128.f);
          const float v = (j < 256) ? cospif(a0) : -sinpif(a0); dc[e] = (unsigned short)(pk2(v * sc, 0.f) & 0xffffu); }
    }
    { __syncthreads();
      LAS float* sl = (LAS float*)F.lds;
      LAS float* red = (LAS float*)(F.lds + 36864);
      for (int e = F.tid; e < 9 * 1024; e += 512) { const int r = e >> 10, k = e & 1023; const float c = r < 8 ? pin(F, I_C)[r * 1024 + k] : pin(F, I_CCTX)[k]; sl[e] = c / (1.f + __expf(-c)); }
      __syncthreads();
      const int col = F.tid & 63, kg = F.tid >> 6;
      for (int item = F.bid; item < 4 * 96; item += F.G) {
          const int l = item / 96, cb = (item % 96) * 64;
          const float* wa = pin(F, I_WADA) + (size_t)l * 1024 * 6144 + cb + col;
          float a[9];
#pragma unroll
          for (int r = 0; r < 9; ++r) a[r] = 0.f;
          for (int k0 = kg * 128; k0 < kg * 128 + 128; k0 += 16) { float wv[16];
#pragma unroll
              for (int q = 0; q < 16; ++q) wv[q] = wa[(size_t)(k0 + q) * 6144];
#pragma unroll
              for (int q = 0; q < 16; ++q)
#pragma unroll
                  for (int r = 0; r < 9; ++r) a[r] += sl[r * 1024 + k0 + q] * wv[q]; }
#pragma unroll
          for (int r = 0; r < 9; ++r) red[(kg * 9 + r) * 64 + col] = a[r];
          __syncthreads();
          for (int e = F.tid; e < 9 * 64; e += 512) { const int r = e >> 6, c2 = e & 63; float s = pin(F, I_BADA)[l * 6144 + cb + c2];
#pragma unroll
              for (int q = 0; q < 8; ++q) s += red[(q * 9 + r) * 64 + c2];
              ((float*)(ws + WS_MOD))[(size_t)(l * 9 + r) * 6144 + cb + c2] = s; }
          __syncthreads();
      }
    }
}
DI void prologue_b(const Frame& F) {
    const int gw = F.vcu * 8 + F.wave, NGW = F.G * 8;
    bf16_t* H = (bf16_t*)(F.ws + WS_HB);
    for (int row = gw; row < MT; row += NGW) {
        const int mr = row < ML ? (row >> 11) : 8;
        const float* xi = row < ML ? pin(F, I_X) + (size_t)row * D : pin(F, I_CTX) + (size_t)(row - ML) * D;
        ln_row(F, xi, nullptr, nullptr, nullptr, modp(F, 0, mr, 0), modp(F, 0, mr, 1), H + (size_t)row * D);
    }
}
DI void ln_phase(const Frame& F, int which) {
    const int gw = F.vcu * 8 + F.wave, NGW = F.G * 8; const int l = F.l;
    const int nrows = (l == NL - 1) ? ML : MT;
    bf16_t* H = (bf16_t*)(F.ws + WS_HB);
    const float* g = pin(F, which == 0 ? I_LN1G : I_LN2G) + l * 1024; const float* b = pin(F, which == 0 ? I_LN1B : I_LN2B) + l * 1024;
    const bool wh = !(which == 1 && l == NL - 1);
    f32x4 vc[4], vn[4];
    if (gw < nrows) ln_load(F, xrow_ptr(F, gw), vc);
    for (int row = gw; row < nrows; row += NGW) {
        if (row + NGW < nrows) ln_load(F, xrow_ptr(F, row + NGW), vn);
        const int mr = row < ML ? (row >> 11) : 8;
        const float* sh = which == 0 ? modp(F, l, mr, 3) : modp(F, l + 1 < NL ? l + 1 : l, mr, 0);
        const float* sc = which == 0 ? modp(F, l, mr, 4) : modp(F, l + 1 < NL ? l + 1 : l, mr, 1);
        const bool sl = (which == 1 && row >= ML);
        const bool st_only = row < ML && !(which == 1 && l == NL - 1);
        float* stp = st_only ? (float*)(F.ws + (which == 0 ? WS_ST1 : WS_ST2)) + 2 * (size_t)row : nullptr;
        ln_row_v(F, vc, st_only ? nullptr : xrow_ptr(F, row), g, b, sh, sc, wh ? H + (size_t)row * D : nullptr, sl ? (const float*)(F.ws + WS_KN) + (size_t)(row - ML) * 1024 : nullptr, modp(F, l, mr, 5), stp);
#pragma unroll
        for (int j = 0; j < 4; ++j) vc[j] = vn[j];
    }
}

DI void phase_g1(const Frame& F) {
    const unsigned char* W = F.ws + WS_W; const char* H = (const char*)(F.ws + WS_HB);
    pg8::Sched2 S; S.tileBytes = 256L * 1024 * 2; S.G = F.G; S.c = F.bid;
    S.j0 = pg8::JobD{H, (const char*)(W + W_IN), MT / 256, NIN / 256, 1, 0, 0};
    S.j1 = pg8::JobD{(const char*)(W + W_T), H, 4, MT / 256, 1, 0, 0};
    S.n0 = (MT / 256) * (NIN / 256); S.total = S.n0 + 4 * (MT / 256);
    krope_phase(F, F.bid, F.G);
    EpiG1 E{F};
    pg8::gemm_phase(F.lds, 1024, S, E, F.tid);
}
DI void phase_g2(const Frame& F) {
    const unsigned char* W = F.ws + WS_W;
    pg8::Sched2 S; S.tileBytes = 256L * 256 * 2; S.G = F.G; S.c = F.bid;
    S.j0 = pg8::JobD{(const char*)(F.ws + WS_CKV), (const char*)(W + W_UKV), MT / 256, 4, 1, 0, 0};
    S.j1 = pg8::JobD{(const char*)(F.ws + WS_CQ), (const char*)(W + W_UQ), MT / 256, 3, 1, 0, 0};
    S.n0 = (MT / 256) * 4; S.total = S.n0 + (MT / 256) * 3;
    EpiG2 E{F};
    pg8::gemm_phase(F.lds, 256, S, E, F.tid);
}
DI void phase_att(const Frame& F) {
    const bool lastl = (F.l == NL - 1);
    const int nun = (!lastl && F.vcu < 128) ? 5 : 4;
#pragma unroll 1
    for (int i = 0; i < nun; ++i) {
        int kind, b, h, q0, nt;
        if (i < 4) { const int idx = (i >> 1) * 256 + F.vcu; kind = i & 1; b = idx >> 6; h = (idx >> 3) & 7; q0 = b * SEQ + (idx & 7) * 256; nt = 36; }
        else { const int idx = F.vcu >> 1; kind = F.vcu & 1; b = idx >> 3; h = idx & 7; q0 = ML + b * CTXL; nt = 4; }
        if (kind == 0) attn_unit<0>(F, q0, h, ML + b * CTXL, b * SEQ, nt);
        else attn_unit<1>(F, q0, h, ML + b * CTXL, b * SEQ, nt);
    }
    __syncthreads();
#ifndef NO_DFT
    {
        pg8::Sched2 S; S.tileBytes = 256L * 4096 * 2; S.G = F.G; S.c = (F.bid + 128) & 255;
        S.j0 = pg8::JobD{(const char*)(F.ws + WS_DFTM), (const char*)(F.ws + WS_TF), 8, 2, 8, 0, 1024L * 2048 * 2}; S.j1 = S.j0;
        S.n0 = 128; S.total = 128;
        EpiDft E{(bf16_t*)(F.ws + WS_F), 2048, 512};
        pg8::gemm_phase(F.lds, 4096, S, E, F.tid);
#ifdef PROBE_DFT
        pg8::gemm_phase(F.lds, 4096, S, E, F.tid);
#endif
    }
    if (!lastl) {
        pg8::Sched2 S; S.tileBytes = 256L * 512 * 2; S.G = F.G; S.c = F.bid;
        S.j0 = pg8::JobD{(const char*)(F.ws + WS_DFTMC), (const char*)(F.ws + WS_TFC), 1, 2, 8, 0, 1024L * 256 * 2}; S.j1 = S.j0;
        S.n0 = 16; S.total = 16;
        EpiDft E{(bf16_t*)(F.ws + WS_F) + (size_t)ML * 512, 256, 512};
        pg8::gemm_phase(F.lds, 512, S, E, F.tid);
    }
#endif
    if (F.bid < 128) {
        __syncthreads();
        const int cr = (F.bid & 7) * 16 + (F.bid >> 3);
        convert_weights<5, 11>(F, F.l, cr, 128);
    }
}
DI void phase_g3(const Frame& F) {
    const unsigned char* W = F.ws + WS_W; const int nM = (F.l == NL - 1 ? ML : MT) / 256;
    pg8::Sched3 S; S.tileBytes = 256L * 512 * 2; S.G = F.G; S.c = F.bid; S.ntiles = nM * 4;
    S.j = pg8::JobD{(const char*)(F.ws + WS_F), (const char*)(W + W_FO), nM, 4, 1, 0, 0};
    S.A1 = (const char*)(F.ws + WS_AM); S.B1 = (const char*)(W + W_MO); S.A2 = (const char*)(F.ws + WS_QG); S.B2 = (const char*)(W + W_GO);
    EpiG3 E{F};
    pg8::gemm_phase(F.lds, 512, S, E, F.tid);
    if (F.l + 1 < NL && F.bid >= 32) {
        __syncthreads();
        convert_weights<0, 5>(F, F.l + 1, F.bid - 32, F.G - 32); fold_fourier(F, F.l + 1, F.bid - 32, F.G - 32);
    }
}
DI void phase_g4(const Frame& F) {
    const unsigned char* W = F.ws + WS_W; const int nM = (F.l == NL - 1 ? ML : MT) / 256;
    pg8::Sched2 S; S.tileBytes = 256L * 1024 * 2; S.G = F.G; S.c = F.bid;
    S.j0 = pg8::JobD{(const char*)(F.ws + WS_HB), (const char*)(W + W_O), nM, 4, 1, 0, 0}; S.j1 = S.j0; S.n0 = nM * 4; S.total = S.n0;
    EpiRes E{F, 2, true, F.l > 0 ? 2 : 0};
    pg8::gemm_phase(F.lds, 1024, S, E, F.tid);
}
DI void phase_g5(const Frame& F) {
    const unsigned char* W = F.ws + WS_W; const int nM = (F.l == NL - 1 ? ML : MT) / 256;
    pg8::Sched2 S; S.tileBytes = 256L * 1024 * 2; S.G = F.G; S.c = F.bid;
    S.j0 = pg8::JobD{(const char*)(F.ws + WS_HB), (const char*)(W + W_1), nM, 16, 1, 0, 0}; S.j1 = S.j0; S.n0 = nM * 16; S.total = S.n0;
    EpiW1 E{F};
    pg8::gemm_phase(F.lds, 1024, S, E, F.tid);
#ifdef PROBE_G5
    pg8::gemm_phase(F.lds, 1024, S, E, F.tid);
#endif
}
DI void phase_g6(const Frame& F) {
    const unsigned char* W = F.ws + WS_W;
    {
        pg8::Sched2 S; S.tileBytes = 256L * 4096 * 2; S.G = F.G; S.c = F.bid;
        S.j0 = pg8::JobD{(const char*)(F.ws + WS_U), (const char*)(W + W_2), ML / 256, 4, 1, 0, 0}; S.j1 = S.j0; S.n0 = (ML / 256) * 4; S.total = S.n0;
        EpiRes E{F, 5, false, 1};
        pg8::gemm_phase(F.lds, 4096, S, E, F.tid);
    }
    if (F.l < NL - 1) {
        pg8::Sched2 S; S.tileBytes = 256L * 4096 * 2; S.G = F.G; S.c = F.bid;
        S.j0 = pg8::JobD{(const char*)(F.ws + WS_U) + (size_t)ML * 4096 * 2, (const char*)(W + W_2), MC / 256, 4, 8, 512 * 2, 512 * 2}; S.j1 = S.j0; S.n0 = (MC / 256) * 4 * 8; S.total = S.n0;
        EpiSlab E{(float*)(F.ws + WS_KN)};
        pg8::gemm_phase<4096>(F.lds, 512, S, E, F.tid);
    }
}

constexpr int N_PHASES = 2 + 9 * NL;
template <int ONLY>
__global__ void __launch_bounds__(512, 2) fwd_kernel(Params prm) {
    extern __shared__ __attribute__((aligned(16))) unsigned char lds_raw[];
    Frame F;
    F.P = &prm; F.ws = prm.ws; F.lds = (LAS unsigned char*)lds_raw;
    F.tid = threadIdx.x; F.lane = F.tid & 63; F.wave = __builtin_amdgcn_readfirstlane(F.tid >> 6);
    F.G = gridDim.x; F.bid = blockIdx.x; F.vcu = (F.G % 8 == 0) ? (F.bid % 8) * (F.G / 8) + F.bid / 8 : F.bid; F.l = 0;
    volatile LAS unsigned* MISC = (volatile LAS unsigned*)(F.lds + MISC_OFF);
    for (int u = F.tid; u < (LDS_BYTES - RING_BYTES) / 4; u += 512) ((LAS unsigned*)(F.lds + RING_BYTES))[u] = 0u;
    __syncthreads();
#if MK_ONE_LAUNCH
    const int lo = 0, hi = N_PHASES;
#else
    const int lo = prm.ph_lo, hi = prm.ph_hi;
#endif
    XcdBarrier bar; bar.bar = (unsigned*)(F.ws + WS_CTL) + 4096; bar.x = 0; bar.st = nullptr;
    if (hi - lo > 1) {
        bar = xcd_barrier_post((unsigned*)(F.ws + WS_CTL) + 4096, MISC + 8);
        cg::this_grid().sync();
        if (threadIdx.x == 0) { unsigned nloc, nx; xcd_barrier_complete(bar.bar, bar.x, nloc, nx); bar.st[0] = nloc; bar.st[1] = nx; }
        __syncthreads();
    }
    const int wave_s = __builtin_amdgcn_readfirstlane(threadIdx.x >> 6);
    for (int ph = lo; ph < hi; ++ph) {
        { int lane_; asm volatile("v_mbcnt_lo_u32_b32 %0, -1, 0\n\tv_mbcnt_hi_u32_b32 %0, -1, %0" : "=v"(lane_));
          int z_ = 0, b_ = blockIdx.x, g_ = gridDim.x, t_ = wave_s * 64 + lane_;
#if (OPQ_MASK & 1)
          asm volatile("" : "+s"(z_));
#endif
#if (OPQ_MASK & 2)
          asm volatile("" : "+s"(b_), "+s"(g_));
#endif
#if (OPQ_MASK & 4)
          asm volatile("" : "+v"(t_));
#endif
          F.ws = prm.ws + z_; F.zo = z_;
          b_ &= 1023; g_ &= 1023; F.bid = b_; F.G = g_; F.vcu = (g_ % 8 == 0) ? (b_ % 8) * (g_ / 8) + b_ / 8 : b_; F.tid = t_ & 511; F.lane = t_ & 63; F.wave = __builtin_amdgcn_readfirstlane((t_ & 511) >> 6); }
        if constexpr (ONLY >= 0) {
            F.l = ph < 2 ? 0 : (ph - 2) / 9;
            if constexpr (ONLY == 100) prologue_a(F);
            else if constexpr (ONLY == 101) prologue_b(F);
            else if constexpr (ONLY == 0) phase_g1(F);
            else if constexpr (ONLY == 1) phase_g2(F);
            else if constexpr (ONLY == 2) phase_att(F);
            else if constexpr (ONLY == 3) phase_g3(F);
            else if constexpr (ONLY == 4) phase_g4(F);
            else if constexpr (ONLY == 5) ln_phase(F, 0);
            else if constexpr (ONLY == 6) phase_g5(F);
            else if constexpr (ONLY == 7) phase_g6(F);
            else ln_phase(F, 1);
            continue;
        }
        if (ph == 0) prologue_a(F);
        else if (ph == 1) prologue_b(F);
        else {
            const int q = ph - 2; F.l = q / 9; const int sub = q - F.l * 9;
            switch (sub) {
            case 0: phase_g1(F); break;
            case 1: phase_g2(F); break;
            case 2: phase_att(F); break;
            case 3: phase_g3(F); break;
            case 4: phase_g4(F); break;
            case 5: ln_phase(F, 0); break;
            case 6: phase_g5(F); break;
            case 7: phase_g6(F); break;
            default: ln_phase(F, 1); break;
            }
        }
        if (ph + 1 < hi) { XcdBarrier b2; b2.bar = (unsigned*)(F.ws + WS_CTL) + 4096; b2.x = xb_xcc_id(); b2.st = (volatile LAS unsigned*)(F.lds + MISC_OFF) + 8; xcd_barrier(b2, F.tid); }
    }
}

extern "C" void kernel_launch(void* const* d_in, const int* in_sizes, int n_in, void* d_out, int out_size, void* d_ws, size_t ws_size, hipStream_t stream) {
    static int grid = 0;
    if (grid == 0) {
        if (n_in != 25 || out_size != ML * D || ws_size < WS_END) { fprintf(stderr, "kernel_launch: unexpected shapes (n_in %d out %d ws %zu)\n", n_in, out_size, ws_size); grid = -1; return; }
        int dev = 0, cus = 0, per_cu = 0;
        (void)hipGetDevice(&dev); (void)hipDeviceGetAttribute(&cus, hipDeviceAttributeMultiprocessorCount, dev);
#if MK_ONE_LAUNCH
        (void)hipFuncSetAttribute((const void*)fwd_kernel<-1>, hipFuncAttributeMaxDynamicSharedMemorySize, LDS_BYTES);
        (void)hipOccupancyMaxActiveBlocksPerMultiprocessor(&per_cu, (const void*)fwd_kernel<-1>, 512, LDS_BYTES);
#else
        (void)hipFuncSetAttribute((const void*)fwd_kernel<100>, hipFuncAttributeMaxDynamicSharedMemorySize, LDS_BYTES);
        (void)hipFuncSetAttribute((const void*)fwd_kernel<101>, hipFuncAttributeMaxDynamicSharedMemorySize, LDS_BYTES);
        (void)hipFuncSetAttribute((const void*)fwd_kernel<0>, hipFuncAttributeMaxDynamicSharedMemorySize, LDS_BYTES);
        (void)hipFuncSetAttribute((const void*)fwd_kernel<1>, hipFuncAttributeMaxDynamicSharedMemorySize, LDS_BYTES);
        (void)hipFuncSetAttribute((const void*)fwd_kernel<2>, hipFuncAttributeMaxDynamicSharedMemorySize, LDS_BYTES);
        (void)hipFuncSetAttribute((const void*)fwd_kernel<3>, hipFuncAttributeMaxDynamicSharedMemorySize, LDS_BYTES);
        (void)hipFuncSetAttribute((const void*)fwd_kernel<4>, hipFuncAttributeMaxDynamicSharedMemorySize, LDS_BYTES);
        (void)hipFuncSetAttribute((const void*)fwd_kernel<5>, hipFuncAttributeMaxDynamicSharedMemorySize, LDS_BYTES);
        (void)hipFuncSetAttribute((const void*)fwd_kernel<6>, hipFuncAttributeMaxDynamicSharedMemorySize, LDS_BYTES);
        (void)hipFuncSetAttribute((const void*)fwd_kernel<7>, hipFuncAttributeMaxDynamicSharedMemorySize, LDS_BYTES);
        (void)hipFuncSetAttribute((const void*)fwd_kernel<8>, hipFuncAttributeMaxDynamicSharedMemorySize, LDS_BYTES);
#endif
        (void)hipGetLastError();
        if (per_cu < 1) per_cu = 1;
        grid = cus;
        if (grid != 256) fprintf(stderr, "kernel_launch: grid %d (expected 256)\n", grid);
    }
    if (grid < 0) return;
    (void)hipMemsetAsync((char*)d_ws + WS_CTL, 0, CTL_BYTES, stream);
    Params p{};
    for (int i = 0; i < 25; ++i) p.in[i] = (const float*)d_in[i];
    p.out = (float*)d_out; p.ws = (unsigned char*)d_ws;
#if MK_ONE_LAUNCH
    p.ph_lo = 0; p.ph_hi = N_PHASES;
    void* args[] = {&p};
    hipError_t e = hipLaunchCooperativeKernel((const void*)fwd_kernel<-1>, dim3(grid), dim3(512), args, LDS_BYTES, stream);
    if (e != hipSuccess) fprintf(stderr, "cooperative launch failed: %s\n", hipGetErrorString(e));
#else
    for (int ph = 0; ph < N_PHASES; ++ph) {
        p.ph_lo = ph; p.ph_hi = ph + 1;
        const int sub = ph < 2 ? 100 + ph : (ph - 2) % 9;
        switch (sub) {
        case 100: hipLaunchKernelGGL(fwd_kernel<100>, dim3(grid), dim3(512), LDS_BYTES, stream, p); break;
        case 101: hipLaunchKernelGGL(fwd_kernel<101>, dim3(grid), dim3(512), LDS_BYTES, stream, p); break;
        case 0: hipLaunchKernelGGL(fwd_kernel<0>, dim3(grid), dim3(512), LDS_BYTES, stream, p); break;
        case 1: hipLaunchKernelGGL(fwd_kernel<1>, dim3(grid), dim3(512), LDS_BYTES, stream, p); break;
        case 2: hipLaunchKernelGGL(fwd_kernel<2>, dim3(grid), dim3(512), LDS_BYTES, stream, p); break;
        case 3: hipLaunchKernelGGL(fwd_kernel<3>, dim3(grid), dim3(512), LDS_BYTES, stream, p); break;
        case 4: hipLaunchKernelGGL(fwd_kernel<4>, dim3(grid), dim3(512), LDS_BYTES, stream, p); break;
        case 5: hipLaunchKernelGGL(fwd_kernel<5>, dim3(grid), dim3(512), LDS_BYTES, stream, p); break;
        case 6: hipLaunchKernelGGL(fwd_kernel<6>, dim3(grid), dim3(512), LDS_BYTES, stream, p); break;
        case 7: hipLaunchKernelGGL(fwd_kernel<7>, dim3(grid), dim3(512), LDS_BYTES, stream, p); break;
        default: hipLaunchKernelGGL(fwd_kernel<8>, dim3(grid), dim3(512), LDS_BYTES, stream, p); break;
        }
    }
#endif
}
```

```cpp
#include <hip/hip_runtime.h>
#include <hip/hip_cooperative_groups.h>
#include <cstdio>
#include <cstdint>
namespace cg = cooperative_groups;

#define LAS __attribute__((address_space(3)))
#define DI __device__ __forceinline__
typedef unsigned short bf16_t;
typedef short bf16x8 __attribute__((ext_vector_type(8)));
typedef short s16x4 __attribute__((ext_vector_type(4)));
typedef float f32x2 __attribute__((ext_vector_type(2)));
typedef float f32x4 __attribute__((ext_vector_type(4)));
typedef float f32x16 __attribute__((ext_vector_type(16)));
typedef unsigned u32x4 __attribute__((ext_vector_type(4)));
typedef unsigned u32x2 __attribute__((ext_vector_type(2)));
typedef __bf16 bf16x2_t __attribute__((ext_vector_type(2)));

#ifndef MK_ONE_LAUNCH
#define MK_ONE_LAUNCH 1
#endif
#ifndef OPQ_MASK
#if MK_ONE_LAUNCH
#define OPQ_MASK 7
#else
#define OPQ_MASK 0
#endif
#endif

constexpr int D = 1024, NB = 8, SEQ = 2048, CTXL = 256, NL = 4;
constexpr int ML = NB * SEQ, MC = NB * CTXL, MT = ML + MC;
constexpr int DFF = 4096, INC = 4896;
constexpr float EPS = 1e-6f;
constexpr float ALPHA = 1.6817928305074290f;
constexpr float QS_MLA = (float)(0.10206207261596575 * 1.4426950408889634);
constexpr float QS_GQA = (float)(0.125 * 1.4426950408889634);
constexpr int NIN = 4352;

constexpr size_t MiB = 1u << 20;
constexpr size_t WS_CTL = 0, CTL_BYTES = 65536;
constexpr size_t WS_MOD = 1 * MiB;
constexpr size_t WS_ROPEM = 2 * MiB;
constexpr size_t WS_ROPEG = 2 * MiB + 262144;
constexpr size_t WS_SSKV = 3 * MiB, WS_SSQ = 3 * MiB + 524288;
constexpr size_t WS_DFTMC = 4 * MiB;
constexpr size_t WS_ST1 = 4 * MiB + 524288, WS_ST2 = 4 * MiB + 786432;
constexpr size_t WS_DFTM = 5 * MiB;
constexpr size_t WS_W = 21 * MiB;
constexpr size_t W_IN = 0, W_KR = 8 * MiB + 524288, W_T = 9 * MiB, W_UKV = 11 * MiB, W_UQ = 11 * MiB + 524288, W_FO = 12 * MiB, W_MO = 13 * MiB,
                 W_GO = 14 * MiB, W_O = 15 * MiB, W_1 = 17 * MiB, W_2 = 25 * MiB;
constexpr size_t WS_XC = 54 * MiB;
constexpr size_t WS_HB = 62 * MiB;
constexpr size_t WS_CKV = 98 * MiB, WS_CQ = 107 * MiB, WS_KG = 116 * MiB, WS_VG = 120 * MiB + 524288, WS_QG = 125 * MiB, WS_KR = 143 * MiB;
constexpr size_t WS_KN = 145 * MiB, WS_VM = 163 * MiB, WS_QM = 181 * MiB;
constexpr size_t WS_F = 208 * MiB, WS_AM = 226 * MiB;
constexpr size_t WS_GATE = 244 * MiB, WS_TF = 352 * MiB, WS_TFC = 384 * MiB, WS_U = 244 * MiB;
constexpr size_t WS_END = 388 * MiB;

constexpr int LDS_BYTES = 147456, RING_BYTES = 131072, MISC_OFF = RING_BYTES + 320;

struct Params {
    const float* in[25];
    float* out;
    unsigned char* ws;
    int ph_lo, ph_hi;
};
enum { I_X = 0, I_C, I_CTX, I_CCTX, I_WADA, I_BADA, I_WIN, I_BGATE, I_MQG, I_MKVG, I_WUQ, I_WUK, I_WUV, I_GQG, I_GKG, I_WFO, I_WMO, I_WGO, I_WO,
       I_LN1G, I_LN1B, I_W1, I_W2, I_LN2G, I_LN2B };

DI unsigned pk2(float lo, float hi) { f32x2 v = {lo, hi}; bf16x2_t b = __builtin_convertvector(v, bf16x2_t); return __builtin_bit_cast(unsigned, b); }
DI u32x4 pk8(const f32x4& a, const f32x4& b) { u32x4 w; w.x = pk2(a[0], a[1]); w.y = pk2(a[2], a[3]); w.z = pk2(b[0], b[1]); w.w = pk2(b[2], b[3]); return w; }
DI float bf2f(unsigned short h) { return __uint_as_float((unsigned)h << 16); }
DI void unpk8(const u32x4& w, float* f) {
    f[0] = __uint_as_float(w.x << 16); f[1] = __uint_as_float(w.x & 0xffff0000u); f[2] = __uint_as_float(w.y << 16); f[3] = __uint_as_float(w.y & 0xffff0000u);
    f[4] = __uint_as_float(w.z << 16); f[5] = __uint_as_float(w.z & 0xffff0000u); f[6] = __uint_as_float(w.w << 16); f[7] = __uint_as_float(w.w & 0xffff0000u);
}
DI float shx(float v, int m, int lane) { return __int_as_float(__builtin_amdgcn_ds_bpermute((lane ^ m) << 2, __float_as_int(v))); }
DI float wave_sum(float v, int lane) {
#pragma unroll
    for (int o = 1; o < 64; o <<= 1) v += shx(v, o, lane);
    return v;
}

#define XB_TMO      128
#define XB_XCNT(j)  (256  + 64 * (j))
#define XB_XSUB(j)  (1280 + 64 * (j))
#define XB_XGEN(j)  (2304 + 64 * (j))
#define XB_TOP      3328
#define XB_TOPGEN   3392
#define XB_SPIN_CAP (1u << 22)
DI unsigned xb_ld(unsigned* p)              { return __hip_atomic_load(p, __ATOMIC_RELAXED, __HIP_MEMORY_SCOPE_AGENT); }
DI unsigned xb_add(unsigned* p, unsigned v) { return __hip_atomic_fetch_add(p, v, __ATOMIC_RELAXED, __HIP_MEMORY_SCOPE_AGENT); }
DI unsigned xb_xcc_id() { return (unsigned)__builtin_amdgcn_s_getreg((3 << 11) | 20) & 0xFu; }
#define XB_SPIN(cond, bar) do { unsigned _sp = 0; while (cond) { __builtin_amdgcn_s_sleep(1); \
    if ((++_sp & 255u) == 0u) { if (xb_ld(&(bar)[XB_TMO])) break; if (_sp > XB_SPIN_CAP) { atomicAdd(&(bar)[XB_TMO], 1u); break; } } } } while (0)
struct XcdBarrier { unsigned* bar; unsigned x; volatile LAS unsigned* st; };
DI XcdBarrier xcd_barrier_post(unsigned* bar, volatile LAS unsigned* st) {
    XcdBarrier b; b.bar = bar; b.x = xb_xcc_id(); b.st = st;
    if (threadIdx.x == 0) (void)xb_add(&bar[XB_XCNT(b.x)], 1u);
    return b;
}
DI void xcd_barrier_complete(unsigned* bar, unsigned x, unsigned& nloc, unsigned& nx) {
    const unsigned G = gridDim.x * gridDim.y * gridDim.z;
    unsigned sum, cnt, mine, sp = 0u;
    for (;;) {
        sum = 0u; cnt = 0u; mine = 0u;
#pragma unroll
        for (unsigned j = 0; j < 16; ++j) { const unsigned c = xb_ld(&bar[XB_XCNT(j)]); sum += c; cnt += (c > 0u) ? 1u : 0u; mine = (j == x) ? c : mine; }
        if (sum == G) break;
        __builtin_amdgcn_s_sleep(1);
        if ((++sp & 255u) == 0u) { if (xb_ld(&bar[XB_TMO])) break; if (sp > XB_SPIN_CAP) { atomicAdd(&bar[XB_TMO], 1u); break; } }
    }
    nloc = mine > 0u ? mine : 1u; nx = cnt > 0u ? cnt : 1u;
}
DI void xcd_barrier(const XcdBarrier& b, const int tid) {
    asm volatile("s_waitcnt vmcnt(0)" ::: "memory");
    __syncthreads();
    if (tid == 0) {
        unsigned* bar = b.bar;
        __builtin_amdgcn_s_waitcnt(0);
        unsigned nloc = b.st[0], nx = b.st[1];
        const unsigned old = xb_add(&bar[XB_XSUB(b.x)], 1u);
        const unsigned gen = old / nloc;
        if (old + 1u == (gen + 1u) * nloc) {
            __builtin_amdgcn_fence(__ATOMIC_RELEASE, "agent");
            asm volatile("s_waitcnt vmcnt(0)" ::: "memory");
            const unsigned og = xb_add(&bar[XB_TOP], 1u);
            const unsigned tg = og / nx;
            if (og + 1u == (tg + 1u) * nx) xb_add(&bar[XB_TOPGEN], 1u);
            else XB_SPIN(xb_ld(&bar[XB_TOPGEN]) == tg, bar);
            __builtin_amdgcn_fence(__ATOMIC_ACQUIRE, "agent");
            xb_add(&bar[XB_XGEN(b.x)], 1u);
            asm volatile("s_waitcnt vmcnt(0)" ::: "memory");
        } else {
            XB_SPIN(xb_ld(&bar[XB_XGEN(b.x)]) == gen, bar);
            __builtin_amdgcn_fence(__ATOMIC_ACQUIRE, "agent");
            asm volatile("s_waitcnt vmcnt(0)" ::: "memory");
        }
    }
    __syncthreads();
}

namespace pg8 {
constexpr int BM = 256, BK = 64, HALF = 128, HTB = HALF * BK * 2;
DI int lds_byte(int r, int c) { const int st = (r >> 4) * 2 + (c >> 5), rr = r & 15, cc = c & 31, ob = rr * 64 + cc * 2; return st * 1024 + (ob ^ (((ob >> 9) & 1) << 5)); }
DI void stage_rc(int b, int& R, int& C) { const int st = b / 1024, sb = b % 1024, swz = sb ^ (((sb >> 9) & 1) << 5); R = (st >> 1) * 16 + swz / 64; C = (st & 1) * 32 + (swz % 64) / 2; }
DI int perm32(int rho) { const int n = rho >> 4, i = rho & 15; return 8 * (i >> 2) + 4 * n + (i & 3); }

struct Unit { const char* A; const char* B; int job, pm, pn, z, seg; bool last; };
struct JobD { const char* A; const char* B; int nM, nN, nZ; long Az, Bz; };
DI void decode(const JobD& j, int t, long tileBytes, int jobid, Unit& u) {
    const int nMt = j.nM * j.nZ, nwg = nMt * j.nN;
    int wg; { const int q = nwg >> 3, r = nwg & 7, xcd = t & 7, off = t >> 3; wg = (xcd < r ? xcd * (q + 1) : r * (q + 1) + (xcd - r) * q) + off; }
    const int nig = 8 * j.nN, gid = wg / nig, fm = gid * 8, gsz = (nMt - fm) < 8 ? (nMt - fm) : 8;
    const int rem = wg - gid * nig, pn = rem / gsz, pmt = fm + (rem - pn * gsz);
    const int z = pmt / j.nM, pm = pmt - z * j.nM;
    u.A = j.A + (long)z * j.Az + (long)pm * tileBytes; u.B = j.B + (long)z * j.Bz + (long)pn * tileBytes;
    u.job = jobid; u.pm = pm; u.pn = pn; u.z = z; u.seg = 0; u.last = true;
}
struct Sched2 {
    JobD j0, j1; int n0, total, G, c; long tileBytes;
    DI bool next(int i, Unit& u) const {
        const long L = (long)i * G + c; if (L >= total) return false;
        if ((int)L < n0) decode(j0, (int)L, tileBytes, 0, u); else decode(j1, (int)L - n0, tileBytes, 1, u);
        return true;
    }
};
struct Sched3 {
    JobD j; const char* A1; const char* A2; const char* B1; const char* B2; int ntiles, G, c; long tileBytes;
    DI bool next(int i, Unit& u) const {
        const int ti = i / 3, seg = i - ti * 3; const long L = (long)ti * G + c; if (L >= ntiles) return false;
        decode(j, (int)L, tileBytes, 0, u);
        if (seg == 1) { u.A = A1 + (u.A - j.A); u.B = B1 + (u.B - j.B); }
        if (seg == 2) { u.A = A2 + (u.A - j.A); u.B = B2 + (u.B - j.B); }
        u.seg = seg; u.last = (seg == 2);
        return true;
    }
};

typedef f32x4 Acc[2][2][4][2];
template <int PITCH = 0, class Epi, class Sched>
DI void gemm_phase(LAS unsigned char* lds, const int K_, const Sched& S, const Epi& E, const int tid_in) {
    int Kq = K_; asm volatile("" : "+s"(Kq)); const int K = Kq & 0x1fc0;
    int tid_ = tid_in;
#ifndef NO_OPQ_TID
    asm volatile("" : "+v"(tid_));
#endif
    const int tid = tid_ & 511, wid = __builtin_amdgcn_readfirstlane(tid >> 6), lane = tid & 63, wr = wid >> 2, wc = wid & 3, fr = lane & 15, fq = lane >> 4;
    const int nt = K / BK;
    unsigned voffA[2], voffB[2];
#pragma unroll
    for (int i = 0; i < 2; ++i) { int R, C; stage_rc(tid * 16 + i * 8192, R, C); const int Rb = (R & ~31) + perm32(R & 31);
        voffA[i] = (unsigned)(R * (PITCH ? PITCH : K) + C) * 2u; voffB[i] = (unsigned)(Rb * (PITCH ? PITCH : K) + C) * 2u; }
    const size_t kstep = (size_t)(BK * 2);
    const size_t hstep = (size_t)HALF * (PITCH ? PITCH : K) * 2;
    const unsigned ldsw = (unsigned)wid * 1024u;
    const int aoff = lds_byte(wr * 64 + fr, fq * 8), boff = lds_byte(wc * 32 + fr, fq * 8);
#define PG8_SA(b, h) (((b) * 2 + (h)) * HTB)
#define PG8_SB(b, h) ((4 + (b) * 2 + (h)) * HTB)
#define PG8_STAGE(bufoff, gbase, voff) do { _Pragma("unroll") for (int _i = 0; _i < 2; ++_i) \
        __builtin_amdgcn_global_load_lds((const unsigned*)((const char*)(gbase) + (voff)[_i]), (LAS unsigned*)(lds + (bufoff) + ldsw + _i * 8192), 16, 0, 0); } while (0)
#define PG8_LDA(dst, b, h) do { _Pragma("unroll") for (int m = 0; m < 4; ++m) _Pragma("unroll") for (int k = 0; k < 2; ++k) dst[m][k] = *(const LAS bf16x8*)(lds + PG8_SA(b, h) + aoff + m * 2048 + k * 1024); } while (0)
#define PG8_LDB(dst, b, h) do { _Pragma("unroll") for (int n = 0; n < 2; ++n) _Pragma("unroll") for (int k = 0; k < 2; ++k) dst[n][k] = *(const LAS bf16x8*)(lds + PG8_SB(b, h) + boff + n * 2048 + k * 1024); } while (0)
#define PG8_MMA(ai, bj, At, Bt) do { __builtin_amdgcn_s_setprio(1); _Pragma("unroll") for (int m = 0; m < 4; ++m) _Pragma("unroll") for (int n = 0; n < 2; ++n) _Pragma("unroll") for (int k = 0; k < 2; ++k) \
        acc[ai][bj][m][n] = __builtin_amdgcn_mfma_f32_16x16x32_bf16(Bt[n][k], At[m][k], acc[ai][bj][m][n], 0, 0, 0); __builtin_amdgcn_s_setprio(0); } while (0)
#define PG8_WAIT_V(n) asm volatile("s_waitcnt vmcnt(" #n ")" ::: "memory")
#define PG8_WAIT_L(n) asm volatile("s_waitcnt lgkmcnt(" #n ")" ::: "memory")
#define PG8_BAR __builtin_amdgcn_s_barrier()
#define PG8_SCHED __builtin_amdgcn_sched_barrier(0)
    Unit cur, nxt; int ui = 0;
    if (!S.next(0, cur)) return;
    Acc acc;
#pragma unroll
    for (int a = 0; a < 2; ++a)
#pragma unroll
        for (int b = 0; b < 2; ++b)
#pragma unroll
            for (int m = 0; m < 4; ++m)
#pragma unroll
                for (int n = 0; n < 2; ++n) acc[a][b][m][n] = (f32x4){0.f, 0.f, 0.f, 0.f};
    bf16x8 At[4][2], B0[2][2], B1[2][2];
    const char* cA = cur.A; const char* cB = cur.B;
    PG8_STAGE(PG8_SB(0, 0), cB, voffB); PG8_STAGE(PG8_SB(0, 1), cB + hstep, voffB); PG8_STAGE(PG8_SA(0, 0), cA, voffA); PG8_STAGE(PG8_SA(0, 1), cA + hstep, voffA);
    if (wr == 1) PG8_BAR;
    PG8_WAIT_V(2); PG8_BAR;
    PG8_STAGE(PG8_SB(1, 0), cB + kstep, voffB); PG8_STAGE(PG8_SA(1, 0), cA + kstep, voffA); PG8_STAGE(PG8_SB(1, 1), cB + hstep + kstep, voffB);
    PG8_WAIT_V(6); PG8_BAR;
    for (;;) {
        const bool has_next = S.next(ui + 1, nxt);
        const char* nA = has_next ? nxt.A : cA; const char* nB = has_next ? nxt.B : cB;
        for (int t = 0; t < nt; t += 2) {
            const bool last = (t == nt - 2);
            const char* a1 = cA + (size_t)(t + 1) * kstep;
            const char* a2 = last ? nA : cA + (size_t)(t + 2) * kstep; const char* b2 = last ? nB : cB + (size_t)(t + 2) * kstep;
            const char* a3 = a2 + kstep; const char* b3 = b2 + kstep;
            PG8_LDB(B0, 0, 0); PG8_LDB(B1, 0, 1); PG8_SCHED; PG8_LDA(At, 0, 0); PG8_STAGE(PG8_SA(1, 1), a1 + hstep, voffA);
            PG8_WAIT_V(8); PG8_WAIT_L(0); PG8_BAR; PG8_MMA(0, 0, At, B0); PG8_MMA(0, 1, At, B1); PG8_BAR; PG8_SCHED;
            PG8_LDA(At, 0, 1); PG8_STAGE(PG8_SB(0, 0), b2, voffB); PG8_STAGE(PG8_SB(0, 1), b2 + hstep, voffB); PG8_STAGE(PG8_SA(0, 0), a2, voffA);
            PG8_WAIT_V(8); PG8_WAIT_L(0); PG8_BAR; PG8_MMA(1, 0, At, B0); PG8_MMA(1, 1, At, B1); PG8_BAR; PG8_SCHED;
            PG8_LDB(B0, 1, 0); PG8_LDB(B1, 1, 1); PG8_SCHED; PG8_LDA(At, 1, 0); PG8_STAGE(PG8_SA(0, 1), a2 + hstep, voffA);
            PG8_WAIT_V(8); PG8_WAIT_L(0); PG8_BAR; PG8_MMA(0, 0, At, B0); PG8_MMA(0, 1, At, B1); PG8_BAR; PG8_SCHED;
            PG8_LDA(At, 1, 1); PG8_STAGE(PG8_SB(1, 0), b3, voffB); PG8_STAGE(PG8_SB(1, 1), b3 + hstep, voffB); PG8_STAGE(PG8_SA(1, 0), a3, voffA);
            PG8_WAIT_V(8); PG8_WAIT_L(0); PG8_BAR; PG8_MMA(1, 0, At, B0); PG8_MMA(1, 1, At, B1); PG8_BAR; PG8_SCHED;
        }
        if (wr == 0) PG8_BAR;
        E(acc, cur, wr, wc, fr, fq);
        if (!has_next) break;
        if (cur.last) {
#pragma unroll
            for (int a = 0; a < 2; ++a)
#pragma unroll
                for (int b = 0; b < 2; ++b)
#pragma unroll
                    for (int m = 0; m < 4; ++m)
#pragma unroll
                        for (int n = 0; n < 2; ++n) acc[a][b][m][n] = (f32x4){0.f, 0.f, 0.f, 0.f};
        }
        cur = nxt; cA = nA; cB = nB; ++ui;
        if (wr == 1) PG8_BAR;
    }
    PG8_WAIT_V(0);
    PG8_BAR;
#undef PG8_SA
#undef PG8_SB
#undef PG8_STAGE
#undef PG8_LDA
#undef PG8_LDB
#undef PG8_MMA
#undef PG8_WAIT_V
#undef PG8_WAIT_L
#undef PG8_BAR
#undef PG8_SCHED
}
}
using pg8::Acc; using pg8::Unit;

struct Frame {
    const Params* P;
    unsigned char* ws;
    LAS unsigned char* lds;
    int tid, lane, wave, G, bid, vcu;
    int l;
    int zo;
};
DI const float* pin(const Frame& F, int idx) { return F.P->in[idx + F.zo]; }
DI const float* inl(const Frame& F, int idx, size_t per_layer) { return pin(F, idx) + (size_t)F.l * per_layer; }
DI const float* modp(const Frame& F, int l, int mr, int which) { return (const float*)(F.ws + WS_MOD) + ((size_t)(l * 9 + mr) * 6 + which) * 1024; }
DI int modrow_of_tile(int row0) { return row0 < ML ? (row0 >> 11) : 8; }
DI float* xrow_ptr(const Frame& F, int row) { return row < ML ? F.P->out + (size_t)row * D : (float*)(F.ws + WS_XC) + (size_t)(row - ML) * D; }
DI const float* xin_ptr(const Frame& F, int row) {
    if (F.l == 0) return row < ML ? pin(F, I_X) + (size_t)row * D : pin(F, I_CTX) + (size_t)(row - ML) * D;
    return xrow_ptr(F, row);
}

#define EPI_ROWS(ai, m) (128 * (ai) + 64 * wr + 16 * (m) + fr)
#define EPI_COL8(bj) (128 * (bj) + 32 * wc + 8 * fq)
#define FOR_AI_M _Pragma("unroll") for (int ai = 0; ai < 2; ++ai) _Pragma("unroll") for (int m = 0; m < 4; ++m)
#define ROW_FENCE asm volatile("" ::: "memory")

struct EpiG1 {
    const Frame& F;
    DI void operator()(Acc& acc, const Unit& u, int wr, int wc, int fr, int fq) const {
        unsigned char* ws = F.ws;
        if (u.job == 1) {
            bf16_t* base; int ld;
            if (u.pn < 64) { base = (bf16_t*)(ws + WS_TF) + (size_t)(u.pn >> 3) * 1024 * 2048 + (u.pn & 7) * 256; ld = 2048; }
            else { base = (bf16_t*)(ws + WS_TFC) + (size_t)(u.pn - 64) * 1024 * 256; ld = 256; }
            FOR_AI_M { const int r = u.pm * 256 + EPI_ROWS(ai, m);
#pragma unroll
                for (int bj = 0; bj < 2; ++bj) *(u32x4*)(base + (size_t)r * ld + EPI_COL8(bj)) = pk8(acc[ai][bj][m][0], acc[ai][bj][m][1]); }
            return;
        }
        const int row0 = u.pm * 256;
        if (u.pn <= 1) {
            bf16_t* dst = (bf16_t*)(ws + (u.pn == 0 ? WS_CKV : WS_CQ)); float* ss = (float*)(ws + (u.pn == 0 ? WS_SSKV : WS_SSQ));
            FOR_AI_M { const int r = row0 + EPI_ROWS(ai, m); float s = 0.f;
#pragma unroll
                for (int bj = 0; bj < 2; ++bj) { const f32x4 a = acc[ai][bj][m][0], b = acc[ai][bj][m][1];
                    s += (a[0] * a[0] + a[1] * a[1]) + (a[2] * a[2] + a[3] * a[3]) + (b[0] * b[0] + b[1] * b[1]) + (b[2] * b[2] + b[3] * b[3]);
                    *(u32x4*)(dst + (size_t)r * 256 + EPI_COL8(bj)) = pk8(a, b); }
                s += shx(s, 16, fr + 16 * fq); s += shx(s, 32, fr + 16 * fq);
                if (fq == 0) ss[(size_t)r * 4 + wc] = s; }
            return;
        }
        if (u.pn >= 5) {
            const int cb = (u.pn - 5) * 256; const float* bg = inl(F, I_BGATE, 3072) + cb; bf16_t* dst = (bf16_t*)(ws + WS_GATE) + cb;
            f32x4 bv[2][2];
#pragma unroll
            for (int bj = 0; bj < 2; ++bj) { bv[bj][0] = *(const f32x4*)(bg + EPI_COL8(bj)); bv[bj][1] = *(const f32x4*)(bg + EPI_COL8(bj) + 4); }
            FOR_AI_M { const int r = row0 + EPI_ROWS(ai, m);
#pragma unroll
                for (int bj = 0; bj < 2; ++bj) { f32x4 a = acc[ai][bj][m][0] + bv[bj][0], b = acc[ai][bj][m][1] + bv[bj][1];
#pragma unroll
                    for (int e = 0; e < 4; ++e) { a[e] = __builtin_amdgcn_rcpf(1.f + __builtin_amdgcn_exp2f(-1.4426950408889634f * a[e])); b[e] = __builtin_amdgcn_rcpf(1.f + __builtin_amdgcn_exp2f(-1.4426950408889634f * b[e])); }
                    *(u32x4*)(dst + (size_t)r * 3072 + EPI_COL8(bj)) = pk8(a, b); } }
            return;
        }
        const bool is_q = (u.pn >= 3);
        const bool is_v = (!is_q) && (wc >= 2);
        const float* gain = is_q ? inl(F, I_GQG, 64) : inl(F, I_GKG, 64);
        f32x4 gv[2][2];
#pragma unroll
        for (int bj = 0; bj < 2; ++bj) { gv[bj][0] = *(const f32x4*)(gain + 32 * bj + 8 * fq); gv[bj][1] = *(const f32x4*)(gain + 32 * bj + 8 * fq + 4); }
        bf16_t* dst; int ld, colb;
        if (is_q) { dst = (bf16_t*)(ws + WS_QG); ld = 512; colb = ((u.pn - 3) * 4 + wc) * 64; }
        else if (!is_v) { dst = (bf16_t*)(ws + WS_KG); ld = 128; colb = wc * 64; }
        else { dst = (bf16_t*)(ws + WS_VG); ld = 128; colb = (wc - 2) * 64; }
        const bool rope = (row0 < ML);
        const float* rg = (const float*)(ws + WS_ROPEG);
        const float qs = is_q ? QS_GQA : 1.f;
        FOR_AI_M { const int r = row0 + EPI_ROWS(ai, m);
            f32x4 x[2][2];
#pragma unroll
            for (int bj = 0; bj < 2; ++bj) { x[bj][0] = acc[ai][bj][m][0]; x[bj][1] = acc[ai][bj][m][1]; }
            if (!is_v) {
                float s = 0.f;
#pragma unroll
                for (int bj = 0; bj < 2; ++bj)
#pragma unroll
                    for (int n = 0; n < 2; ++n) s += (x[bj][n][0] * x[bj][n][0] + x[bj][n][1] * x[bj][n][1]) + (x[bj][n][2] * x[bj][n][2] + x[bj][n][3] * x[bj][n][3]);
                s += shx(s, 16, fr + 16 * fq); s += shx(s, 32, fr + 16 * fq);
                const float rstd = 1.f / sqrtf(s * (1.f / 64.f) + EPS);
#pragma unroll
                for (int bj = 0; bj < 2; ++bj)
#pragma unroll
                    for (int n = 0; n < 2; ++n) x[bj][n] = x[bj][n] * rstd * gv[bj][n];
                if (rope) {
                    const float* rr = rg + (size_t)(r & 2047) * 64 + 8 * fq;
#pragma unroll
                    for (int n = 0; n < 2; ++n) { const f32x4 cs = *(const f32x4*)(rr + 4 * n), sn = *(const f32x4*)(rr + 32 + 4 * n);
                        const f32x4 x1 = x[0][n], x2 = x[1][n]; x[0][n] = x1 * cs - x2 * sn; x[1][n] = x1 * sn + x2 * cs; }
                }
#pragma unroll
                for (int bj = 0; bj < 2; ++bj)
#pragma unroll
                    for (int n = 0; n < 2; ++n) x[bj][n] = x[bj][n] * qs;
            }
#pragma unroll
            for (int bj = 0; bj < 2; ++bj) *(u32x4*)(dst + (size_t)r * ld + colb + 32 * bj + 8 * fq) = pk8(x[bj][0], x[bj][1]);
            if (m & 1) ROW_FENCE;
        }
    }
};

struct EpiG2 {
    const Frame& F;
    DI void operator()(Acc& acc, const Unit& u, int wr, int wc, int fr, int fq) const {
        unsigned char* ws = F.ws; const int row0 = u.pm * 256;
        const float* ss = (const float*)(ws + (u.job == 0 ? WS_SSKV : WS_SSQ));
        bf16_t* dst; int ld; float sc = 1.f;
        if (u.job == 0) { dst = (bf16_t*)(ws + (u.pn < 2 ? WS_KN : WS_VM)) + (u.pn & 1) * 256; ld = 512; }
        else { dst = (bf16_t*)(ws + WS_QM); ld = 768; sc = QS_MLA; }
        const bool ropet = (u.job == 1 && u.pn == 2);
        const bool rope = ropet && row0 < ML;
        const float* rm = (const float*)(ws + WS_ROPEM) + 4 * fq;
        int colv[2];
#pragma unroll
        for (int bj = 0; bj < 2; ++bj) {
            if (u.job == 0) colv[bj] = EPI_COL8(bj);
            else if (!ropet) { const int c = u.pn * 256 + EPI_COL8(bj); colv[bj] = (c >> 6) * 96 + (c & 63); }
            else { const int c = EPI_COL8(bj); colv[bj] = (c >> 5) * 96 + 64 + (c & 31); }
        }
        FOR_AI_M { const int r = row0 + EPI_ROWS(ai, m);
            const f32x4 s4 = *(const f32x4*)(ss + (size_t)r * 4);
            const float rstd = sc * __builtin_amdgcn_rsqf(((s4[0] + s4[1]) + (s4[2] + s4[3])) * (1.f / 256.f) + EPS);
            f32x4 cs = {1.f, 1.f, 1.f, 1.f}, sn = {0.f, 0.f, 0.f, 0.f};
            if (rope) { const float* rr = rm + (size_t)(r & 2047) * 32; cs = *(const f32x4*)rr; sn = *(const f32x4*)(rr + 16); }
#pragma unroll
            for (int bj = 0; bj < 2; ++bj) {
                const f32x4 x1 = acc[ai][bj][m][0] * rstd, x2 = acc[ai][bj][m][1] * rstd;
                f32x4 a = x1, b = x2;
                if (ropet) { a = x1 * cs - x2 * sn; b = x1 * sn + x2 * cs; }
                *(u32x4*)(dst + (size_t)r * ld + colv[bj]) = pk8(a, b);
            }
            ROW_FENCE;
        }
    }
};

struct EpiDft {
    bf16_t* dst; int zrows, ld;
    DI void operator()(Acc& acc, const Unit& u, int wr, int wc, int fr, int fq) const {
        FOR_AI_M { const int r = u.z * zrows + u.pm * 256 + EPI_ROWS(ai, m);
#pragma unroll
            for (int bj = 0; bj < 2; ++bj) *(u32x4*)(dst + (size_t)r * ld + u.pn * 256 + EPI_COL8(bj)) = pk8(acc[ai][bj][m][0], acc[ai][bj][m][1]); }
    }
};

struct EpiG3 {
    const Frame& F;
    DI void operator()(Acc& acc, const Unit& u, int wr, int wc, int fr, int fq) const {
        const bf16_t* gate = (const bf16_t*)(F.ws + WS_GATE); bf16_t* Y = (bf16_t*)(F.ws + WS_HB);
        const int row0 = u.pm * 256, col0 = u.pn * 256;
        const int s1 = u.seg < 2 ? u.seg + 1 : u.seg;
#pragma unroll
        for (int aim = 0; aim < 4; ++aim) { const int ai = aim >> 1, mb = (aim & 1) * 2;
            u32x4 ga[4][2], gb[4][2];
#pragma unroll
            for (int m = mb; m < mb + 2; ++m)
#pragma unroll
                for (int bj = 0; bj < 2; ++bj) { const size_t o = (size_t)(row0 + EPI_ROWS(ai, m)) * 3072 + col0 + EPI_COL8(bj);
                    ga[m][bj] = *(const u32x4*)(gate + o + u.seg * 1024); if (u.seg < 2) gb[m][bj] = *(const u32x4*)(gate + o + s1 * 1024); }
#pragma unroll
            for (int m = mb; m < mb + 2; ++m) { const int r = row0 + EPI_ROWS(ai, m);
#pragma unroll
                for (int bj = 0; bj < 2; ++bj) {
                    float g0[8]; unpk8(ga[m][bj], g0);
                    if (u.seg < 2) { float g1[8]; unpk8(gb[m][bj], g1);
#pragma unroll
                        for (int e = 0; e < 8; ++e) g0[e] = g0[e] * __builtin_amdgcn_rcpf(fmaxf(g1[e], 1e-20f)); }
#pragma unroll
                    for (int e = 0; e < 4; ++e) { acc[ai][bj][m][0][e] *= g0[e]; acc[ai][bj][m][1][e] *= g0[4 + e]; }
                    if (u.seg == 2) *(u32x4*)(Y + (size_t)r * 1024 + col0 + EPI_COL8(bj)) = pk8(acc[ai][bj][m][0], acc[ai][bj][m][1]);
                }
            }
            ROW_FENCE;
        }
    }
};

struct EpiRes {
    const Frame& F; int which; bool from_input;
    int lnmode;
    DI void operator()(Acc& acc, const Unit& u, int wr, int wc, int fr, int fq) const {
        const int row0 = u.pm * 256, col0 = u.pn * 256;
        const float* g = modp(F, F.l, modrow_of_tile(row0), which) + col0;
        const bool ln = (lnmode != 0) && row0 < ML;
        const float* st = (const float*)(F.ws + (lnmode == 1 ? WS_ST1 : WS_ST2));
        const float* lg = lnmode == 1 ? pin(F, I_LN1G) + F.l * 1024 : pin(F, I_LN2G) + (F.l > 0 ? F.l - 1 : 0) * 1024;
        const float* lb = lnmode == 1 ? pin(F, I_LN1B) + F.l * 1024 : pin(F, I_LN2B) + (F.l > 0 ? F.l - 1 : 0) * 1024;
        {
#pragma unroll
            for (int bj = 0; bj < 2; ++bj) {
                f32x4 gv0 = *(const f32x4*)(g + EPI_COL8(bj)), gv1 = *(const f32x4*)(g + EPI_COL8(bj) + 4);
                f32x4 c0 = {0.f, 0.f, 0.f, 0.f}, c1 = {0.f, 0.f, 0.f, 0.f};
                if (ln) { c0 = *(const f32x4*)(lb + col0 + EPI_COL8(bj)) * ALPHA; c1 = *(const f32x4*)(lb + col0 + EPI_COL8(bj) + 4) * ALPHA; }
#pragma unroll
                for (int ai = 0; ai < 2; ++ai)
#pragma unroll
                    for (int m = 0; m < 4; ++m) { acc[ai][bj][m][0] = acc[ai][bj][m][0] * gv0 + c0; acc[ai][bj][m][1] = acc[ai][bj][m][1] * gv1 + c1; }
            }
        }
        f32x4 la[2][2];
#pragma unroll
        for (int bj = 0; bj < 2; ++bj) {
#pragma unroll
            for (int n = 0; n < 2; ++n) la[bj][n] = (f32x4){ALPHA, ALPHA, ALPHA, ALPHA};
            if (ln) {
#pragma unroll
                for (int n = 0; n < 2; ++n) la[bj][n] = *(const f32x4*)(lg + col0 + EPI_COL8(bj) + 4 * n) * ALPHA; } }
        const float* xib = (from_input ? xin_ptr(F, row0) : xrow_ptr(F, row0)) + col0; float* xob = xrow_ptr(F, row0) + col0;
        int oz_ = 0; asm volatile("" : "+v"(oz_));
#pragma unroll
        for (int aim = 0; aim < 8; ++aim) { const int ai = aim >> 2, m = aim & 3;
            f32x4 xa[2][2]; f32x2 sv = {0.f, 1.f};
            if (ln) sv = *(const f32x2*)(st + 2 * (size_t)(row0 + EPI_ROWS(ai, m) + oz_));
#pragma unroll
            for (int bj = 0; bj < 2; ++bj) { const float* p = xib + (size_t)(EPI_ROWS(ai, m) + oz_) * D + EPI_COL8(bj); xa[bj][0] = *(const f32x4*)p; xa[bj][1] = *(const f32x4*)(p + 4); }
#pragma unroll
            for (int bj = 0; bj < 2; ++bj) { float* p = xob + (size_t)(EPI_ROWS(ai, m) + oz_) * D + EPI_COL8(bj);
                *(f32x4*)p = ((xa[bj][0] - sv[0]) * sv[1]) * la[bj][0] + acc[ai][bj][m][0];
                *(f32x4*)(p + 4) = ((xa[bj][1] - sv[0]) * sv[1]) * la[bj][1] + acc[ai][bj][m][1]; }
            if (m & 1) ROW_FENCE;
        }
    }
};

struct EpiSlab {
    float* slab;
    DI void operator()(Acc& acc, const Unit& u, int wr, int wc, int fr, int fq) const {
        FOR_AI_M { const int r = u.z * MC + u.pm * 256 + EPI_ROWS(ai, m);
#pragma unroll
            for (int bj = 0; bj < 2; ++bj) { float* o = slab + (size_t)r * 1024 + u.pn * 256 + EPI_COL8(bj);
                *(f32x4*)o = acc[ai][bj][m][0]; *(f32x4*)(o + 4) = acc[ai][bj][m][1]; } }
    }
};

struct EpiW1 {
    const Frame& F;
    DI void operator()(Acc& acc, const Unit& u, int wr, int wc, int fr, int fq) const {
        bf16_t* U = (bf16_t*)(F.ws + WS_U);
        FOR_AI_M { const int r = u.pm * 256 + EPI_ROWS(ai, m);
#pragma unroll
            for (int bj = 0; bj < 2; ++bj) { f32x4 a = acc[ai][bj][m][0], b = acc[ai][bj][m][1];
#pragma unroll
                for (int e = 0; e < 4; ++e) { const float x = fmaxf(a[e], 0.f), y = fmaxf(b[e], 0.f); a[e] = x * x; b[e] = y * y; }
                *(u32x4*)(U + (size_t)r * DFF + u.pn * 256 + EPI_COL8(bj)) = pk8(a, b); } }
    }
};

#define MFMA32(a, b, c) __builtin_amdgcn_mfma_f32_32x32x16_bf16((a), (b), (c), 0, 0, 0)
constexpr int ATT_KBUF = 14336;
constexpr int ATT_KR = 9216, ATT_VB = 28672, ATT_VBUF = 8192, ATT_OST = 57344;
template <int KIND>
DI void attn_unit(const Frame& F, int qrow0, int head, int ctx_row0, int lat_row0, int ntiles) {
    constexpr int ND = KIND == 0 ? 6 : 4;
    unsigned char* ws = F.ws; LAS unsigned char* lds = F.lds;
    int tid_ = F.tid; asm volatile("" : "+v"(tid_));
    const int tid = tid_ & 511, lane = tid & 63, w = __builtin_amdgcn_readfirstlane(tid >> 6), r32 = lane & 31, h5 = lane >> 5;
    const bf16_t *Kp, *Vp, *Qp; bf16_t* Op; int ldk, ldq, ldo;
    if (KIND == 0) { Kp = (const bf16_t*)(ws + WS_KN) + head * 64; Vp = (const bf16_t*)(ws + WS_VM) + head * 64; ldk = 512; Qp = (const bf16_t*)(ws + WS_QM) + head * 96; ldq = 768;
                     Op = (bf16_t*)(ws + WS_AM) + head * 64; ldo = 512; }
    else { Kp = (const bf16_t*)(ws + WS_KG) + (head >> 2) * 64; Vp = (const bf16_t*)(ws + WS_VG) + (head >> 2) * 64; ldk = 128; Qp = (const bf16_t*)(ws + WS_QG) + head * 64; ldq = 512;
           Op = (bf16_t*)(ws + WS_QG) + head * 64; ldo = 512; }
    const bf16_t* Krp = (const bf16_t*)(ws + WS_KR);
    bf16x8 qf[ND];
    { const bf16_t* qr = Qp + (size_t)(qrow0 + 32 * w + r32) * ldq + 8 * h5;
#pragma unroll
      for (int ds = 0; ds < ND; ++ds) qf[ds] = *(const bf16x8*)(qr + 16 * ds); }
    const int skey = tid >> 3, sch = tid & 7;
    const int skey_r = (tid & 255) >> 2, sch_r = tid & 3;
    const unsigned kdst = skey * 144 + sch * 16;
    const unsigned vdst = (sch >> 2) * 4096 + skey * 64 + (sch & 3) * 16;
    const unsigned rdst = ATT_KR + skey_r * 80 + sch_r * 16;
    u32x4 kreg, vreg, rreg;
#define ATT_KEYROW(t) ((t) < 4 ? ctx_row0 + 64 * (t) : lat_row0 + 64 * ((t) - 4))
    const unsigned kbase = r32 * 144 + h5 * 16, rbase = ATT_KR + r32 * 80 + h5 * 16;
    const unsigned voff = (4 * h5 + ((lane & 15) >> 2)) * 64 + ((lane >> 4) & 1) * 32 + (lane & 3) * 8;
    float mref = 0.f, lsum = 0.f;
    f32x16 o0, o1;
#pragma unroll
    for (int i = 0; i < 16; ++i) { o0[i] = 0.f; o1[i] = 0.f; }
#define ATT_QK1(S, buf, kb, C) do { LAS unsigned char* kq_ = lds + (buf) * ATT_KBUF + (kb) * 32 * 144; LAS unsigned char* kr_ = lds + (buf) * ATT_KBUF + (kb) * 32 * 80; \
        bf16x8 kf_[ND]; \
        _Pragma("unroll") for (int ds = 0; ds < ND; ++ds) kf_[ds] = ds < 4 ? *(const LAS bf16x8*)(kq_ + kbase + ds * 32) : *(const LAS bf16x8*)(kr_ + rbase + (ds - 4) * 32); \
        _Pragma("unroll") for (int ds = 0; ds < ND; ++ds) { if (ds == 0) S = MFMA32(kf_[0], qf[0], C); else S = MFMA32(kf_[ds], qf[ds], S); } } while (0)
#define ATT_QKM(S0, S1, buf, C) do { ATT_QK1(S0, buf, 0, C); ATT_QK1(S1, buf, 1, C); } while (0)
#define ATT_VFRAG(dst, vb, kb) do { \
        _Pragma("unroll") for (int s = 0; s < 2; ++s) _Pragma("unroll") for (int db = 0; db < 2; ++db) { \
            const unsigned a_ = voff + db * 4096 + (32 * (kb) + 16 * s) * 64; \
            const s16x4 lo = __builtin_bit_cast(s16x4, __builtin_amdgcn_ds_read_tr16_b64_v4i16((LAS s16x4*)((vb) + a_))); \
            const s16x4 hi = __builtin_bit_cast(s16x4, __builtin_amdgcn_ds_read_tr16_b64_v4i16((LAS s16x4*)((vb) + a_ + 512))); \
            dst[s][db] = __builtin_shufflevector(lo, hi, 0, 1, 2, 3, 4, 5, 6, 7); } } while (0)
#define ATT_PV(PF, vb) do { \
        { bf16x8 va[2][2]; ATT_VFRAG(va, vb, 0); \
          _Pragma("unroll") for (int s = 0; s < 2; ++s) { o0 = MFMA32(va[s][0], PF[0][s], o0); o1 = MFMA32(va[s][1], PF[0][s], o1); } } \
        { bf16x8 vb2[2][2]; ATT_VFRAG(vb2, vb, 1); \
          _Pragma("unroll") for (int s = 0; s < 2; ++s) { o0 = MFMA32(vb2[s][0], PF[1][s], o0); o1 = MFMA32(vb2[s][1], PF[1][s], o1); } } } while (0)
    bf16x8 pfa[2][2], pfb[2][2];
    f32x16 s0, s1, n0, n1;
#define ATT_LOADK2(t, KR_, RR_) do { const int kr_ = ATT_KEYROW(t); KR_ = *(const u32x4*)(Kp + (size_t)(kr_ + skey) * ldk + sch * 8); \
        if (KIND == 0 && tid < 256) RR_ = *(const u32x4*)(Krp + (size_t)(kr_ + skey_r) * 32 + sch_r * 8); } while (0)
#define ATT_LOADV2(t, VR_) do { const int kr_ = ATT_KEYROW(t); VR_ = *(const u32x4*)(Vp + (size_t)(kr_ + skey) * ldk + sch * 8); } while (0)
#define ATT_STOREK2(buf, KR_, RR_) do { LAS unsigned char* b_ = lds + (buf) * ATT_KBUF; *(LAS u32x4*)(b_ + kdst) = KR_; if (KIND == 0 && tid < 256) *(LAS u32x4*)(b_ + rdst) = RR_; } while (0)
#define ATT_STOREV2(vsl, VR_) do { *(LAS u32x4*)(lds + ATT_VB + (vsl) + vdst) = VR_; } while (0)
#define ATT_PACK(PF_, A0, A1) do { _Pragma("unroll") for (int s = 0; s < 2; ++s) { \
            u32x4 a, b; \
            a.x = pk2(A0[8 * s + 0], A0[8 * s + 1]); a.y = pk2(A0[8 * s + 2], A0[8 * s + 3]); a.z = pk2(A0[8 * s + 4], A0[8 * s + 5]); a.w = pk2(A0[8 * s + 6], A0[8 * s + 7]); \
            b.x = pk2(A1[8 * s + 0], A1[8 * s + 1]); b.y = pk2(A1[8 * s + 2], A1[8 * s + 3]); b.z = pk2(A1[8 * s + 4], A1[8 * s + 5]); b.w = pk2(A1[8 * s + 6], A1[8 * s + 7]); \
            PF_[0][s] = __builtin_bit_cast(bf16x8, a); PF_[1][s] = __builtin_bit_cast(bf16x8, b); } } while (0)
#define ATT_BODY(t, KS, VS, RS, KL, VL, RL, C0, C1, N0, N1, PFN, PFP, HAS_PV, HAS_QK) do { \
        const bool more = (t + 1 < ntiles), more2 = (t + 2 < ntiles); \
        if (more2) ATT_LOADK2(t + 2, KS, RS); \
        if (more) ATT_LOADV2(t + 1, VS); \
        if (HAS_QK) { f32x16 ng_; _Pragma("unroll") for (int i = 0; i < 16; ++i) ng_[i] = -mref; ATT_QKM(N0, N1, (t + 1) & 1, ng_); } \
        if (HAS_PV) ATT_PV(PFP, lds + ATT_VB + (vs_c == 0 ? 2 * ATT_VBUF : vs_c - ATT_VBUF)); \
        float psa = 0.f, psb = 0.f; \
        _Pragma("unroll") for (int i = 0; i < 16; ++i) { C0[i] = __builtin_amdgcn_exp2f(C0[i]); C1[i] = __builtin_amdgcn_exp2f(C1[i]); psa += C0[i]; psb += C1[i]; } \
        psa += psb; \
        ATT_PACK(PFN, C0, C1); \
        if (__builtin_expect(__any(psa > BIGP), 0)) { \
            float mx = fmaxf(C0[0], C1[0]); \
            _Pragma("unroll") for (int i = 1; i < 16; ++i) mx = fmaxf(mx, fmaxf(C0[i], C1[i])); \
            { auto rr = __builtin_amdgcn_permlane32_swap(__float_as_uint(mx), __float_as_uint(mx), false, false); mx = fmaxf(__uint_as_float(rr[0]), __uint_as_float(rr[1])); } \
            const float dl = mx > 1.f ? ceilf(__log2f(mx)) : 0.f; const float f = __builtin_amdgcn_exp2f(-dl); \
            mref += dl; lsum *= f; psa *= f; \
            _Pragma("unroll") for (int i = 0; i < 16; ++i) { C0[i] *= f; C1[i] *= f; o0[i] *= f; o1[i] *= f; N0[i] -= dl; N1[i] -= dl; } \
            ATT_PACK(PFN, C0, C1); \
        } \
        lsum += psa; \
        if (more2) ATT_STOREK2(t & 1, KS, RS); \
        if (more) ATT_STOREV2((vs_c == 2 * ATT_VBUF ? 0 : vs_c + ATT_VBUF), VS); \
        asm volatile("s_waitcnt lgkmcnt(0)\n\ts_barrier" ::: "memory"); \
        vs_c = (vs_c == 2 * ATT_VBUF ? 0 : vs_c + ATT_VBUF); \
    } while (0)
    constexpr float BIGP = 65536.f;
    int vs_c = 0;
    ATT_LOADK2(0, kreg, rreg); ATT_LOADV2(0, vreg);
    ATT_STOREK2(0, kreg, rreg); ATT_STOREV2(0, vreg);
    ATT_LOADK2(1, kreg, rreg); ATT_STOREK2(1, kreg, rreg);
    __syncthreads();
    { f32x16 z_; _Pragma("unroll") for (int i = 0; i < 16; ++i) z_[i] = 0.f; ATT_QKM(s0, s1, 0, z_); }
    asm volatile("s_waitcnt lgkmcnt(0)\n\ts_barrier" ::: "memory");
    {
        float mx = fmaxf(s0[0], s1[0]);
#pragma unroll
        for (int i = 1; i < 16; ++i) mx = fmaxf(mx, fmaxf(s0[i], s1[i]));
        { auto rr = __builtin_amdgcn_permlane32_swap(__float_as_uint(mx), __float_as_uint(mx), false, false); mx = fmaxf(__uint_as_float(rr[0]), __uint_as_float(rr[1])); }
        mref = mx;
#pragma unroll
        for (int i = 0; i < 16; ++i) { s0[i] -= mx; s1[i] -= mx; }
    }
    { const int t = 0; ATT_BODY(t, kreg, vreg, rreg, kreg, vreg, rreg, s0, s1, n0, n1, pfa, pfb, 0, 1); }
    for (int t2 = 1; t2 < ntiles - 1; t2 += 2) {
        { const int t = t2; ATT_BODY(t, kreg, vreg, rreg, kreg, vreg, rreg, n0, n1, s0, s1, pfb, pfa, 1, 1); }
        { const int t = t2 + 1; ATT_BODY(t, kreg, vreg, rreg, kreg, vreg, rreg, s0, s1, n0, n1, pfa, pfb, 1, 1); }
    }
    { const int t = ntiles - 1; ATT_BODY(t, kreg, vreg, rreg, kreg, vreg, rreg, n0, n1, s0, s1, pfb, pfa, 1, 0); }
    ATT_PV(pfb, lds + ATT_VB + (vs_c == 0 ? 2 * ATT_VBUF : vs_c - ATT_VBUF));
    { auto rr = __builtin_amdgcn_permlane32_swap(__float_as_uint(lsum), __float_as_uint(lsum), false, false); lsum = __uint_as_float(rr[0]) + __uint_as_float(rr[1]); }
    const float inv = 1.f / lsum;
    {
        LAS unsigned char* stg = lds + ATT_OST + w * 4608;
        LAS unsigned char* mine = stg + r32 * 144 + 8 * h5;
#pragma unroll
        for (int g = 0; g < 4; ++g) {
            u32x2 a, b;
            a.x = pk2(o0[4 * g] * inv, o0[4 * g + 1] * inv); a.y = pk2(o0[4 * g + 2] * inv, o0[4 * g + 3] * inv);
            b.x = pk2(o1[4 * g] * inv, o1[4 * g + 1] * inv); b.y = pk2(o1[4 * g + 2] * inv, o1[4 * g + 3] * inv);
            *(LAS u32x2*)(mine + 16 * g) = a; *(LAS u32x2*)(mine + 64 + 16 * g) = b;
        }
        asm volatile("s_waitcnt lgkmcnt(0)" ::: "memory");
        bf16_t* ob = Op + (size_t)(qrow0 + 32 * w) * ldo;
#pragma unroll
        for (int it = 0; it < 4; ++it) { const int row = it * 8 + (lane >> 3), ch = lane & 7;
            const u32x4 v = *(const LAS u32x4*)(stg + row * 144 + ch * 16);
            *(u32x4*)(ob + (size_t)row * ldo + ch * 8) = v; }
    }
    asm volatile("s_waitcnt lgkmcnt(0)\n\ts_barrier" ::: "memory");
#undef ATT_PV
#undef ATT_PACK
#undef ATT_LOADK
#undef ATT_LOADV
#undef ATT_STOREK
#undef ATT_STOREV
#undef ATT_QK1
#undef ATT_BODY
#undef ATT_LOADK2
#undef ATT_LOADV2
#undef ATT_STOREK2
#undef ATT_STOREV2
#undef ATT_QKM
#undef ATT_VFRAG
#undef ATT_KEYROW
#undef ATT_LOAD
#undef ATT_STORE
}

DI void wave_sum2(float& a, float& b, int lane) {
#pragma unroll
    for (int o = 1; o < 64; o <<= 1) { const float ta = shx(a, o, lane), tb = shx(b, o, lane); a += ta; b += tb; }
}
DI void ln_row_v(const Frame& F, f32x4 (&v)[4], float* xout, const float* g, const float* b, const float* sh, const float* sc, bf16_t* hout, const float* slab, const float* gres, float* stat = nullptr) {
    if (slab) {
#pragma unroll
        for (int j = 0; j < 4; ++j) { f32x4 a = ((const f32x4*)slab)[F.lane + 64 * j];
#pragma unroll
            for (int z = 1; z < 8; ++z) a += ((const f32x4*)(slab + (size_t)z * MC * 1024))[F.lane + 64 * j];
            v[j] = v[j] * ALPHA + ((const f32x4*)gres)[F.lane + 64 * j] * a; }
    }
    if (g) {
        float s = 0.f, s2 = 0.f;
#pragma unroll
        for (int j = 0; j < 4; ++j) { s += (v[j][0] + v[j][1]) + (v[j][2] + v[j][3]); s2 += (v[j][0] * v[j][0] + v[j][1] * v[j][1]) + (v[j][2] * v[j][2] + v[j][3] * v[j][3]); }
        wave_sum2(s, s2, F.lane);
        const float mean = s * (1.f / D); const float rstd = 1.f / sqrtf(fmaxf(s2 * (1.f / D) - mean * mean, 0.f) + EPS);
        if (stat && F.lane == 0) { f32x2 sv = {mean, rstd}; *(f32x2*)stat = sv; }
#pragma unroll
        for (int j = 0; j < 4; ++j) { const f32x4 gg = ((const f32x4*)g)[F.lane + 64 * j], bb = ((const f32x4*)b)[F.lane + 64 * j];
            v[j] = (v[j] - mean) * rstd * gg + bb; if (xout) ((f32x4*)xout)[F.lane + 64 * j] = v[j]; }
    }
    if (hout) {
        float s = 0.f, s2 = 0.f;
#pragma unroll
        for (int j = 0; j < 4; ++j) { s += (v[j][0] + v[j][1]) + (v[j][2] + v[j][3]); s2 += (v[j][0] * v[j][0] + v[j][1] * v[j][1]) + (v[j][2] * v[j][2] + v[j][3] * v[j][3]); }
        wave_sum2(s, s2, F.lane);
        const float mean = s * (1.f / D); const float rstd = 1.f / sqrtf(fmaxf(s2 * (1.f / D) - mean * mean, 0.f) + EPS);
#pragma unroll
        for (int j = 0; j < 4; ++j) { const f32x4 hh = ((const f32x4*)sh)[F.lane + 64 * j], cc = ((const f32x4*)sc)[F.lane + 64 * j];
            const f32x4 o = (v[j] - mean) * rstd * (cc + 1.f) + hh; u32x2 wv; wv.x = pk2(o[0], o[1]); wv.y = pk2(o[2], o[3]);
            ((u32x2*)hout)[F.lane + 64 * j] = wv; }
    }
}
DI void ln_load(const Frame& F, const float* xin, f32x4 (&v)[4]) {
    const f32x4* xr = (const f32x4*)xin + F.lane;
#pragma unroll
    for (int j = 0; j < 4; ++j) v[j] = xr[64 * j];
}
DI void ln_row(const Frame& F, const float* xin, float* xout, const float* g, const float* b, const float* sh, const float* sc, bf16_t* hout, const float* slab = nullptr, const float* gres = nullptr) {
    f32x4 v[4]; ln_load(F, xin, v);
    ln_row_v(F, v, xout, g, b, sh, sc, hout, slab, gres);
}

DI int srcmap(int kind, int n) {
    switch (kind) {
    case 0: {
        if (n < 256) return n;
        if (n < 512) return 1056 + (n - 256);
        if (n < 768) { const int c = n - 512, slot = (c & 127) >> 5, d = 32 * (c >> 7) + (c & 31); return slot < 2 ? 288 + slot * 64 + d : 416 + (slot - 2) * 64 + d; }
        if (n < 1280) { const int t = (n - 768) >> 8, c = (n - 768) & 255, slot = (c & 127) >> 5, d = 32 * (c >> 7) + (c & 31); return 1312 + (4 * t + slot) * 64 + d; }
        return 1824 + (n - 1280); }
    case 1: { const int half = (n & 7) >> 2, i = 4 * (n >> 3) + (n & 3); return 256 + half * 16 + i; }
    case 2: {
        if (n < 512) return (n >> 6) * 96 + (n & 63);
        const int c = n - 512, hd = c >> 5, j = c & 31, half = (j & 7) >> 2, i = 4 * (j >> 3) + (j & 3); return hd * 96 + 64 + half * 16 + i; }
    default: return n;
    }
}
DI void conv_item(const float* W, int K, int ld, int kind, const float* gain, bf16_t* WT, int item, int nblk, LAS float* scr, int lane) {
    const int kb = item / nblk, nb = item % nblk, k0 = 64 * kb, n0 = 32 * nb;
    const int sc_ = srcmap(kind, n0 + (lane & 31));
    float wv[32];
#pragma unroll
    for (int i = 0; i < 32; ++i) wv[i] = W[(size_t)(k0 + 2 * i + (lane >> 5)) * ld + sc_];
    if (gain) {
#pragma unroll
        for (int i = 0; i < 32; ++i) wv[i] *= gain[k0 + 2 * i + (lane >> 5)];
    }
#pragma unroll
    for (int i = 0; i < 32; ++i) scr[(2 * i + (lane >> 5)) * 33 + (lane & 31)] = wv[i];
    asm volatile("s_waitcnt lgkmcnt(0)" ::: "memory");
    const int c = lane & 7;
#pragma unroll
    for (int j = 0; j < 4; ++j) { const int n = (lane >> 3) + 8 * j; const LAS float* s = scr + (8 * c) * 33 + n;
        u32x4 o; o.x = pk2(s[0 * 33], s[1 * 33]); o.y = pk2(s[2 * 33], s[3 * 33]); o.z = pk2(s[4 * 33], s[5 * 33]); o.w = pk2(s[6 * 33], s[7 * 33]);
        *(u32x4*)(WT + (size_t)(n0 + n) * K + k0 + 8 * c) = o; }
    asm volatile("s_waitcnt lgkmcnt(0)" ::: "memory");
}
template <int Q0, int Q1>
DI void convert_weights(const Frame& F, int l, int crank, int ncu) {
    LAS float* scr = (LAS float*)(F.lds + F.wave * 16384);
    unsigned char* W = F.ws + WS_W;
    const int gw = crank * 8 + F.wave, NGW = ncu * 8;
    const float* w_in = pin(F, I_WIN) + (size_t)l * D * INC;
    struct It { const float* src; int K, ld, kind, N; const float* gain; size_t dst; };
    const It its[11] = {
        {w_in, 1024, INC, 0, NIN, nullptr, W_IN},
        {w_in, 1024, INC, 1, 32, nullptr, W_KR},
        {pin(F, I_WUK) + (size_t)l * 256 * 512, 256, 512, 9, 512, pin(F, I_MKVG) + l * 256, W_UKV},
        {pin(F, I_WUV) + (size_t)l * 256 * 512, 256, 512, 9, 512, pin(F, I_MKVG) + l * 256, W_UKV + 512 * 256 * 2},
        {pin(F, I_WUQ) + (size_t)l * 256 * 768, 256, 768, 2, 768, pin(F, I_MQG) + l * 256, W_UQ},
        {pin(F, I_WFO) + (size_t)l * 512 * 1024, 512, 1024, 9, 1024, nullptr, W_FO},
        {pin(F, I_WMO) + (size_t)l * 512 * 1024, 512, 1024, 9, 1024, nullptr, W_MO},
        {pin(F, I_WGO) + (size_t)l * 512 * 1024, 512, 1024, 9, 1024, nullptr, W_GO},
        {pin(F, I_WO) + (size_t)l * 1024 * 1024, 1024, 1024, 9, 1024, nullptr, W_O},
        {pin(F, I_W1) + (size_t)l * 1024 * 4096, 1024, 4096, 9, 4096, nullptr, W_1},
        {pin(F, I_W2) + (size_t)l * 4096 * 1024, 4096, 1024, 9, 1024, nullptr, W_2}};
    int base = 0;
#pragma unroll
    for (int q = Q0; q < Q1; ++q) {
        const int nblk = its[q].N / 32, nit = (its[q].K / 64) * nblk;
        int first = (gw - base) % NGW; if (first < 0) first += NGW;
        for (int it = first; it < nit; it += NGW) conv_item(its[q].src, its[q].K, its[q].ld, its[q].kind, its[q].gain, (bf16_t*)(W + its[q].dst), it, nblk, scr, F.lane);
        base = (base + nit) % NGW;
    }
}
DI void fold_fourier(const Frame& F, int l, int crank, int ncu) {
    __syncthreads();
    LAS float* u = (LAS float*)F.lds;
    LAS float* T = (LAS float*)(F.lds + 32768);
    if (F.tid < 128) T[F.tid] = cospif((float)F.tid * (1.f / 64.f));
    const float* w_in = pin(F, I_WIN) + (size_t)l * D * INC;
    bf16_t* WT = (bf16_t*)(F.ws + WS_W + W_T);
    for (int item = crank; item < 256; item += ncu) {
        const int g = item >> 6, k0 = (item & 63) * 16;
        __syncthreads();
        for (int e = F.tid; e < 16 * 128; e += 512) { const int kk = e >> 7, c = e & 127; u[kk * 129 + c] = w_in[(size_t)(k0 + kk) * INC + 544 + g * 128 + c]; }
        __syncthreads();
        const int kk = F.tid & 15, grp = F.tid >> 4;
        float a[8];
#pragma unroll
        for (int o = 0; o < 8; ++o) a[o] = 0.f;
        for (int c = 0; c < 128; ++c) { const float uv = u[kk * 129 + c];
#pragma unroll
            for (int o = 0; o < 8; ++o) { const int mcs = grp * 8 + o, mm = mcs >> 1, cs = mcs & 1; a[o] += uv * T[(mm * c - 32 * cs) & 127]; } }
#pragma unroll
        for (int o = 0; o < 8; ++o) { const int mcs = grp * 8 + o; unsigned short hv = (unsigned short)(pk2(a[o], 0.f) & 0xffffu); WT[(size_t)(g * 256 + mcs) * 1024 + k0 + kk] = hv; }
    }
    __syncthreads();
}
DI void krope_phase(const Frame& F, int crank, int ncu) {
    const bf16_t* H = (const bf16_t*)(F.ws + WS_HB); const bf16_t* Wk = (const bf16_t*)(F.ws + WS_W + W_KR); bf16_t* KR = (bf16_t*)(F.ws + WS_KR);
    const float* rm = (const float*)(F.ws + WS_ROPEM);
    const int r32 = F.lane & 31, h5 = F.lane >> 5, w = F.wave;
    LAS float* part = (LAS float*)F.lds;
    for (int it = crank; it < MT / 32; it += ncu) {
        const int row0 = it * 32;
        f32x16 acc;
#pragma unroll
        for (int i = 0; i < 16; ++i) acc[i] = 0.f;
        const bf16_t* hp = H + (size_t)(row0 + r32) * 1024 + 8 * h5 + 128 * w; const bf16_t* wp = Wk + (size_t)r32 * 1024 + 8 * h5 + 128 * w;
        bf16x8 a[8], b[8];
#pragma unroll
        for (int q = 0; q < 8; ++q) { a[q] = *(const bf16x8*)(wp + 16 * q); b[q] = *(const bf16x8*)(hp + 16 * q); }
#pragma unroll
        for (int q = 0; q < 8; ++q) acc = MFMA32(a[q], b[q], acc);
        __syncthreads();
#pragma unroll
        for (int i = 0; i < 16; ++i) part[(w * 16 + i) * 64 + F.lane] = acc[i];
        __syncthreads();
        if (w == 0) {
#pragma unroll
            for (int i = 0; i < 16; ++i) { float sacc = 0.f;
#pragma unroll
                for (int q = 0; q < 8; ++q) sacc += part[(q * 16 + i) * 64 + F.lane];
                acc[i] = sacc; }
            const int row = row0 + r32;
            f32x16 oth;
#pragma unroll
            for (int i = 0; i < 16; ++i) oth[i] = shx(acc[i], 32, F.lane);
            u32x2 wv[4];
#pragma unroll
            for (int g = 0; g < 4; ++g) { float o[4];
#pragma unroll
                for (int e = 0; e < 4; ++e) { const int i = 4 * g + e; float x1 = h5 ? oth[i] : acc[i], x2 = h5 ? acc[i] : oth[i]; float cs = 1.f, sn = 0.f;
                    if (row < ML) { cs = rm[(size_t)(row & 2047) * 32 + i]; sn = rm[(size_t)(row & 2047) * 32 + 16 + i]; }
                    o[e] = h5 ? (x1 * sn + x2 * cs) : (x1 * cs - x2 * sn); }
                wv[g].x = pk2(o[0], o[1]); wv[g].y = pk2(o[2], o[3]); }
#pragma unroll
            for (int g = 0; g < 4; ++g) *(u32x2*)(KR + (size_t)row * 32 + 8 * g + 4 * h5) = wv[g];
        }
    }
    __syncthreads();
}

DI void prologue_a(const Frame& F) {
    unsigned char* ws = F.ws;
    convert_weights<0, 5>(F, 0, F.vcu, F.G);
    fold_fourier(F, 0, F.bid, F.G);
    { const int gt = F.bid * 512 + F.tid, NT = F.G * 512;
      float* rm = (float*)(ws + WS_ROPEM); float* rg = (float*)(ws + WS_ROPEG);
      for (int e = gt; e < 2048 * 16; e += NT) { const int pos = e >> 4, i = e & 15; const float fr_ = powf(10000.f, -(float)(i & 7) / 8.f); const float p_ = (i < 8) ? (float)(pos >> 6) : (float)(pos & 63);
          float sn, cs; sincosf(p_ * fr_, &sn, &cs); rm[pos * 32 + i] = cs; rm[pos * 32 + 16 + i] = sn; }
      for (int e = gt; e < 2048 * 32; e += NT) { const int pos = e >> 5, i = e & 31; const float fr_ = powf(10000.f, -(float)(i & 15) / 16.f); const float p_ = (i < 16) ? (float)(pos >> 6) : (float)(pos & 63);
          float sn, cs; sincosf(p_ * fr_, &sn, &cs); rg[pos * 64 + i] = cs; rg[pos * 64 + 32 + i] = sn; }
      bf16_t* dm = (bf16_t*)(ws + WS_DFTM);
      for (int e = gt; e < 2048 * 1024; e += NT) { const int k = e >> 10, j2 = (e & 1023) * 2; unsigned wv[2];
#pragma unroll
          for (int q = 0; q < 2; ++q) { const int j = j2 + q * 2048; float v0, v1; { const int jj = j & 2047; const float a0 = (float)((k * jj) & 2047) * (1.f / 1024.f), a1 = (float)((k * (jj + 1)) & 2047) * (1.f / 1024.f);
              if (j < 2048) { v0 = cospif(a0); v1 = cospif(a1); } else { v0 = -sinpif(a0); v1 = -sinpif(a1); } }
              wv[q] = pk2(v0 * (1.f / 512.f), v1 * (1.f / 512.f)); }
          *(unsigned*)(dm + (size_t)k * 4096 + j2) = wv[0]; *(unsigned*)(dm + (size_t)k * 4096 + 2048 + j2) = wv[1]; }
      bf16_t* dc = (bf16_t*)(ws + WS_DFTMC); const float sc = 0.005524271728019903f;
      for (int e = gt; e < 256 * 512; e += NT) { const int k = e >> 9, j = e & 511, jj = j & 255; const float a0 = (float)((k * jj) & 255) * (1.f / 128.f);
          const float v = (j < 256) ? cospif(a0) : -sinpif(a0); dc[e] = (unsigned short)(pk2(v * sc, 0.f) & 0xffffu); }
    }
    { __syncthreads();
      LAS float* sl = (LAS float*)F.lds;
      LAS float* red = (LAS float*)(F.lds + 36864);
      for (int e = F.tid; e < 9 * 1024; e += 512) { const int r = e >> 10, k = e & 1023; const float c = r < 8 ? pin(F, I_C)[r * 1024 + k] : pin(F, I_CCTX)[k]; sl[e] = c / (1.f + __expf(-c)); }
      __syncthreads();
      const int col = F.tid & 63, kg = F.tid >> 6;
      for (int item = F.bid; item < 4 * 96; item += F.G) {
          const int l = item / 96, cb = (item % 96) * 64;
          const float* wa = pin(F, I_WADA) + (size_t)l * 1024 * 6144 + cb + col;
          float a[9];
#pragma unroll
          for (int r = 0; r < 9; ++r) a[r] = 0.f;
          for (int k0 = kg * 128; k0 < kg * 128 + 128; k0 += 16) { float wv[16];
#pragma unroll
              for (int q = 0; q < 16; ++q) wv[q] = wa[(size_t)(k0 + q) * 6144];
#pragma unroll
              for (int q = 0; q < 16; ++q)
#pragma unroll
                  for (int r = 0; r < 9; ++r) a[r] += sl[r * 1024 + k0 + q] * wv[q]; }
#pragma unroll
          for (int r = 0; r < 9; ++r) red[(kg * 9 + r) * 64 + col] = a[r];
          __syncthreads();
          for (int e = F.tid; e < 9 * 64; e += 512) { const int r = e >> 6, c2 = e & 63; float s = pin(F, I_BADA)[l * 6144 + cb + c2];
#pragma unroll
              for (int q = 0; q < 8; ++q) s += red[(q * 9 + r) * 64 + c2];
              ((float*)(ws + WS_MOD))[(size_t)(l * 9 + r) * 6144 + cb + c2] = s; }
          __syncthreads();
      }
    }
}
DI void prologue_b(const Frame& F) {
    const int gw = F.vcu * 8 + F.wave, NGW = F.G * 8;
    bf16_t* H = (bf16_t*)(F.ws + WS_HB);
    for (int row = gw; row < MT; row += NGW) {
        const int mr = row < ML ? (row >> 11) : 8;
        const float* xi = row < ML ? pin(F, I_X) + (size_t)row * D : pin(F, I_CTX) + (size_t)(row - ML) * D;
        ln_row(F, xi, nullptr, nullptr, nullptr, modp(F, 0, mr, 0), modp(F, 0, mr, 1), H + (size_t)row * D);
    }
}
DI void ln_phase(const Frame& F, int which) {
    const int gw = F.vcu * 8 + F.wave, NGW = F.G * 8; const int l = F.l;
    const int nrows = (l == NL - 1) ? ML : MT;
    bf16_t* H = (bf16_t*)(F.ws + WS_HB);
    const float* g = pin(F, which == 0 ? I_LN1G : I_LN2G) + l * 1024; const float* b = pin(F, which == 0 ? I_LN1B : I_LN2B) + l * 1024;
    const bool wh = !(which == 1 && l == NL - 1);
    f32x4 vc[4], vn[4];
    if (gw < nrows) ln_load(F, xrow_ptr(F, gw), vc);
    for (int row = gw; row < nrows; row += NGW) {
        if (row + NGW < nrows) ln_load(F, xrow_ptr(F, row + NGW), vn);
        const int mr = row < ML ? (row >> 11) : 8;
        const float* sh = which == 0 ? modp(F, l, mr, 3) : modp(F, l + 1 < NL ? l + 1 : l, mr, 0);
        const float* sc = which == 0 ? modp(F, l, mr, 4) : modp(F, l + 1 < NL ? l + 1 : l, mr, 1);
        const bool sl = (which == 1 && row >= ML);
        const bool st_only = row < ML && !(which == 1 && l == NL - 1);
        float* stp = st_only ? (float*)(F.ws + (which == 0 ? WS_ST1 : WS_ST2)) + 2 * (size_t)row : nullptr;
        ln_row_v(F, vc, st_only ? nullptr : xrow_ptr(F, row), g, b, sh, sc, wh ? H + (size_t)row * D : nullptr, sl ? (const float*)(F.ws + WS_KN) + (size_t)(row - ML) * 1024 : nullptr, modp(F, l, mr, 5), stp);
#pragma unroll
        for (int j = 0; j < 4; ++j) vc[j] = vn[j];
    }
}

DI void phase_g1(const Frame& F) {
    const unsigned char* W = F.ws + WS_W; const char* H = (const char*)(F.ws + WS_HB);
    pg8::Sched2 S; S.tileBytes = 256L * 1024 * 2; S.G = F.G; S.c = F.bid;
    S.j0 = pg8::JobD{H, (const char*)(W + W_IN), MT / 256, NIN / 256, 1, 0, 0};
    S.j1 = pg8::JobD{(const char*)(W + W_T), H, 4, MT / 256, 1, 0, 0};
    S.n0 = (MT / 256) * (NIN / 256); S.total = S.n0 + 4 * (MT / 256);
    krope_phase(F, F.bid, F.G);
    EpiG1 E{F};
    pg8::gemm_phase(F.lds, 1024, S, E, F.tid);
}
DI void phase_g2(const Frame& F) {
    const unsigned char* W = F.ws + WS_W;
    pg8::Sched2 S; S.tileBytes = 256L * 256 * 2; S.G = F.G; S.c = F.bid;
    S.j0 = pg8::JobD{(const char*)(F.ws + WS_CKV), (const char*)(W + W_UKV), MT / 256, 4, 1, 0, 0};
    S.j1 = pg8::JobD{(const char*)(F.ws + WS_CQ), (const char*)(W + W_UQ), MT / 256, 3, 1, 0, 0};
    S.n0 = (MT / 256) * 4; S.total = S.n0 + (MT / 256) * 3;
    EpiG2 E{F};
    pg8::gemm_phase(F.lds, 256, S, E, F.tid);
}
DI void phase_att(const Frame& F) {
    const bool lastl = (F.l == NL - 1);
    const int nun = (!lastl && F.vcu < 128) ? 5 : 4;
#pragma unroll 1
    for (int i = 0; i < nun; ++i) {
        int kind, b, h, q0, nt;
        if (i < 4) { const int idx = (i >> 1) * 256 + F.vcu; kind = i & 1; b = idx >> 6; h = (idx >> 3) & 7; q0 = b * SEQ + (idx & 7) * 256; nt = 36; }
        else { const int idx = F.vcu >> 1; kind = F.vcu & 1; b = idx >> 3; h = idx & 7; q0 = ML + b * CTXL; nt = 4; }
        if (kind == 0) attn_unit<0>(F, q0, h, ML + b * CTXL, b * SEQ, nt);
        else attn_unit<1>(F, q0, h, ML + b * CTXL, b * SEQ, nt);
    }
    __syncthreads();
#ifndef NO_DFT
    {
        pg8::Sched2 S; S.tileBytes = 256L * 4096 * 2; S.G = F.G; S.c = (F.bid + 128) & 255;
        S.j0 = pg8::JobD{(const char*)(F.ws + WS_DFTM), (const char*)(F.ws + WS_TF), 8, 2, 8, 0, 1024L * 2048 * 2}; S.j1 = S.j0;
        S.n0 = 128; S.total = 128;
        EpiDft E{(bf16_t*)(F.ws + WS_F), 2048, 512};
        pg8::gemm_phase(F.lds, 4096, S, E, F.tid);
#ifdef PROBE_DFT
        pg8::gemm_phase(F.lds, 4096, S, E, F.tid);
#endif
    }
    if (!lastl) {
        pg8::Sched2 S; S.tileBytes = 256L * 512 * 2; S.G = F.G; S.c = F.bid;
        S.j0 = pg8::JobD{(const char*)(F.ws + WS_DFTMC), (const char*)(F.ws + WS_TFC), 1, 2, 8, 0, 1024L * 256 * 2}; S.j1 = S.j0;
        S.n0 = 16; S.total = 16;
        EpiDft E{(bf16_t*)(F.ws + WS_F) + (size_t)ML * 512, 256, 512};
        pg8::gemm_phase(F.lds, 512, S, E, F.tid);
    }
#endif
    if (F.bid < 128) {
        __syncthreads();
        const int cr = (F.bid & 7) * 16 + (F.bid >> 3);
        convert_weights<5, 11>(F, F.l, cr, 128);
    }
}
DI void phase_g3(const Frame& F) {
    const unsigned char* W = F.ws + WS_W; const int nM = (F.l == NL - 1 ? ML : MT) / 256;
    pg8::Sched3 S; S.tileBytes = 256L * 512 * 2; S.G = F.G; S.c = F.bid; S.ntiles = nM * 4;
    S.j = pg8::JobD{(const char*)(F.ws + WS_F), (const char*)(W + W_FO), nM, 4, 1, 0, 0};
    S.A1 = (const char*)(F.ws + WS_AM); S.B1 = (const char*)(W + W_MO); S.A2 = (const char*)(F.ws + WS_QG); S.B2 = (const char*)(W + W_GO);
    EpiG3 E{F};
    pg8::gemm_phase(F.lds, 512, S, E, F.tid);
    if (F.l + 1 < NL && F.bid >= 32) {
        __syncthreads();
        convert_weights<0, 5>(F, F.l + 1, F.bid - 32, F.G - 32); fold_fourier(F, F.l + 1, F.bid - 32, F.G - 32);
    }
}
DI void phase_g4(const Frame& F) {
    const unsigned char* W = F.ws + WS_W; const int nM = (F.l == NL - 1 ? ML : MT) / 256;
    pg8::Sched2 S; S.tileBytes = 256L * 1024 * 2; S.G = F.G; S.c = F.bid;
    S.j0 = pg8::JobD{(const char*)(F.ws + WS_HB), (const char*)(W + W_O), nM, 4, 1, 0, 0}; S.j1 = S.j0; S.n0 = nM * 4; S.total = S.n0;
    EpiRes E{F, 2, true, F.l > 0 ? 2 : 0};
    pg8::gemm_phase(F.lds, 1024, S, E, F.tid);
}
DI void phase_g5(const Frame& F) {
    const unsigned char* W = F.ws + WS_W; const int nM = (F.l == NL - 1 ? ML : MT) / 256;
    pg8::Sched2 S; S.tileBytes = 256L * 1024 * 2; S.G = F.G; S.c = F.bid;
    S.j0 = pg8::JobD{(const char*)(F.ws + WS_HB), (const char*)(W + W_1), nM, 16, 1, 0, 0}; S.j1 = S.j0; S.n0 = nM * 16; S.total = S.n0;
    EpiW1 E{F};
    pg8::gemm_phase(F.lds, 1024, S, E, F.tid);
#ifdef PROBE_G5
    pg8::gemm_phase(F.lds, 1024, S, E, F.tid);
#endif
}
DI void phase_g6(const Frame& F) {
    const unsigned char* W = F.ws + WS_W;
    {
        pg8::Sched2 S; S.tileBytes = 256L * 4096 * 2; S.G = F.G; S.c = F.bid;
        S.j0 = pg8::JobD{(const char*)(F.ws + WS_U), (const char*)(W + W_2), ML / 256, 4, 1, 0, 0}; S.j1 = S.j0; S.n0 = (ML / 256) * 4; S.total = S.n0;
        EpiRes E{F, 5, false, 1};
        pg8::gemm_phase(F.lds, 4096, S, E, F.tid);
    }
    if (F.l < NL - 1) {
        pg8::Sched2 S; S.tileBytes = 256L * 4096 * 2; S.G = F.G; S.c = F.bid;
        S.j0 = pg8::JobD{(const char*)(F.ws + WS_U) + (size_t)ML * 4096 * 2, (const char*)(W + W_2), MC / 256, 4, 8, 512 * 2, 512 * 2}; S.j1 = S.j0; S.n0 = (MC / 256) * 4 * 8; S.total = S.n0;
        EpiSlab E{(float*)(F.ws + WS_KN)};
        pg8::gemm_phase<4096>(F.lds, 512, S, E, F.tid);
    }
}

constexpr int N_PHASES = 2 + 9 * NL;
template <int ONLY>
__global__ void __launch_bounds__(512, 2) fwd_kernel(Params prm) {
    extern __shared__ __attribute__((aligned(16))) unsigned char lds_raw[];
    Frame F;
    F.P = &prm; F.ws = prm.ws; F.lds = (LAS unsigned char*)lds_raw;
    F.tid = threadIdx.x; F.lane = F.tid & 63; F.wave = __builtin_amdgcn_readfirstlane(F.tid >> 6);
    F.G = gridDim.x; F.bid = blockIdx.x; F.vcu = (F.G % 8 == 0) ? (F.bid % 8) * (F.G / 8) + F.bid / 8 : F.bid; F.l = 0;
    volatile LAS unsigned* MISC = (volatile LAS unsigned*)(F.lds + MISC_OFF);
    for (int u = F.tid; u < (LDS_BYTES - RING_BYTES) / 4; u += 512) ((LAS unsigned*)(F.lds + RING_BYTES))[u] = 0u;
    __syncthreads();
#if MK_ONE_LAUNCH
    const int lo = 0, hi = N_PHASES;
#else
    const int lo = prm.ph_lo, hi = prm.ph_hi;
#endif
    XcdBarrier bar; bar.bar = (unsigned*)(F.ws + WS_CTL) + 4096; bar.x = 0; bar.st = nullptr;
    if (hi - lo > 1) {
        bar = xcd_barrier_post((unsigned*)(F.ws + WS_CTL) + 4096, MISC + 8);
        cg::this_grid().sync();
        if (threadIdx.x == 0) { unsigned nloc, nx; xcd_barrier_complete(bar.bar, bar.x, nloc, nx); bar.st[0] = nloc; bar.st[1] = nx; }
        __syncthreads();
    }
    const int wave_s = __builtin_amdgcn_readfirstlane(threadIdx.x >> 6);
    for (int ph = lo; ph < hi; ++ph) {
        { int lane_; asm volatile("v_mbcnt_lo_u32_b32 %0, -1, 0\n\tv_mbcnt_hi_u32_b32 %0, -1, %0" : "=v"(lane_));
          int z_ = 0, b_ = blockIdx.x, g_ = gridDim.x, t_ = wave_s * 64 + lane_;
#if (OPQ_MASK & 1)
          asm volatile("" : "+s"(z_));
#endif
#if (OPQ_MASK & 2)
          asm volatile("" : "+s"(b_), "+s"(g_));
#endif
#if (OPQ_MASK & 4)
          asm volatile("" : "+v"(t_));
#endif
          F.ws = prm.ws + z_; F.zo = z_;
          b_ &= 1023; g_ &= 1023; F.bid = b_; F.G = g_; F.vcu = (g_ % 8 == 0) ? (b_ % 8) * (g_ / 8) + b_ / 8 : b_; F.tid = t_ & 511; F.lane = t_ & 63; F.wave = __builtin_amdgcn_readfirstlane((t_ & 511) >> 6); }
        if constexpr (ONLY >= 0) {
            F.l = ph < 2 ? 0 : (ph - 2) / 9;
            if constexpr (ONLY == 100) prologue_a(F);
            else if constexpr (ONLY == 101) prologue_b(F);
            else if constexpr (ONLY == 0) phase_g1(F);
            else if constexpr (ONLY == 1) phase_g2(F);
            else if constexpr (ONLY == 2) phase_att(F);
            else if constexpr (ONLY == 3) phase_g3(F);
            else if constexpr (ONLY == 4) phase_g4(F);
            else if constexpr (ONLY == 5) ln_phase(F, 0);
            else if constexpr (ONLY == 6) phase_g5(F);
            else if constexpr (ONLY == 7) phase_g6(F);
            else ln_phase(F, 1);
            continue;
        }
        if (ph == 0) prologue_a(F);
        else if (ph == 1) prologue_b(F);
        else {
            const int q = ph - 2; F.l = q / 9; const int sub = q - F.l * 9;
            switch (sub) {
            case 0: phase_g1(F); break;
            case 1: phase_g2(F); break;
            case 2: phase_att(F); break;
            case 3: phase_g3(F); break;
            case 4: phase_g4(F); break;
            case 5: ln_phase(F, 0); break;
            case 6: phase_g5(F); break;
            case 7: phase_g6(F); break;
            default: ln_phase(F, 1); break;
            }
        }
        if (ph + 1 < hi) { XcdBarrier b2; b2.bar = (unsigned*)(F.ws + WS_CTL) + 4096; b2.x = xb_xcc_id(); b2.st = (volatile LAS unsigned*)(F.lds + MISC_OFF) + 8; xcd_barrier(b2, F.tid); }
    }
}

extern "C" void kernel_launch(void* const* d_in, const int* in_sizes, int n_in, void* d_out, int out_size, void* d_ws, size_t ws_size, hipStream_t stream) {
    static int grid = 0;
    if (grid == 0) {
        if (n_in != 25 || out_size != ML * D || ws_size < WS_END) { fprintf(stderr, "kernel_launch: unexpected shapes (n_in %d out %d ws %zu)\n", n_in, out_size, ws_size); grid = -1; return; }
        int dev = 0, cus = 0, per_cu = 0;
        (void)hipGetDevice(&dev); (void)hipDeviceGetAttribute(&cus, hipDeviceAttributeMultiprocessorCount, dev);
#if MK_ONE_LAUNCH
        (void)hipFuncSetAttribute((const void*)fwd_kernel<-1>, hipFuncAttributeMaxDynamicSharedMemorySize, LDS_BYTES);
        (void)hipOccupancyMaxActiveBlocksPerMultiprocessor(&per_cu, (const void*)fwd_kernel<-1>, 512, LDS_BYTES);
#else
        (void)hipFuncSetAttribute((const void*)fwd_kernel<100>, hipFuncAttributeMaxDynamicSharedMemorySize, LDS_BYTES);
        (void)hipFuncSetAttribute((const void*)fwd_kernel<101>, hipFuncAttributeMaxDynamicSharedMemorySize, LDS_BYTES);
        (void)hipFuncSetAttribute((const void*)fwd_kernel<0>, hipFuncAttributeMaxDynamicSharedMemorySize, LDS_BYTES);
        (void)hipFuncSetAttribute((const void*)fwd_kernel<1>, hipFuncAttributeMaxDynamicSharedMemorySize, LDS_BYTES);
        (void)hipFuncSetAttribute((const void*)fwd_kernel<2>, hipFuncAttributeMaxDynamicSharedMemorySize, LDS_BYTES);
        (void)hipFuncSetAttribute((const void*)fwd_kernel<3>, hipFuncAttributeMaxDynamicSharedMemorySize, LDS_BYTES);
        (void)hipFuncSetAttribute((const void*)fwd_kernel<4>, hipFuncAttributeMaxDynamicSharedMemorySize, LDS_BYTES);
        (void)hipFuncSetAttribute((const void*)fwd_kernel<5>, hipFuncAttributeMaxDynamicSharedMemorySize, LDS_BYTES);
        (void)hipFuncSetAttribute((const void*)fwd_kernel<6>, hipFuncAttributeMaxDynamicSharedMemorySize, LDS_BYTES);
        (void)hipFuncSetAttribute((const void*)fwd_kernel<7>, hipFuncAttributeMaxDynamicSharedMemorySize, LDS_BYTES);
        (void)hipFuncSetAttribute((const void*)fwd_kernel<8>, hipFuncAttributeMaxDynamicSharedMemorySize, LDS_BYTES);
#endif
        (void)hipGetLastError();
        if (per_cu < 1) per_cu = 1;
        grid = cus;
        if (grid != 256) fprintf(stderr, "kernel_launch: grid %d (expected 256)\n", grid);
    }
    if (grid < 0) return;
    (void)hipMemsetAsync((char*)d_ws + WS_CTL, 0, CTL_BYTES, stream);
    Params p{};
    for (int i = 0; i < 25; ++i) p.in[i] = (const float*)d_in[i];
    p.out = (float*)d_out; p.ws = (unsigned char*)d_ws;
#if MK_ONE_LAUNCH
    p.ph_lo = 0; p.ph_hi = N_PHASES;
    void* args[] = {&p};
    hipError_t e = hipLaunchCooperativeKernel((const void*)fwd_kernel<-1>, dim3(grid), dim3(512), args, LDS_BYTES, stream);
    if (e != hipSuccess) fprintf(stderr, "cooperative launch failed: %s\n", hipGetErrorString(e));
#else
    for (int ph = 0; ph < N_PHASES; ++ph) {
        p.ph_lo = ph; p.ph_hi = ph + 1;
        const int sub = ph < 2 ? 100 + ph : (ph - 2) % 9;
        switch (sub) {
        case 100: hipLaunchKernelGGL(fwd_kernel<100>, dim3(grid), dim3(512), LDS_BYTES, stream, p); break;
        case 101: hipLaunchKernelGGL(fwd_kernel<101>, dim3(grid), dim3(512), LDS_BYTES, stream, p); break;
        case 0: hipLaunchKernelGGL(fwd_kernel<0>, dim3(grid), dim3(512), LDS_BYTES, stream, p); break;
        case 1: hipLaunchKernelGGL(fwd_kernel<1>, dim3(grid), dim3(512), LDS_BYTES, stream, p); break;
        case 2: hipLaunchKernelGGL(fwd_kernel<2>, dim3(grid), dim3(512), LDS_BYTES, stream, p); break;
        case 3: hipLaunchKernelGGL(fwd_kernel<3>, dim3(grid), dim3(512), LDS_BYTES, stream, p); break;
        case 4: hipLaunchKernelGGL(fwd_kernel<4>, dim3(grid), dim3(512), LDS_BYTES, stream, p); break;
        case 5: hipLaunchKernelGGL(fwd_kernel<5>, dim3(grid), dim3(512), LDS_BYTES, stream, p); break;
        case 6: hipLaunchKernelGGL(fwd_kernel<6>, dim3(grid), dim3(512), LDS_BYTES, stream, p); break;
        case 7: hipLaunchKernelGGL(fwd_kernel<7>, dim3(grid), dim3(512), LDS_BYTES, stream, p); break;
        default: hipLaunchKernelGGL(fwd_kernel<8>, dim3(grid), dim3(512), LDS_BYTES, stream, p); break;
        }
    }
#endif
}
```
